# Optimizing an MI355X kernel written in HIP

```python
import functools
import jax, jax.numpy as jnp
from jax import lax
import numpy as np

D_MODEL = 2048
BATCH = 16
SEQ = 256
DEPTH = 2
DEC_BATCH = 4
DEC_SEQ = 2048
PAST_LEN = 512

GRID_W = 64
N_MOD = 9
D_FF = 5504
FFN_RES = 0.5
EPS = 1e-6
NEG_INF = -1e30

POOL_GROUPS = 4
POOL_WINDOWS = (2, 4, 8, 16)
POOL_WIDTH = 1024
POOL_GC = POOL_WIDTH // POOL_GROUPS

NA_HEADS = 8
NA_HEAD_DIM = 128
NA_WIDTH = NA_HEADS * NA_HEAD_DIM
NA_WIN_H = 8
NA_WIN_W = 16
NA_QBLK = 16
NA_KBAND = NA_QBLK + NA_WIN_W
ATTN_QBLK = 128

GLA_HEADS = 4
GLA_DK = 128
GLA_DV = 256
GLA_KW = GLA_HEADS * GLA_DK
GLA_VW = GLA_HEADS * GLA_DV
GLA_RANK = 16
GLA_TAU = 16.0
GLA_CHUNK = 64
ROPE_BASE = 10000.0

BRANCH_W = 1024
N_BRANCH = 3
IN_SPLITS = (POOL_WIDTH, NA_WIDTH, NA_WIDTH, NA_WIDTH, GLA_KW, GLA_KW, GLA_VW, 2 * GLA_RANK, GLA_VW, N_BRANCH * D_MODEL)
IN_COLS = sum(IN_SPLITS)

kernel_name = 'hybrid_pool_na_gla_diffusion_step'

f32 = jnp.float32


def rmsnorm(x, g):
    xf = x.astype(f32)
    y = xf * lax.rsqrt(jnp.mean(xf * xf, axis=-1, keepdims=True) + EPS)
    return (y * g.astype(f32)).astype(x.dtype)


def modulate(x, shift, scale):
    return x * (1 + scale) + shift


def swiglu(h, w_in, w_out):
    gt, up = jnp.split(h @ w_in, 2, axis=-1)
    return (jax.nn.silu(gt) * up) @ w_out


def heads(x, n):
    B, L, _ = x.shape
    return x.reshape(B, L, n, -1).transpose(0, 2, 1, 3)


def merge_heads(x):
    B, H, L, d = x.shape
    return x.transpose(0, 2, 1, 3).reshape(B, L, H * d)


def split_in(h, w_in):
    idx = [int(i) for i in np.cumsum(IN_SPLITS)[:-1]]
    return jnp.split(h @ w_in, idx, axis=-1)


def pool_mix(u, w_grp, scale):
    B, L, _ = u.shape
    ug = u.reshape(B, L, POOL_GROUPS, POOL_GC)
    cs = jnp.concatenate([jnp.zeros((B, 1, POOL_GROUPS, POOL_GC), f32),
                          jnp.cumsum(ug.astype(f32), axis=1)], axis=1)
    t = jnp.arange(L)
    outs = []
    for gi, win in enumerate(POOL_WINDOWS):
        lo = jnp.clip(t - win // 2, 0, L - 1)
        hi = jnp.clip(t + win - 1 - win // 2, 0, L - 1)
        csg = cs[:, :, gi]
        cnt = (hi - lo + 1).astype(f32)[None, :, None]
        outs.append((csg[:, hi + 1] - csg[:, lo]) / cnt)
    pooled = jnp.stack(outs, axis=2).astype(u.dtype) - ug
    y = jnp.einsum('blgc,gcd->blgd', pooled, w_grp).reshape(B, L, POOL_WIDTH)
    return y * scale


def context_attention(q, k, v):
    B, H, L, d = q.shape
    nb = L // ATTN_QBLK
    qb = q.reshape(B, H, nb, ATTN_QBLK, d).transpose(2, 0, 1, 3, 4)

    def blk(qi):
        s = jnp.einsum('bhqd,bhkd->bhqk', qi, k).astype(f32) * (d ** -0.5)
        p = jax.nn.softmax(s, axis=-1).astype(v.dtype)
        return jnp.einsum('bhqk,bhkd->bhqd', p, v)

    o = lax.map(blk, qb)
    return o.transpose(1, 2, 0, 3, 4).reshape(B, H, L, d)


def na_latent(q, k, v, ck, cv, rpb):
    B, H, N, hd = q.shape
    rows = N // GRID_W
    kh = min(NA_WIN_H, rows)
    nb = GRID_W // NA_QBLK
    qc = np.arange(GRID_W).reshape(nb, NA_QBLK)
    cs = np.clip(qc - NA_WIN_W // 2, 0, GRID_W - NA_WIN_W)
    bs = np.clip(np.arange(nb) * NA_QBLK - NA_WIN_W // 2, 0, GRID_W - NA_KBAND)
    kc = bs[:, None] + np.arange(NA_KBAND)
    col_ok = (kc[:, None, :] >= cs[:, :, None]) & (kc[:, None, :] < cs[:, :, None] + NA_WIN_W)
    col_idx = np.clip(kc[:, None, :] - qc[:, :, None] + NA_WIN_W - 1, 0, 2 * NA_WIN_W - 2)
    scale = hd ** -0.5
    k_grid = k.reshape(B, H, rows, GRID_W, hd)
    v_grid = v.reshape(B, H, rows, GRID_W, hd)
    q_rows = jnp.moveaxis(q.reshape(B, H, rows, GRID_W, hd), 2, 0)
    n_loc = kh * NA_KBAND

    def row_block(args):
        qr, r = args
        rs = jnp.clip(r - kh // 2, 0, rows - kh)
        kb = lax.dynamic_slice_in_dim(k_grid, rs, kh, axis=2)[:, :, :, kc]
        vb = lax.dynamic_slice_in_dim(v_grid, rs, kh, axis=2)[:, :, :, kc]
        qb = qr.reshape(B, H, nb, NA_QBLK, hd)
        s_loc = jnp.einsum('bhnqd,bhinkd->bhnqik', qb, kb).astype(f32) * scale
        bias = rpb[:, rs + jnp.arange(kh) - r + NA_WIN_H - 1][:, :, col_idx]
        s_loc = jnp.where(col_ok[:, :, None, :], s_loc + bias.transpose(0, 2, 3, 1, 4).astype(f32), NEG_INF)
        s_ctx = jnp.einsum('bhnqd,bhcd->bhnqc', qb, ck).astype(f32) * scale
        s = jnp.concatenate([s_loc.reshape(B, H, nb, NA_QBLK, n_loc), s_ctx], axis=-1)
        p = jax.nn.softmax(s, axis=-1).astype(v.dtype)
        p_loc = p[..., :n_loc].reshape(B, H, nb, NA_QBLK, kh, NA_KBAND)
        o = (jnp.einsum('bhnqik,bhinkd->bhnqd', p_loc, vb)
             + jnp.einsum('bhnqc,bhcd->bhnqd', p[..., n_loc:], cv.astype(v.dtype)))
        return o.reshape(B, H, GRID_W, hd)

    o = lax.map(row_block, (q_rows, jnp.arange(rows)))
    return jnp.moveaxis(o, 0, 2).reshape(B, H, N, hd)


def axial_rope(x):
    L = x.shape[2]
    t = jnp.arange(L)
    pos = (t // GRID_W, t % GRID_W)
    half = GLA_DK // 2
    nf = half // 2
    inv = ROPE_BASE ** (-jnp.arange(nf, dtype=f32) / nf)
    parts = []
    for ax in range(2):
        xa = x[..., ax * half:(ax + 1) * half]
        ang = pos[ax].astype(f32)[:, None] * inv
        cos, sin = jnp.cos(ang), jnp.sin(ang)
        x1, x2 = xa[..., :nf], xa[..., nf:]
        parts += [x1 * cos - x2 * sin, x2 * cos + x1 * sin]
    return jnp.concatenate(parts, axis=-1)


def gla_chunked(q, k, v, g, s0):
    B, H, L, dk = q.shape
    dv = v.shape[-1]
    n = L // GLA_CHUNK
    rs = lambda a: a.reshape(B, H, n, GLA_CHUNK, a.shape[-1])
    q, k, v, g = rs(q), rs(k), rs(v), rs(g)
    b = jnp.cumsum(g, axis=3)
    b_end = b[:, :, :, -1:, :]
    q_in = q * jnp.exp(b)
    a = jnp.einsum('bhncd,bhnsd->bhncs', q_in, k * jnp.exp(-b))
    causal = jnp.tril(jnp.ones((GLA_CHUNK, GLA_CHUNK), dtype=bool))
    o_intra = jnp.einsum('bhncs,bhnse->bhnce', jnp.where(causal, a, 0.0), v)
    k_dec = k * jnp.exp(b_end - b)
    decay = jnp.exp(b_end[:, :, :, 0, :])

    def step(S, xs):
        qi, ki, vi, di = xs
        o = jnp.einsum('bhcd,bhde->bhce', qi, S)
        S = di[..., None] * S + jnp.einsum('bhcd,bhce->bhde', ki, vi)
        return S, o

    mv = lambda a: jnp.moveaxis(a, 2, 0)
    s_fin, o_inter = lax.scan(step, s0, (mv(q_in), mv(k_dec), mv(v), mv(decay)))
    o = o_intra + jnp.moveaxis(o_inter, 0, 2)
    return o.reshape(B, H, L, dv), s_fin


def gla_bidir(q, k, v, z, w_gate, b_gate, s0):
    outs, states = [], []
    for d in range(2):
        logit = jnp.einsum('blr,rk->blk', z[:, :, d], w_gate[d].astype(f32)) + b_gate[d].astype(f32)
        g = heads(jax.nn.log_sigmoid(logit) / GLA_TAU, GLA_HEADS)
        if d == 0:
            o, s = gla_chunked(q, k, v, g, s0[:, 0].astype(f32))
        else:
            fl = lambda a: jnp.flip(a, axis=2)
            o, s = gla_chunked(fl(q), fl(k), fl(v), fl(g), s0[:, 1].astype(f32))
            o = fl(o)
        outs.append(o)
        states.append(s)
    return outs[0] + outs[1], jnp.stack(states, axis=1)


def gla_out(o, norm_g, r):
    B, H, L, dv = o.shape
    o = o * lax.rsqrt(jnp.mean(o * o, axis=-1, keepdims=True) + EPS) * norm_g.astype(f32).reshape(H, 1, dv)
    return merge_heads(o).astype(r.dtype) * jax.nn.silu(r)


def merge_branches(y_pool, y_na, y_gla, gate_logits, w_branch, w_out):
    B, L, _ = y_pool.shape
    br = jnp.stack([y_pool, y_na.astype(y_pool.dtype), y_gla], axis=2)
    y = jnp.einsum('blnc,ncd->blnd', br, w_branch)
    g = jax.nn.sigmoid(gate_logits.reshape(B, L, N_BRANCH, D_MODEL).astype(f32)).astype(y.dtype)
    return jnp.sum(g * y, axis=2) @ w_out


def gla_qkv(gq, gk, gv, rope):
    q = heads(gq, GLA_HEADS).astype(f32)
    k = heads(gk, GLA_HEADS).astype(f32)
    if rope:
        q, k = axial_rope(q), axial_rope(k)
    return q * (GLA_DK ** -0.5), k, heads(gv, GLA_HEADS).astype(f32)


def context_mixer(h, w_in, pool_w, pool_scale, gla_w_gate, gla_b_gate, gla_norm, w_branch, w_out):
    B, L, _ = h.shape
    u, nq, nk, nv, gq, gk, gv, gz, gr, gl = split_in(h, w_in)
    y_pool = pool_mix(u, pool_w, pool_scale)
    nq, nk, nv = heads(nq, NA_HEADS), heads(nk, NA_HEADS), heads(nv, NA_HEADS)
    y_na = merge_heads(context_attention(nq, nk, nv))
    q, k, v = gla_qkv(gq, gk, gv, rope=False)
    s0 = jnp.zeros((B, 2, GLA_HEADS, GLA_DK, GLA_DV), f32)
    o, s_fin = gla_bidir(q, k, v, gz.reshape(B, L, 2, GLA_RANK).astype(f32), gla_w_gate, gla_b_gate, s0)
    y_gla = gla_out(o, gla_norm, gr)
    return merge_branches(y_pool, y_na, y_gla, gl, w_branch, w_out), (nk, nv, s_fin)


def latent_mixer(h, ck, cv, s_ctx, w_in, pool_w, pool_scale, na_rpb, gla_w_gate, gla_b_gate, gla_norm, w_branch, w_out):
    B, L, _ = h.shape
    u, nq, nk, nv, gq, gk, gv, gz, gr, gl = split_in(h, w_in)
    y_pool = pool_mix(u, pool_w, pool_scale)
    nq, nk, nv = heads(nq, NA_HEADS), heads(nk, NA_HEADS), heads(nv, NA_HEADS)
    y_na = merge_heads(na_latent(nq, nk, nv, ck, cv, na_rpb))
    q, k, v = gla_qkv(gq, gk, gv, rope=True)
    o, _ = gla_bidir(q, k, v, gz.reshape(B, L, 2, GLA_RANK).astype(f32), gla_w_gate, gla_b_gate, s_ctx)
    y_gla = gla_out(o, gla_norm, gr)
    return merge_branches(y_pool, y_na, y_gla, gl, w_branch, w_out), None


def trunk_layer(x, mod, pre, post, ffn_in, ffn_out, mixer_fn):
    m = lambda i: (mod[:, None, 3 * i], mod[:, None, 3 * i + 1], mod[:, None, 3 * i + 2])
    sh, sc, gt = m(0)
    y = swiglu(modulate(rmsnorm(x, pre[0]), sh, sc), ffn_in[0], ffn_out[0])
    x = x + FFN_RES * gt * rmsnorm(y, post[0])
    sh, sc, gt = m(1)
    y, aux = mixer_fn(modulate(rmsnorm(x, pre[1]), sh, sc))
    x = x + gt * rmsnorm(y, post[1])
    sh, sc, gt = m(2)
    y = swiglu(modulate(rmsnorm(x, pre[2]), sh, sc), ffn_in[1], ffn_out[1])
    x = x + FFN_RES * gt * rmsnorm(y, post[2])
    return x, aux


def setup_inputs(seed: int = 0) -> dict:
    key = jax.random.key(seed)
    ks = jax.random.split(key, 24)
    nrm = lambda i, shape, s=1.0: jax.random.normal(ks[i], shape, f32) * s
    D = D_MODEL
    return {
        'x_prompt': nrm(0, (BATCH, SEQ, D)),
        'x_sample': nrm(1, (DEC_BATCH, DEC_SEQ, D)),
        'c': nrm(2, (DEC_BATCH, D)),
        'cache_na_k': nrm(3, (DEC_BATCH, DEPTH, NA_HEADS, PAST_LEN, NA_HEAD_DIM)),
        'cache_na_v': nrm(4, (DEC_BATCH, DEPTH, NA_HEADS, PAST_LEN, NA_HEAD_DIM)),
        'state_gla': nrm(5, (DEC_BATCH, DEPTH, 2, GLA_HEADS, GLA_DK, GLA_DV)),
        'c_ctx': nrm(6, (D,)),
        'w_mod': nrm(7, (DEPTH, D, N_MOD * D), D ** -0.5),
        'b_mod': nrm(8, (DEPTH, N_MOD * D), 0.01),
        'norm_pre': 1.0 + nrm(9, (DEPTH, 3, D), 0.05),
        'norm_post': 1.0 + nrm(10, (DEPTH, 3, D), 0.05),
        'w_ffn_in': nrm(11, (DEPTH, 2, D, 2 * D_FF), D ** -0.5),
        'w_ffn_out': nrm(12, (DEPTH, 2, D_FF, D), D_FF ** -0.5),
        'w_in': nrm(13, (DEPTH, D, IN_COLS), D ** -0.5),
        'pool_w': nrm(14, (DEPTH, POOL_GROUPS, POOL_GC, POOL_GC), POOL_GC ** -0.5),
        'pool_scale': 1.0 + nrm(15, (DEPTH, POOL_WIDTH), 0.1),
        'na_rpb': nrm(16, (DEPTH, NA_HEADS, 2 * NA_WIN_H - 1, 2 * NA_WIN_W - 1), 0.1),
        'gla_w_gate': nrm(17, (DEPTH, 2, GLA_RANK, GLA_KW), GLA_RANK ** -0.5),
        'gla_b_gate': nrm(18, (DEPTH, 2, GLA_KW), 0.1),
        'gla_norm': 1.0 + nrm(19, (DEPTH, GLA_VW), 0.05),
        'w_branch': nrm(20, (DEPTH, N_BRANCH, BRANCH_W, D), BRANCH_W ** -0.5),
        'w_out': nrm(21, (DEPTH, D, D), D ** -0.5),
    }


def reference(x_prompt, x_sample, c, cache_na_k, cache_na_v, state_gla, c_ctx, w_mod, b_mod, norm_pre,
              norm_post, w_ffn_in, w_ffn_out, w_in, pool_w, pool_scale, na_rpb, gla_w_gate, gla_b_gate,
              gla_norm, w_branch, w_out):
    xp = x_prompt
    new_k, new_v, new_s = [], [], []
    for l in range(DEPTH):
        mod = (jax.nn.silu(c_ctx)[None] @ w_mod[l] + b_mod[l]).reshape(1, N_MOD, D_MODEL)
        mixer = functools.partial(context_mixer, w_in=w_in[l], pool_w=pool_w[l], pool_scale=pool_scale[l],
                                  gla_w_gate=gla_w_gate[l], gla_b_gate=gla_b_gate[l], gla_norm=gla_norm[l],
                                  w_branch=w_branch[l], w_out=w_out[l])
        xp, (k_l, v_l, s_l) = trunk_layer(xp, mod, norm_pre[l], norm_post[l], w_ffn_in[l], w_ffn_out[l], mixer)
        new_k.append(k_l)
        new_v.append(v_l)
        new_s.append(s_l)
    new_na_k = jnp.stack(new_k, axis=1)
    new_na_v = jnp.stack(new_v, axis=1)
    new_state_gla = jnp.stack(new_s, axis=1)

    xs = x_sample
    for l in range(DEPTH):
        mod = (jax.nn.silu(c) @ w_mod[l] + b_mod[l]).reshape(-1, N_MOD, D_MODEL)
        mixer = functools.partial(latent_mixer, ck=cache_na_k[:, l], cv=cache_na_v[:, l], s_ctx=state_gla[:, l],
                                  w_in=w_in[l], pool_w=pool_w[l], pool_scale=pool_scale[l], na_rpb=na_rpb[l],
                                  gla_w_gate=gla_w_gate[l], gla_b_gate=gla_b_gate[l], gla_norm=gla_norm[l],
                                  w_branch=w_branch[l], w_out=w_out[l])
        xs, _ = trunk_layer(xs, mod, norm_pre[l], norm_post[l], w_ffn_in[l], w_ffn_out[l], mixer)

    return (xp, xs, new_na_k, new_na_v, new_state_gla)
```

```cpp
#include <hip/hip_runtime.h>
#include <cstdio>
#include <cstdint>

namespace pg8 {
#define PG8_LAS __attribute__((address_space(3)))
typedef unsigned short bf16_t;
typedef short bf16x8 __attribute__((ext_vector_type(8)));
typedef float f32x4 __attribute__((ext_vector_type(4)));
typedef unsigned u32x4 __attribute__((ext_vector_type(4)));
typedef unsigned u32x2 __attribute__((ext_vector_type(2)));
constexpr int BM = 256, BK = 64, HALF = 128, HTB = HALF * BK * 2, STAGE_BYTES = 8 * HTB, NXCD = 8, WGM = 8;

__host__ __device__ __forceinline__ int lds_byte(int r, int c) { const int st = (r >> 4) * 2 + (c >> 5), rr = r & 15, cc = c & 31, ob = rr * 64 + cc * 2; return st * 1024 + (ob ^ (((ob >> 9) & 1) << 5)); }
__host__ __device__ __forceinline__ void stage_rc(int b, int& R, int& C) { const int st = b / 1024, sb = b % 1024, swz = sb ^ (((sb >> 9) & 1) << 5); R = (st >> 1) * 16 + swz / 64; C = (st & 1) * 32 + (swz % 64) / 2; }
__host__ __device__ __forceinline__ int perm32(int rho) { const int n = rho >> 4, i = rho & 15; return 8 * (i >> 2) + 4 * n + (i & 3); }

struct Unit { int pm, pn, z; };
struct Gemm { const bf16_t* A; const bf16_t* Bt; int lda, ldb; size_t zA, zB; int K0, K1; unsigned* dummy; };

struct ZOrder {
    static constexpr bool CUSTOM_NT = false;
    int nM, nN, nZ, ntile, G, c, zinner;
    __device__ void init(int nM_, int nN_, int nZ_, int G_, int c_, int zinner_) { nM = nM_; nN = nN_; nZ = nZ_; ntile = nM_ * nN_; G = G_; c = c_; zinner = zinner_; }
    __device__ void map(int wgid, Unit& u) const {
        { const int q = ntile / NXCD, r = ntile % NXCD, xcd = wgid % NXCD, off = wgid / NXCD; wgid = (xcd < r ? xcd * (q + 1) : r * (q + 1) + (xcd - r) * q) + off; }
        const int nig = WGM * nN, gid = wgid / nig, fm = gid * WGM, gsz = (nM - fm) < WGM ? (nM - fm) : WGM;
        u.pm = fm + ((wgid % nig) % gsz); u.pn = (wgid % nig) / gsz;
    }
    __device__ bool next(int i, Unit& u) const {
        long L; int z;
        if (zinner) { const int ti = i / nZ; z = i - ti * nZ; L = (long)ti * G + c; if (L >= ntile) return false; }
        else { L = (long)i * G + c; if (L >= (long)ntile * nZ) return false; z = (int)(L / ntile); L -= (long)z * ntile; }
        int wgid = (int)L; { const int q = ntile / NXCD, r = ntile % NXCD, xcd = wgid % NXCD, off = wgid / NXCD; wgid = (xcd < r ? xcd * (q + 1) : r * (q + 1) + (xcd - r) * q) + off; }
        const int nig = WGM * nN, gid = wgid / nig, fm = gid * WGM, gsz = (nM - fm) < WGM ? (nM - fm) : WGM;
        u.pm = fm + ((wgid % nig) % gsz); u.pn = (wgid % nig) / gsz; u.z = z; return true;
    }
};

struct MergeOrder {
    static constexpr bool CUSTOM_NT = false;
    ZOrder Z; int G, c, n1;
    __device__ void init(int G_, int c_) { G = G_; c = c_; Z.init(48, 8, 3, G_, c_, 1); const int r = 384 - G_; n1 = (r > 0 && 2 * r <= G_) ? r : 0; }
    __device__ bool next(int i, Unit& u) const {
        bool ok;
        if (n1 == 0 || i < 3) ok = Z.next(i, u);
        else if (c < n1) { ok = i < 5; Z.map(G + c, u); u.z = i - 3; }
        else if (c < 2 * n1) { ok = i < 4; Z.map(G + c - n1, u); u.z = 2; }
        else ok = false;
        u.pm = __builtin_amdgcn_readfirstlane(u.pm); u.pn = __builtin_amdgcn_readfirstlane(u.pn); u.z = __builtin_amdgcn_readfirstlane(u.z);
        return ok;
    }
};

struct SplitKOrder {
    static constexpr bool CUSTOM_NT = true;
    ZOrder Z; int G, c, n1, pm2, pn2, ntf, nt0, nt1;
    __device__ void init(int G_, int c_, int Kfull, int K0h) { G = G_; c = c_; Z.init(48, 8, 1, G_, c_, 0); const int r = 384 - G_; n1 = (r > 0 && 2 * r <= G_) ? r : 0; ntf = Kfull / BK; nt0 = K0h / BK; nt1 = (Kfull - K0h) / BK;
        Unit u2; u2.pm = -1; u2.pn = -1; if (n1 > 0 && c_ < 2 * n1) Z.map(G_ + (c_ < n1 ? c_ : c_ - n1), u2); pm2 = __builtin_amdgcn_readfirstlane(u2.pm); pn2 = __builtin_amdgcn_readfirstlane(u2.pn); }
    __device__ bool next(int i, Unit& u) const {
        bool ok;
        if (n1 == 0) { const int L = i * G + c; ok = L < 384; if (ok) Z.map(L, u); u.z = 0; }
        else if (i == 0) { ok = c < 384; Z.map(c < 384 ? c : 0, u); u.z = 0; }
        else if (i == 1 && c < n1) { ok = true; Z.map(G + c, u); u.z = 0; }
        else if (i == 1 && c < 2 * n1) { ok = true; Z.map(G + c - n1, u); u.z = 1; }
        else ok = false;
        u.pm = __builtin_amdgcn_readfirstlane(u.pm); u.pn = __builtin_amdgcn_readfirstlane(u.pn); u.z = __builtin_amdgcn_readfirstlane(u.z);
        return ok;
    }
    __device__ int nt(const Unit& u) const { const int z1 = (u.z == 1) ? 1 : 0, sp = (u.pm == pm2 && u.pn == pn2) ? 1 : 0; return z1 * nt1 + (1 - z1) * (sp * nt0 + (1 - sp) * ntf); }
};

struct FfnOrder {
    static constexpr bool CUSTOM_NT = false;
    ZOrder Z; int G, c, pre;
    __device__ void init(int G_, int c_, int pre_) { G = G_; c = c_; pre = pre_; Z.init(48, 42, 1, G_, c_, 0); }
    __device__ bool next(int i, Unit& u) const {
        if (pre) { if (i > 0 || c >= 16) return false; u.pm = c; u.pn = 42; u.z = 0; return true; }
        const long L = (long)i * G + c;
        if (L < 2016) return Z.next(i, u);
        if (L >= 2048) return false;
        u.pm = 16 + (int)(L - 2016); u.pn = 42; u.z = 0; return true;
    }
};

struct FfnPreOrder {
    static constexpr bool CUSTOM_NT = true;
    int c, split, ntk;
    __device__ void init(int G_, int c_, int K) { c = c_; split = G_ >= 64 ? 1 : 0; ntk = K / BK; }
    __device__ int nblk() const { return split ? 32 : 16; }
    __device__ bool next(int i, Unit& u) const { if (i > 0 || c >= nblk()) return false; u.pm = c & 15; u.pn = 42; u.z = c >> 4; return true; }
    __device__ int nt(const Unit&) const { return split ? ntk / 2 : ntk; }
};

__device__ __forceinline__ unsigned cvt_pk_bf16(float lo, float hi) { unsigned r; asm volatile("v_cvt_pk_bf16_f32 %0, %1, %2" : "=v"(r) : "v"(lo), "v"(hi)); return r; }

template <class Epi, class Sched>
__device__ __forceinline__ void gemm_phase(PG8_LAS unsigned char* lds, const Gemm g, const Sched& S, const Epi& E, const int tid) {
    const int wid = __builtin_amdgcn_readfirstlane(tid >> 6), lane = tid & 63, wr = wid >> 2, wc = wid & 3, fr = lane & 15, fq = lane >> 4;
    unsigned voffA[2], voffB[2];
#pragma unroll
    for (int i = 0; i < 2; ++i) { int R, C; stage_rc(tid * 16 + i * 8192, R, C); const int Rb = Epi::PERM ? ((R & ~31) + perm32(R & 31)) : R;
        voffA[i] = (unsigned)(R * g.lda + C) * 2u; voffB[i] = (unsigned)(Rb * g.ldb + C) * 2u; }
    const size_t kstep = (size_t)(BK * 2);
    const size_t hA = (size_t)HALF * g.lda * 2, hB = (size_t)HALF * g.ldb * 2;
    const unsigned ldsw = (unsigned)wid * 1024u;
    const int aoff = lds_byte(wr * 64 + fr, fq * 8), boff = lds_byte(wc * 32 + fr, fq * 8);
#define PG8_SA(b, h) (((b) * 2 + (h)) * HTB)
#define PG8_SB(b, h) ((4 + (b) * 2 + (h)) * HTB)
#define PG8_STAGE(bufoff, gbase, voff) do { _Pragma("unroll") for (int _i = 0; _i < 2; ++_i) \
        __builtin_amdgcn_global_load_lds((const unsigned*)((const char*)(gbase) + (voff)[_i]), (PG8_LAS unsigned*)(lds + (bufoff) + ldsw + _i * 8192), 16, 0, 0); } while (0)
#define PG8_LDA(dst, b, h) do { _Pragma("unroll") for (int m = 0; m < 4; ++m) _Pragma("unroll") for (int k = 0; k < 2; ++k) dst[m][k] = *(const PG8_LAS bf16x8*)(lds + PG8_SA(b, h) + aoff + m * 2048 + k * 1024); } while (0)
#define PG8_LDB(dst, b, h) do { _Pragma("unroll") for (int n = 0; n < 2; ++n) _Pragma("unroll") for (int k = 0; k < 2; ++k) dst[n][k] = *(const PG8_LAS bf16x8*)(lds + PG8_SB(b, h) + boff + n * 2048 + k * 1024); } while (0)
#define PG8_MMA(ai, bj, At, Bt) do { __builtin_amdgcn_s_setprio(1); _Pragma("unroll") for (int m = 0; m < 4; ++m) _Pragma("unroll") for (int n = 0; n < 2; ++n) _Pragma("unroll") for (int k = 0; k < 2; ++k) \
        acc[ai][bj][m][n] = __builtin_amdgcn_mfma_f32_16x16x32_bf16(Bt[n][k], At[m][k], acc[ai][bj][m][n], 0, 0, 0); __builtin_amdgcn_s_setprio(0); } while (0)
#define PG8_WAIT_V(n) asm volatile("s_waitcnt vmcnt(" #n ")" ::: "memory")
#define PG8_WAIT_VN(n) asm volatile("s_waitcnt vmcnt(%0)" :: "n"(n) : "memory")
#define PG8_WAIT_L(n) asm volatile("s_waitcnt lgkmcnt(" #n ")" ::: "memory")
#define PG8_BAR __builtin_amdgcn_s_barrier()
#define PG8_SCHED __builtin_amdgcn_sched_barrier(0)
#define PG8_ABASE(u) ((const char*)g.A + ((size_t)(u).z * g.zA) * 2 + (size_t)(u).pm * 2 * hA)
#define PG8_BBASE(u) ((const char*)g.Bt + ((size_t)(u).z * g.zB) * 2 + (size_t)(u).pn * 2 * hB)
    Unit cur, nxt; int ui = 0;
    if (!S.next(0, cur)) return;
    f32x4 acc[2][2][4][2];
#pragma unroll
    for (int a = 0; a < 2; ++a)
#pragma unroll
        for (int b = 0; b < 2; ++b)
#pragma unroll
            for (int m = 0; m < 4; ++m)
#pragma unroll
                for (int n = 0; n < 2; ++n) acc[a][b][m][n] = (f32x4){0.f, 0.f, 0.f, 0.f};
    bf16x8 At[4][2], B0[2][2], B1[2][2];
    const char* cA = PG8_ABASE(cur); const char* cB = PG8_BBASE(cur);
    int nt; if constexpr (Sched::CUSTOM_NT) nt = S.nt(cur); else nt = (cur.z == 0 ? g.K0 : g.K1) / BK;
    PG8_STAGE(PG8_SB(0, 0), cB, voffB); PG8_STAGE(PG8_SB(0, 1), cB + hB, voffB); PG8_STAGE(PG8_SA(0, 0), cA, voffA); PG8_STAGE(PG8_SA(0, 1), cA + hA, voffA);
    if (wr == 1) PG8_BAR;
    PG8_WAIT_V(2); PG8_BAR;
    PG8_STAGE(PG8_SB(1, 0), cB + kstep, voffB); PG8_STAGE(PG8_SA(1, 0), cA + kstep, voffA); PG8_STAGE(PG8_SB(1, 1), cB + hB + kstep, voffB);
    PG8_WAIT_V(6); PG8_BAR;
    if (Epi::NSTORE > 0) { unsigned* dp = g.dummy + blockIdx.x * 512 + tid;
#pragma unroll
        for (int i = 0; i < Epi::NSTORE; ++i) asm volatile("global_store_dword %0, %1, off" :: "v"(dp), "v"(i) : "memory"); }
    for (;;) {
        const bool has_next = S.next(ui + 1, nxt);
        const char* nA = has_next ? PG8_ABASE(nxt) : cA; const char* nB = has_next ? PG8_BBASE(nxt) : cB;
#define PG8_KBODY(WV) do { \
              \
            PG8_LDB(B0, 0, 0); PG8_LDB(B1, 0, 1); PG8_SCHED; PG8_LDA(At, 0, 0); PG8_STAGE(PG8_SA(1, 1), a1 + hA, voffA); \
            PG8_WAIT_VN(WV); PG8_WAIT_L(0); PG8_BAR; PG8_MMA(0, 0, At, B0); PG8_MMA(0, 1, At, B1); PG8_BAR; PG8_SCHED; \
              \
            PG8_LDA(At, 0, 1); PG8_STAGE(PG8_SB(0, 0), b2, voffB); PG8_STAGE(PG8_SB(0, 1), b2 + hB, voffB); PG8_STAGE(PG8_SA(0, 0), a2, voffA); \
            PG8_WAIT_VN(WV); PG8_WAIT_L(0); PG8_BAR; PG8_MMA(1, 0, At, B0); PG8_MMA(1, 1, At, B1); PG8_BAR; PG8_SCHED; \
              \
            PG8_LDB(B0, 1, 0); PG8_LDB(B1, 1, 1); PG8_SCHED; PG8_LDA(At, 1, 0); PG8_STAGE(PG8_SA(0, 1), a2 + hA, voffA); \
            PG8_WAIT_VN(WV); PG8_WAIT_L(0); PG8_BAR; PG8_MMA(0, 0, At, B0); PG8_MMA(0, 1, At, B1); PG8_BAR; PG8_SCHED; \
              \
            PG8_LDA(At, 1, 1); PG8_STAGE(PG8_SB(1, 0), b3, voffB); PG8_STAGE(PG8_SB(1, 1), b3 + hB, voffB); PG8_STAGE(PG8_SA(1, 0), a3, voffA); \
            PG8_WAIT_VN(WV); PG8_WAIT_L(0); PG8_BAR; PG8_MMA(1, 0, At, B0); PG8_MMA(1, 1, At, B1); PG8_BAR; PG8_SCHED; } while (0)
        int t = 0;
        if (Epi::NSTORE > 0) {
            const char* a1 = cA + kstep; const char* a2 = cA + 2 * kstep; const char* b2 = cB + 2 * kstep; const char* a3 = a2 + kstep; const char* b3 = b2 + kstep;
            PG8_KBODY(8 + Epi::NSTORE); t = 2;
        }
        for (; t < nt; t += 2) {
            const bool last = (t == nt - 2);
            const char* a1 = cA + (size_t)(t + 1) * kstep;
            const char* a2 = last ? nA : cA + (size_t)(t + 2) * kstep; const char* b2 = last ? nB : cB + (size_t)(t + 2) * kstep;
            const char* a3 = a2 + kstep; const char* b3 = b2 + kstep;
            PG8_KBODY(8);
        }
#undef PG8_KBODY
        if (wr == 0) PG8_BAR;
        {
            unsigned zz_ = 0u; asm volatile("" : "+v"(zz_)); const int ln_ = (int)__builtin_amdgcn_mbcnt_hi(~0u, __builtin_amdgcn_mbcnt_lo(~0u, zz_));
            E(acc, cur, wr, wc, ln_ & 15, ln_ >> 4);
        }
        if (!has_next) break;
#pragma unroll
        for (int a = 0; a < 2; ++a)
#pragma unroll
            for (int b = 0; b < 2; ++b)
#pragma unroll
                for (int m = 0; m < 4; ++m)
#pragma unroll
                    for (int n = 0; n < 2; ++n) acc[a][b][m][n] = (f32x4){0.f, 0.f, 0.f, 0.f};
        cur = nxt; cA = nA; cB = nB; ++ui; if constexpr (Sched::CUSTOM_NT) nt = S.nt(cur); else nt = (cur.z == 0 ? g.K0 : g.K1) / BK;
        if (wr == 1) PG8_BAR;
    }
    PG8_WAIT_V(0);
    PG8_BAR;
#undef PG8_SA
#undef PG8_SB
#undef PG8_STAGE
#undef PG8_LDA
#undef PG8_LDB
#undef PG8_MMA
#undef PG8_WAIT_V
#undef PG8_WAIT_VN
#undef PG8_WAIT_L
#undef PG8_BAR
#undef PG8_SCHED
#undef PG8_ABASE
#undef PG8_BBASE
}
}

constexpr int DM = 2048, MCTX = 4096, MLAT = 8192, MTOK = 12288;
constexpr int FF = 5504, FF2 = 11008, INC = 13344, INP = 13568;
constexpr int NMOD = 9;
constexpr float EPS = 1e-6f;
constexpr int NWAVES = 8, NTHR = 512;

constexpr size_t MiB = 1u << 20;
constexpr size_t WS_CTL = 0, CTL_ZERO_BYTES = 65536;
constexpr size_t WS_MOD = 1 * MiB;
constexpr size_t WS_ROPE = 1 * MiB + 768 * 1024;
constexpr size_t WS_WFI = 2 * MiB;
constexpr size_t WS_WFO = 174 * MiB;
constexpr size_t WS_WIN = 260 * MiB;
constexpr size_t WS_WBR = 366 * MiB;
constexpr size_t WS_WOUT = 390 * MiB;
constexpr size_t WS_WPOOL = 406 * MiB;
constexpr size_t WS_H = 408 * MiB;
constexpr size_t WS_A = 456 * MiB;
constexpr size_t WS_B = 776 * MiB;
constexpr size_t WS_PL = 968 * MiB;
constexpr size_t WS_BR = 992 * MiB;
constexpr size_t WS_MG = 1064 * MiB;
constexpr size_t WS_CKB = 1112 * MiB;
constexpr size_t WS_CVT = 1120 * MiB;
constexpr size_t WS_QI = 1128 * MiB;
constexpr size_t WS_KI = 1152 * MiB;
constexpr size_t WS_KDT = 1176 * MiB;
constexpr size_t WS_DEC = 1200 * MiB;
constexpr size_t WS_PT = 1202 * MiB;
constexpr size_t WS_END = 1216 * MiB;
constexpr size_t PA_U = 0, PA_NQ = 24 * MiB, PA_NK = 48 * MiB, PA_NV = 72 * MiB, PA_GV = 96 * MiB, PA_GR = 120 * MiB, PA_GQ = 144 * MiB, PA_GK = 156 * MiB, PA_GL = 168 * MiB, PA_GZ = 312 * MiB;

constexpr int CW_MFLAG = 8192;
constexpr int CW_BAR = 4096;
constexpr int RING_BYTES = 131072;
constexpr int LDSCTL_OFF = RING_BYTES, MISC_OFF = LDSCTL_OFF + 320;
constexpr int LDS_BYTES = 155648, TS_OFF = RING_BYTES + 1024, TS_WAVE = 2688;

constexpr int NPH = 34;
#define REP_MIX1 1
#define REP_GEMM 1
#define REP_PRO 1
#define REP_SCAN 1
#define REP_ATT 1
#define REP_FFI 1
#define REP_INP 1
#define REP_FFO 1
#ifndef MK_PER_PHASE
#define MK_PER_PHASE 0
#endif

#define GAS __attribute__((address_space(1)))
#define LAS __attribute__((address_space(3)))
typedef unsigned short bf16;
typedef unsigned v4u __attribute__((ext_vector_type(4)));
typedef unsigned v2u __attribute__((ext_vector_type(2)));
typedef float f32x4 __attribute__((ext_vector_type(4)));
typedef float f32x2 __attribute__((ext_vector_type(2)));
typedef GAS unsigned gu32;
#define RLX_AGENT __ATOMIC_RELAXED, __HIP_MEMORY_SCOPE_AGENT
#define LDS_WAIT() asm volatile("s_waitcnt lgkmcnt(0)" ::: "memory")
__device__ __forceinline__ unsigned f2bf(float f) { unsigned u = __builtin_bit_cast(unsigned, f); return (u + 0x7fffu + ((u >> 16) & 1u)) >> 16; }
__device__ __forceinline__ unsigned pk2(float lo, float hi) { return f2bf(lo) | (f2bf(hi) << 16); }
__device__ __forceinline__ float bflo(unsigned w) { return __builtin_bit_cast(float, w << 16); }
__device__ __forceinline__ float bfhi(unsigned w) { return __builtin_bit_cast(float, w & 0xffff0000u); }
__device__ __forceinline__ float bf2f(bf16 b) { return __builtin_bit_cast(float, ((unsigned)b) << 16); }
__device__ __forceinline__ float sigmoid_f(float x) { return __builtin_amdgcn_rcpf(1.f + __builtin_amdgcn_exp2f(x * -1.4426950408889634f)); }
__device__ __forceinline__ float silu_f(float x) { return x * sigmoid_f(x); }
__device__ __forceinline__ f32x4 sigmoid4(f32x4 x) { const f32x4 t = x * -1.4426950408889634f; f32x4 e; e.x = __builtin_amdgcn_exp2f(t.x); e.y = __builtin_amdgcn_exp2f(t.y); e.z = __builtin_amdgcn_exp2f(t.z); e.w = __builtin_amdgcn_exp2f(t.w);
    const f32x4 d = e + 1.0f; f32x4 r; r.x = __builtin_amdgcn_rcpf(d.x); r.y = __builtin_amdgcn_rcpf(d.y); r.z = __builtin_amdgcn_rcpf(d.z); r.w = __builtin_amdgcn_rcpf(d.w); return r; }

#define XB_TMO      128
#define XB_XCNT(j)  (256  + 64 * (j))
#define XB_XSUB(j)  (1280 + 64 * (j))
#define XB_XGEN(j)  (2304 + 64 * (j))
#define XB_TOP      3328
#define XB_TOPGEN   3392
#define XCD_BAR_WORDS 3456
#define XB_SPIN_CAP (1u << 18)
__device__ __forceinline__ unsigned xb_ld(unsigned* p)              { return __hip_atomic_load(p, __ATOMIC_RELAXED, __HIP_MEMORY_SCOPE_AGENT); }
__device__ __forceinline__ unsigned xb_add(unsigned* p, unsigned v) { return __hip_atomic_fetch_add(p, v, __ATOMIC_RELAXED, __HIP_MEMORY_SCOPE_AGENT); }
__device__ __forceinline__ unsigned xb_xcc_id() { return (unsigned)__builtin_amdgcn_s_getreg((3 << 11) | 20) & 0xFu; }
#define XB_SPIN(cond, bar) do { unsigned _sp = 0; while (cond) { __builtin_amdgcn_s_sleep(1); \
    if ((++_sp & 255u) == 0u) { if (xb_ld(&(bar)[XB_TMO])) break; if (_sp > XB_SPIN_CAP) { atomicAdd(&(bar)[XB_TMO], 1u); break; } } } } while (0)
struct XcdBarrier { unsigned* bar; unsigned x; volatile LAS unsigned* st; };
__device__ __forceinline__ XcdBarrier xcd_barrier_post(unsigned* bar, volatile LAS unsigned* st) {
    XcdBarrier b; b.bar = bar; b.x = (unsigned)__builtin_amdgcn_readfirstlane((int)xb_xcc_id()); b.st = st;
    if (threadIdx.x == 0) (void)xb_add(&bar[XB_XCNT(b.x)], 1u);
    return b;
}
__device__ __forceinline__ void xcd_barrier_complete(unsigned* bar, unsigned x, unsigned& nloc, unsigned& nx) {
    const unsigned G = gridDim.x * gridDim.y * gridDim.z;
    unsigned sum, cnt, mine, sp = 0u;
    for (;;) {
        sum = 0u; cnt = 0u;
#pragma unroll 1
        for (unsigned j = 0; j < 16; ++j) { const unsigned c = xb_ld(&bar[XB_XCNT(j)]); sum += c; cnt += (c > 0u) ? 1u : 0u; }
        if (sum == G) break;
        __builtin_amdgcn_s_sleep(1);
        if ((++sp & 255u) == 0u) { if (xb_ld(&bar[XB_TMO])) break; if (sp > XB_SPIN_CAP) { atomicAdd(&bar[XB_TMO], 1u); break; } }
    }
    mine = xb_ld(&bar[XB_XCNT(x)]);
    nloc = mine > 0u ? mine : 1u; nx = cnt > 0u ? cnt : 1u;
}
static __device__ __forceinline__ void xcd_barrier_impl(unsigned* bar_, unsigned x_, volatile LAS unsigned* st_, int tid_) {
    XcdBarrier b; b.bar = bar_; b.x = x_; b.st = st_;
    asm volatile("s_waitcnt vmcnt(0)" ::: "memory");
    __syncthreads();
    if (tid_ == 0) {
        unsigned* bar = b.bar;
        __builtin_amdgcn_s_waitcnt(0);
        unsigned nloc = b.st[0], nx = b.st[1];
        if (nloc == 0u) { xcd_barrier_complete(bar, b.x, nloc, nx); b.st[0] = nloc; b.st[1] = nx; }
        const unsigned old = xb_add(&bar[XB_XSUB(b.x)], 1u);
        const unsigned gen = old / nloc;
        if (old + 1u == (gen + 1u) * nloc) {
            __builtin_amdgcn_fence(__ATOMIC_RELEASE, "agent");
            asm volatile("s_waitcnt vmcnt(0)" ::: "memory");
            const unsigned og = xb_add(&bar[XB_TOP], 1u);
            const unsigned tg = og / nx;
            if (og + 1u == (tg + 1u) * nx) xb_add(&bar[XB_TOPGEN], 1u);
            else XB_SPIN(xb_ld(&bar[XB_TOPGEN]) == tg, bar);
            xb_add(&bar[XB_XGEN(b.x)], 1u);
            __builtin_amdgcn_fence(__ATOMIC_ACQUIRE, "agent");
            asm volatile("s_waitcnt vmcnt(0)" ::: "memory");
        } else {
            XB_SPIN(xb_ld(&bar[XB_XGEN(b.x)]) == gen, bar);
            __builtin_amdgcn_fence(__ATOMIC_ACQUIRE, "agent");
            asm volatile("s_waitcnt vmcnt(0)" ::: "memory");
        }
    }
    __syncthreads();
}

using pg8::Unit; using pg8::cvt_pk_bf16;
struct EpiSwiGLU {
    static constexpr bool PERM = true; static constexpr int NSTORE = 8;
    bf16* ACT;
    __device__ __forceinline__ void operator()(const f32x4 (&acc)[2][2][4][2], const Unit& u, int wr, int wc, int fr, int fq) const {
        const int row0 = u.pm * 256 + wr * 64 + fr, col0 = u.pn * 128 + wc * 32 + 8 * fq;
#pragma unroll
        for (int ai = 0; ai < 2; ++ai)
#pragma unroll
            for (int m = 0; m < 4; ++m) {
                bf16* rowp = ACT + (size_t)(row0 + ai * 128 + m * 16) * FF + col0;
                const f32x4 v0 = (acc[ai][0][m][0] * acc[ai][1][m][0]) * sigmoid4(acc[ai][0][m][0]), v1 = (acc[ai][0][m][1] * acc[ai][1][m][1]) * sigmoid4(acc[ai][0][m][1]);
                v4u w; w.x = cvt_pk_bf16(v0[0], v0[1]); w.y = cvt_pk_bf16(v0[2], v0[3]); w.z = cvt_pk_bf16(v1[0], v1[1]); w.w = cvt_pk_bf16(v1[2], v1[3]);
                *(v4u*)rowp = w;
            }
    }
};
struct EpiSwiGLUPre {
    static constexpr bool PERM = true; static constexpr int NSTORE = 0;
    bf16* ACT; bf16* P; unsigned* flag; int role;
    __device__ __forceinline__ void operator()(const f32x4 (&acc)[2][2][4][2], const Unit& u, int wr, int wc, int fr, int fq) const {
        const int row0 = u.pm * 256 + wr * 64 + fr, col0 = u.pn * 128 + wc * 32 + 8 * fq;
        const int tidl = (wr * 4 + wc) * 64 + fq * 16 + fr;
        bf16* Pt = P + (size_t)tidl * 8;
        if (role == 2) {
#pragma unroll
            for (int ai = 0; ai < 2; ++ai)
#pragma unroll
                for (int m = 0; m < 4; ++m)
#pragma unroll
                    for (int bj = 0; bj < 2; ++bj) { const f32x4 v0 = acc[ai][bj][m][0], v1 = acc[ai][bj][m][1];
                        v4u w; w.x = cvt_pk_bf16(v0[0], v0[1]); w.y = cvt_pk_bf16(v0[2], v0[3]); w.z = cvt_pk_bf16(v1[0], v1[1]); w.w = cvt_pk_bf16(v1[2], v1[3]);
                        *(v4u*)(Pt + (size_t)(((ai * 4 + m) * 2 + bj) * 512) * 8) = w; }
            asm volatile("s_waitcnt vmcnt(0)" ::: "memory");
            __builtin_amdgcn_s_barrier();
            if (tidl == 0) { __builtin_amdgcn_fence(__ATOMIC_RELEASE, "agent"); asm volatile("s_waitcnt vmcnt(0)" ::: "memory"); __hip_atomic_store(flag, 1u, __ATOMIC_RELAXED, __HIP_MEMORY_SCOPE_AGENT); }
            return;
        }
        if (role == 1) {
            if (tidl == 0) { unsigned sp = 0u; while (__hip_atomic_load(flag, __ATOMIC_RELAXED, __HIP_MEMORY_SCOPE_AGENT) == 0u) { __builtin_amdgcn_s_sleep(2); if (++sp > (1u << 26)) break; }
                __builtin_amdgcn_fence(__ATOMIC_ACQUIRE, "agent"); }
            asm volatile("s_waitcnt vmcnt(0) lgkmcnt(0)" ::: "memory");
            __builtin_amdgcn_s_barrier();
        }
#pragma unroll
        for (int ai = 0; ai < 2; ++ai) {
            v4u hw[4][2];
#pragma unroll
            for (int m = 0; m < 4; ++m)
#pragma unroll
                for (int bj = 0; bj < 2; ++bj) hw[m][bj] = role == 1 ? *(const v4u*)(Pt + (size_t)(((ai * 4 + m) * 2 + bj) * 512) * 8) : (v4u){0u, 0u, 0u, 0u};
#pragma unroll
            for (int m = 0; m < 4; ++m) {
                bf16* rowp = ACT + (size_t)(row0 + ai * 128 + m * 16) * FF + col0;
                const v4u hg = hw[m][0], hu = hw[m][1];
                f32x4 g0 = acc[ai][0][m][0], g1 = acc[ai][0][m][1], u0 = acc[ai][1][m][0], u1 = acc[ai][1][m][1];
                g0[0] += bflo(hg.x); g0[1] += bfhi(hg.x); g0[2] += bflo(hg.y); g0[3] += bfhi(hg.y); g1[0] += bflo(hg.z); g1[1] += bfhi(hg.z); g1[2] += bflo(hg.w); g1[3] += bfhi(hg.w);
                u0[0] += bflo(hu.x); u0[1] += bfhi(hu.x); u0[2] += bflo(hu.y); u0[3] += bfhi(hu.y); u1[0] += bflo(hu.z); u1[1] += bfhi(hu.z); u1[2] += bflo(hu.w); u1[3] += bfhi(hu.w);
                const f32x4 v0 = (g0 * u0) * sigmoid4(g0), v1 = (g1 * u1) * sigmoid4(g1);
                v4u w; w.x = cvt_pk_bf16(v0[0], v0[1]); w.y = cvt_pk_bf16(v0[2], v0[3]); w.z = cvt_pk_bf16(v1[0], v1[1]); w.w = cvt_pk_bf16(v1[2], v1[3]);
                *(v4u*)rowp = w;
            }
            asm volatile("" ::: "memory");
        }
    }
};
struct EpiY {
    static constexpr bool PERM = true; static constexpr int NSTORE = 16;
    bf16* Y; int ldc; unsigned char* ws; int slot, jt, n1, role, pm2, pn2;
    __device__ __forceinline__ void operator()(const f32x4 (&acc)[2][2][4][2], const Unit& u, int wr, int wc, int fr, int fq) const {
        const int row0 = u.pm * 256 + wr * 64 + fr, col0 = u.pn * 256 + wc * 32 + 8 * fq;
        const int tidl = (wr * 4 + wc) * 64 + fq * 16 + fr;
        const bool split = role != 0 && u.pm == pm2 && u.pn == pn2; const int uf = !split ? 0 : role;
        bf16* P = (bf16*)(ws + WS_B + 64 * MiB) + (size_t)jt * 65536 + (size_t)tidl * 8;
        unsigned* cw = (unsigned*)(ws + WS_CTL) + CW_MFLAG;
        if (uf == 1) {
            if (tidl == 0) { const unsigned hx = __hip_atomic_load(cw + n1 + jt, __ATOMIC_RELAXED, __HIP_MEMORY_SCOPE_AGENT) & 15u; unsigned* xflag = cw + 528 + slot * 16 + hx;
                unsigned sp = 0u; while (__hip_atomic_load(xflag, __ATOMIC_RELAXED, __HIP_MEMORY_SCOPE_AGENT) == 0u) { __builtin_amdgcn_s_sleep(2); if (++sp > (1u << 26)) break; }
                __builtin_amdgcn_fence(__ATOMIC_ACQUIRE, "agent"); }
            asm volatile("s_waitcnt vmcnt(0) lgkmcnt(0)" ::: "memory");
            __builtin_amdgcn_s_barrier();
        }
#pragma unroll
        for (int ai = 0; ai < 2; ++ai) {
            v4u hw[4][2];
#pragma unroll
            for (int m = 0; m < 4; ++m)
#pragma unroll
                for (int bj = 0; bj < 2; ++bj) hw[m][bj] = uf == 1 ? *(const v4u*)(P + (size_t)(((ai * 4 + m) * 2 + bj) * 512) * 8) : (v4u){0u, 0u, 0u, 0u};
#pragma unroll
            for (int m = 0; m < 4; ++m) { bf16* rowp = Y + (size_t)(row0 + ai * 128 + m * 16) * ldc + col0;
#pragma unroll
                for (int bj = 0; bj < 2; ++bj) { f32x4 v0 = acc[ai][bj][m][0], v1 = acc[ai][bj][m][1]; const v4u h = hw[m][bj];
                    v0[0] += bflo(h.x); v0[1] += bfhi(h.x); v0[2] += bflo(h.y); v0[3] += bfhi(h.y); v1[0] += bflo(h.z); v1[1] += bfhi(h.z); v1[2] += bflo(h.w); v1[3] += bfhi(h.w);
                    v4u w; w.x = cvt_pk_bf16(v0[0], v0[1]); w.y = cvt_pk_bf16(v0[2], v0[3]); w.z = cvt_pk_bf16(v1[0], v1[1]); w.w = cvt_pk_bf16(v1[2], v1[3]);
                    if (uf == 2) *(v4u*)(P + (size_t)(((ai * 4 + m) * 2 + bj) * 512) * 8) = w;
                    else *(v4u*)(rowp + bj * 128) = w; } }
            asm volatile("" ::: "memory");
        }
        if (uf == 2) {
            asm volatile("s_waitcnt vmcnt(0)" ::: "memory");
            __builtin_amdgcn_s_barrier();
            if (tidl == 0) {
                const unsigned hx = __hip_atomic_load(cw + n1 + jt, __ATOMIC_RELAXED, __HIP_MEMORY_SCOPE_AGENT) & 15u, hcnt = __hip_atomic_load(cw + 384 + hx, __ATOMIC_RELAXED, __HIP_MEMORY_SCOPE_AGENT);
                const unsigned old = __hip_atomic_fetch_add(cw + 400 + slot * 16 + hx, 1u, __ATOMIC_RELAXED, __HIP_MEMORY_SCOPE_AGENT);
                if (old + 1u == hcnt) { __builtin_amdgcn_fence(__ATOMIC_RELEASE, "agent"); asm volatile("s_waitcnt vmcnt(0)" ::: "memory"); __hip_atomic_store(cw + 528 + slot * 16 + hx, 1u, __ATOMIC_RELAXED, __HIP_MEMORY_SCOPE_AGENT); }
            }
        }
    }
};
struct EpiPool {
    static constexpr bool PERM = true; static constexpr int NSTORE = 0;
    bf16* O; const float* scale;
    __device__ __forceinline__ void operator()(const f32x4 (&acc)[2][2][4][2], const Unit& u, int wr, int wc, int fr, int fq) const {
        const int row0 = u.pm * 256 + wr * 64 + fr, col0 = u.z * 256 + wc * 32 + 8 * fq;
        f32x4 sc[2][2];
#pragma unroll
        for (int bj = 0; bj < 2; ++bj)
#pragma unroll
            for (int n = 0; n < 2; ++n) sc[bj][n] = *(const f32x4*)(scale + col0 + bj * 128 + 4 * n);
#pragma unroll
        for (int ai = 0; ai < 2; ++ai)
#pragma unroll
            for (int m = 0; m < 4; ++m) { bf16* rowp = O + (size_t)(row0 + ai * 128 + m * 16) * 1024 + col0;
#pragma unroll
                for (int bj = 0; bj < 2; ++bj) { const f32x4 v0 = acc[ai][bj][m][0] * sc[bj][0], v1 = acc[ai][bj][m][1] * sc[bj][1];
                    v4u w; w.x = cvt_pk_bf16(v0[0], v0[1]); w.y = cvt_pk_bf16(v0[2], v0[3]); w.z = cvt_pk_bf16(v1[0], v1[1]); w.w = cvt_pk_bf16(v1[2], v1[3]);
                    *(v4u*)(rowp + bj * 128) = w; } }
    }
};
struct EpiMerge {
    static constexpr bool PERM = true; static constexpr int NSTORE = 0;
    const bf16* GL; bf16* MS; bf16* MG; unsigned char* ws; int l, jt, n1, role, pm2, pn2;
    __device__ __forceinline__ void operator()(const f32x4 (&acc)[2][2][4][2], const Unit& u, int wr, int wc, int fr, int fq) const {
        const int row0 = u.pm * 256 + wr * 64 + fr, col0 = u.pn * 256 + wc * 32 + 8 * fq;
        const int tidl = (wr * 4 + wc) * 64 + fq * 16 + fr;
        const bool split = role != 0 && u.pm == pm2 && u.pn == pn2; const int uf = !split ? 0 : (role == 1 ? (u.z == 1 ? 1 : 0) : 2);
        const bool first = (u.z == 0) || (uf == 2), fin = (u.z == 2) && (uf == 0);
        bf16* mst = MS + ((size_t)u.pm * 8 + u.pn) * 65536;
        bf16* MS2 = (bf16*)(ws + WS_B + 64 * MiB) + (size_t)jt * 65536;
        bf16* msd = uf == 2 ? MS2 : mst;
#pragma unroll
        for (int ai = 0; ai < 2; ++ai) {
            v4u gw[4][2], mw[4][2];
#pragma unroll
            for (int m = 0; m < 4; ++m)
#pragma unroll
                for (int bj = 0; bj < 2; ++bj) { const size_t cidx = (size_t)(((ai * 4 + m) * 2 + bj) * 512 + tidl) * 8;
                    gw[m][bj] = *(const v4u*)(GL + ((size_t)u.pm * 24 + u.z * 8 + u.pn) * 65536 + cidx);
                    mw[m][bj] = !first ? *(const v4u*)(mst + cidx) : (v4u){0u, 0u, 0u, 0u}; }
#pragma unroll
            for (int m = 0; m < 4; ++m)
#pragma unroll
                for (int bj = 0; bj < 2; ++bj) { const size_t row = (size_t)(row0 + ai * 128 + m * 16); const int col = col0 + bj * 128; const size_t cidx = (size_t)(((ai * 4 + m) * 2 + bj) * 512 + tidl) * 8;
                    const v4u g = gw[m][bj], q = mw[m][bj];
                    f32x4 v0 = acc[ai][bj][m][0], v1 = acc[ai][bj][m][1];
                    v0[0] = v0[0] * bflo(g.x) + bflo(q.x); v0[1] = v0[1] * bfhi(g.x) + bfhi(q.x); v0[2] = v0[2] * bflo(g.y) + bflo(q.y); v0[3] = v0[3] * bfhi(g.y) + bfhi(q.y);
                    v1[0] = v1[0] * bflo(g.z) + bflo(q.z); v1[1] = v1[1] * bfhi(g.z) + bfhi(q.z); v1[2] = v1[2] * bflo(g.w) + bflo(q.w); v1[3] = v1[3] * bfhi(g.w) + bfhi(q.w);
                    v4u w; w.x = cvt_pk_bf16(v0[0], v0[1]); w.y = cvt_pk_bf16(v0[2], v0[3]); w.z = cvt_pk_bf16(v1[0], v1[1]); w.w = cvt_pk_bf16(v1[2], v1[3]);
                    if (!fin) *(v4u*)(msd + cidx) = w;
                    else *(v4u*)(MG + row * DM + col) = w; }
            asm volatile("" ::: "memory");
        }
        if (uf == 2) {
            asm volatile("s_waitcnt vmcnt(0)" ::: "memory");
            __builtin_amdgcn_s_barrier();
            if (tidl == 0) {
                unsigned* cw = (unsigned*)(ws + WS_CTL) + CW_MFLAG;
                const unsigned hx = __hip_atomic_load(cw + n1 + jt, __ATOMIC_RELAXED, __HIP_MEMORY_SCOPE_AGENT) & 15u, hcnt = __hip_atomic_load(cw + 384 + hx, __ATOMIC_RELAXED, __HIP_MEMORY_SCOPE_AGENT);
                unsigned* done = cw + 400 + l * 16 + hx; unsigned* xflag = cw + 528 + l * 16 + hx;
                const unsigned old = __hip_atomic_fetch_add(done, 1u, __ATOMIC_RELAXED, __HIP_MEMORY_SCOPE_AGENT);
                if (old + 1u == hcnt) { __builtin_amdgcn_fence(__ATOMIC_RELEASE, "agent"); asm volatile("s_waitcnt vmcnt(0)" ::: "memory"); __hip_atomic_store(xflag, 1u, __ATOMIC_RELAXED, __HIP_MEMORY_SCOPE_AGENT); }
            }
        }
        if (uf == 1) {
            if (tidl == 0) { unsigned* cw = (unsigned*)(ws + WS_CTL) + CW_MFLAG; const unsigned hx = __hip_atomic_load(cw + n1 + jt, __ATOMIC_RELAXED, __HIP_MEMORY_SCOPE_AGENT) & 15u; unsigned* xflag = cw + 528 + l * 16 + hx;
                unsigned sp = 0u; while (__hip_atomic_load(xflag, __ATOMIC_RELAXED, __HIP_MEMORY_SCOPE_AGENT) == 0u) { __builtin_amdgcn_s_sleep(2); if (++sp > (1u << 26)) break; }
                __builtin_amdgcn_fence(__ATOMIC_ACQUIRE, "agent"); }
            asm volatile("s_waitcnt vmcnt(0) lgkmcnt(0)" ::: "memory");
            __builtin_amdgcn_s_barrier();
#pragma unroll
            for (int ai = 0; ai < 2; ++ai) {
                v4u mw[4][2], hw[4][2];
#pragma unroll
                for (int m = 0; m < 4; ++m)
#pragma unroll
                    for (int bj = 0; bj < 2; ++bj) { const size_t cidx = (size_t)(((ai * 4 + m) * 2 + bj) * 512 + tidl) * 8; mw[m][bj] = *(const v4u*)(mst + cidx); hw[m][bj] = *(const v4u*)(MS2 + cidx); }
#pragma unroll
                for (int m = 0; m < 4; ++m)
#pragma unroll
                    for (int bj = 0; bj < 2; ++bj) { const size_t row = (size_t)(row0 + ai * 128 + m * 16); const int col = col0 + bj * 128; const v4u q = mw[m][bj], h = hw[m][bj];
                        v4u w; w.x = cvt_pk_bf16(bflo(q.x) + bflo(h.x), bfhi(q.x) + bfhi(h.x)); w.y = cvt_pk_bf16(bflo(q.y) + bflo(h.y), bfhi(q.y) + bfhi(h.y));
                        w.z = cvt_pk_bf16(bflo(q.z) + bflo(h.z), bfhi(q.z) + bfhi(h.z)); w.w = cvt_pk_bf16(bflo(q.w) + bflo(h.w), bfhi(q.w) + bfhi(h.w));
                        *(v4u*)(MG + row * DM + col) = w; }
                asm volatile("" ::: "memory");
            }
        }
    }
};
struct EpiInProj {
    static constexpr bool PERM = true; static constexpr int NSTORE = 0;
    unsigned char* PA; float* outK; float* outV; const f32x2* rope; int l; LAS unsigned char* ts;
    __device__ __forceinline__ void operator()(const f32x4 (&acc)[2][2][4][2], const Unit& u, int wr, int wc, int fr, int fq) const {
        const int pn = u.pn;
        const int rl0 = wr * 64 + fr;
        const int cl = wc * 32 + 8 * fq;
        if (pn >= 16 && pn < 20) {
            const bool isq = pn < 18; const int hp = (pn - 16) & 1;
            bf16* G = (bf16*)(PA + (isq ? PA_GQ : PA_GK));
            const float qs = isq ? 0.08838834764831845f : 1.0f;
            const int head = 2 * hp + (wc >> 1), axis = wc & 1, j0 = 8 * fq;
            const bool lat = u.pm >= 16;
#pragma unroll
            for (int ai = 0; ai < 2; ++ai)
#pragma unroll
                for (int m = 0; m < 4; ++m) {
                    const int row = u.pm * 256 + rl0 + ai * 128 + m * 16;
                    float o1[8], o2[8];
                    int pos = 0;
                    if (lat) { const int t = (row - MCTX) & 2047; pos = axis ? (t & 63) : (t >> 6); }
#pragma unroll
                    for (int n = 0; n < 2; ++n)
#pragma unroll
                        for (int i = 0; i < 4; ++i) {
                            const float x1 = acc[ai][0][m][n][i], x2 = acc[ai][1][m][n][i];
                            float c = 1.f, s = 0.f;
                            if (lat) { const f32x2 cs = rope[pos * 32 + j0 + 4 * n + i]; c = cs.x; s = cs.y; }
                            o1[n * 4 + i] = (x1 * c - x2 * s) * qs; o2[n * 4 + i] = (x2 * c + x1 * s) * qs;
                        }
                    bf16* p1 = G + (size_t)row * 512 + head * 128 + axis * 64 + j0;
                    v4u w; w.x = cvt_pk_bf16(o1[0], o1[1]); w.y = cvt_pk_bf16(o1[2], o1[3]); w.z = cvt_pk_bf16(o1[4], o1[5]); w.w = cvt_pk_bf16(o1[6], o1[7]);
                    *(v4u*)p1 = w;
                    w.x = cvt_pk_bf16(o2[0], o2[1]); w.y = cvt_pk_bf16(o2[2], o2[3]); w.z = cvt_pk_bf16(o2[4], o2[5]); w.w = cvt_pk_bf16(o2[6], o2[7]);
                    *(v4u*)(p1 + 32) = w;
                    asm volatile("" ::: "memory");
                }
            return;
        }
        if (pn == 52) {
            if (wc == 0) {
                float* GZ = (float*)(PA + PA_GZ);
#pragma unroll
                for (int ai = 0; ai < 2; ++ai)
#pragma unroll
                    for (int m = 0; m < 4; ++m) { float* rowp = GZ + (size_t)(u.pm * 256 + rl0 + ai * 128 + m * 16) * 32 + 8 * fq;
                        *(f32x4*)rowp = acc[ai][0][m][0]; *(f32x4*)(rowp + 4) = acc[ai][0][m][1]; }
            }
            return;
        }
        const size_t rowb = (size_t)u.pm * 256 + rl0;
#define IP_LOOP(...) do { _Pragma("unroll") for (int ai = 0; ai < 2; ++ai) _Pragma("unroll") for (int m = 0; m < 4; ++m) { const int rl = rl0 + ai * 128 + m * 16; const size_t row = rowb + ai * 128 + m * 16; (void)rl; \
            _Pragma("unroll") for (int bj = 0; bj < 2; ++bj) { f32x4 v0 = acc[ai][bj][m][0], v1 = acc[ai][bj][m][1]; __VA_ARGS__ } asm volatile("" ::: "memory"); } } while (0)
#define IP_PACK_STORE(ptr) do { v4u w_; w_.x = cvt_pk_bf16(v0[0], v0[1]); w_.y = cvt_pk_bf16(v0[2], v0[3]); w_.z = cvt_pk_bf16(v1[0], v1[1]); w_.w = cvt_pk_bf16(v1[2], v1[3]); __builtin_nontemporal_store(w_, (v4u*)(ptr)); } while (0)
#define IP_F32_COPY(fout, tcol_) do { float* fp_ = (fout) + ((((size_t)u.pm * 2 + l) * 8 + ((tcol_) >> 7) + bj) * 256 + rl) * 128 + cl; __builtin_nontemporal_store(v0, (f32x4*)fp_); __builtin_nontemporal_store(v1, (f32x4*)(fp_ + 4)); } while (0)
#define IP_TRANS_STORE(O_, tcol_) do { bf16* tp_ = (O_) + (size_t)((tcol_) + bj * 128 + cl) * MTOK + row; const unsigned p0_ = cvt_pk_bf16(v0[0], v0[1]), p1_ = cvt_pk_bf16(v0[2], v0[3]), p2_ = cvt_pk_bf16(v1[0], v1[1]), p3_ = cvt_pk_bf16(v1[2], v1[3]); \
            tp_[0] = (bf16)p0_; tp_[(size_t)MTOK] = (bf16)(p0_ >> 16); tp_[(size_t)2 * MTOK] = (bf16)p1_; tp_[(size_t)3 * MTOK] = (bf16)(p1_ >> 16); \
            tp_[(size_t)4 * MTOK] = (bf16)p2_; tp_[(size_t)5 * MTOK] = (bf16)(p2_ >> 16); tp_[(size_t)6 * MTOK] = (bf16)p3_; tp_[(size_t)7 * MTOK] = (bf16)(p3_ >> 16); } while (0)
#define IP_TRANSPOSE(KIND, ...) do { LAS bf16* T_ = (LAS bf16*)(ts + (wr * 4 + wc) * TS_WAVE); const int ln_ = fq * 16 + fr; \
            _Pragma("unroll") for (int ai = 0; ai < 2; ++ai) _Pragma("unroll") for (int bj = 0; bj < 2; ++bj) _Pragma("unroll") for (int mp = 0; mp < 2; ++mp) { \
                _Pragma("unroll") for (int ml = 0; ml < 2; ++ml) { const f32x4 v0 = acc[ai][bj][2 * mp + ml][0], v1 = acc[ai][bj][2 * mp + ml][1]; \
                    const unsigned p0_ = cvt_pk_bf16(v0[0], v0[1]), p1_ = cvt_pk_bf16(v0[2], v0[3]), p2_ = cvt_pk_bf16(v1[0], v1[1]), p3_ = cvt_pk_bf16(v1[2], v1[3]); \
                    LAS bf16* d_ = T_ + (8 * fq) * 40 + fq * 16 + ((KIND) == 0 ? ml * 16 + fr : (fr >> 2) * 8 + ml * 4 + (fr & 3)); \
                    d_[0] = (bf16)p0_; d_[40] = (bf16)(p0_ >> 16); d_[80] = (bf16)p1_; d_[120] = (bf16)(p1_ >> 16); d_[160] = (bf16)p2_; d_[200] = (bf16)(p2_ >> 16); d_[240] = (bf16)p3_; d_[280] = (bf16)(p3_ >> 16); } \
                _Pragma("unroll") for (int h_ = 0; h_ < 2; ++h_) { const int q_ = ln_ + 64 * h_, c_ = q_ >> 2, k_ = q_ & 3; const v4u w_ = *(const LAS v4u*)(T_ + c_ * 40 + (c_ >> 3) * 16 + 8 * k_); __VA_ARGS__ } \
                asm volatile("" ::: "memory"); } } while (0)
        if (pn < 8) {
            bf16* O = (bf16*)(PA + (pn < 4 ? PA_U : PA_NQ)); const int tcol = (pn & 3) * 256; const float scl = pn < 4 ? 1.0f : 0.08838834764831845f * 1.4426950408889634f;
            IP_LOOP({ v0 *= scl; v1 *= scl; IP_PACK_STORE(O + row * 1024 + tcol + bj * 128 + cl); });
        } else if (pn < 12) {
            bf16* O = (bf16*)(PA + PA_NK); const int tcol = (pn - 8) * 256;
            if (u.pm < 16) IP_LOOP({ IP_F32_COPY(outK, tcol); IP_PACK_STORE(O + row * 1024 + tcol + bj * 128 + cl); });
            else IP_LOOP({ IP_PACK_STORE(O + row * 1024 + tcol + bj * 128 + cl); });
        } else if (pn < 16) {
            bf16* O = (bf16*)(PA + PA_NV); const int tcol = (pn - 12) * 256;
            if (u.pm < 16) IP_LOOP({ IP_F32_COPY(outV, tcol); });
            IP_TRANSPOSE(0, { *(v4u*)(O + (size_t)(tcol + bj * 128 + wc * 32 + c_) * MTOK + ((size_t)u.pm * 256 + ai * 128 + wr * 64 + 32 * mp + 8 * k_)) = w_; });
        } else if (pn < 24) {
            bf16* O = (bf16*)(PA + PA_GV); const int tcol = (pn - 20) * 256;
            IP_TRANSPOSE(1, { const int e_ = tcol + bj * 128 + wc * 32 + c_, chunk_ = u.pm * 4 + ai * 2 + wr;
                *(v4u*)((unsigned char*)O + ((size_t)chunk_ * 64 + (e_ >> 4)) * 2048 + (size_t)((k_ * 16 + (e_ & 15)) * 32) + mp * 16) = w_; });
        } else if (pn < 28) {
            bf16* O = (bf16*)(PA + PA_GR); const int tcol = (pn - 24) * 256;
            IP_LOOP({ v0 = v0 * sigmoid4(v0); v1 = v1 * sigmoid4(v1); IP_PACK_STORE(O + row * 1024 + tcol + bj * 128 + cl); });
        } else {
            bf16* O = (bf16*)(PA + PA_GL) + ((size_t)u.pm * 24 + (pn - 28)) * 65536 + (size_t)((wr * 4 + wc) * 64 + fq * 16 + fr) * 8;
            IP_LOOP({ v0 = sigmoid4(v0); v1 = sigmoid4(v1); IP_PACK_STORE(O + (size_t)(((ai * 4 + m) * 2 + bj) * 512) * 8); });
        }
#undef IP_TRANSPOSE
#undef IP_LOOP
#undef IP_PACK_STORE
#undef IP_F32_COPY
#undef IP_TRANS_STORE
    }
};

template <int CTRL> __device__ __forceinline__ float dpp_mov(float v) { return __builtin_bit_cast(float, __builtin_amdgcn_update_dpp(0, __builtin_bit_cast(int, v), CTRL, 0xf, 0xf, false)); }
__device__ __forceinline__ float rdlane(float v, int l) { return __builtin_bit_cast(float, __builtin_amdgcn_readlane(__builtin_bit_cast(int, v), l)); }
__device__ __forceinline__ float row16_sum(float v) {
    v += dpp_mov<0xB1>(v); v += dpp_mov<0x4E>(v); v += dpp_mov<0x141>(v); v += dpp_mov<0x140>(v); return v; }
__device__ __forceinline__ float row16_max(float v) {
    v = fmaxf(v, dpp_mov<0xB1>(v)); v = fmaxf(v, dpp_mov<0x4E>(v)); v = fmaxf(v, dpp_mov<0x141>(v)); v = fmaxf(v, dpp_mov<0x140>(v)); return v; }
__device__ __forceinline__ float wave_sum(float v) { v = row16_sum(v); return (rdlane(v, 0) + rdlane(v, 16)) + (rdlane(v, 32) + rdlane(v, 48)); }
__device__ __forceinline__ float wave_max(float v) { v = row16_max(v); return fmaxf(fmaxf(rdlane(v, 0), rdlane(v, 16)), fmaxf(rdlane(v, 32), rdlane(v, 48))); }
__device__ __forceinline__ void p0_transpose_item(const float* W, int K, int N, bf16* WT, int dst_row0, LAS float* scr, int kb, int nb, int lane) {
    const int k0 = 64 * kb, n0 = 32 * nb;
#pragma unroll 8
    for (int i = 0; i < 32; ++i) { const int kk = 2 * i + (lane >> 5); scr[kk * 33 + (lane & 31)] = W[(size_t)(k0 + kk) * N + n0 + (lane & 31)]; }
    LDS_WAIT(); asm volatile("" ::: "memory");
    const int c = lane & 7;
#pragma unroll
    for (int j = 0; j < 4; ++j) { const int n = (lane >> 3) + 8 * j; const LAS float* s = scr + (8 * c) * 33 + n;
        v4u o; o.x = pk2(s[0 * 33], s[1 * 33]); o.y = pk2(s[2 * 33], s[3 * 33]); o.z = pk2(s[4 * 33], s[5 * 33]); o.w = pk2(s[6 * 33], s[7 * 33]);
        *(GAS v4u*)(WT + (size_t)(dst_row0 + n) * K + k0 + 8 * c) = o; }
    LDS_WAIT(); asm volatile("" ::: "memory");
}
__device__ __forceinline__ int win_dst(int n0) {
    if (n0 < 4096) return n0;
    if (n0 < 5120) { const int base = n0 < 4608 ? 4096 : 4608, dd = n0 - base, hh = dd >> 7, w = dd & 127, axis = w >> 6, half = (w >> 5) & 1;
        return base + 256 * (hh >> 1) + 128 * half + (hh & 1) * 64 + axis * 32; }
    if (n0 < 6144) return n0;
    if (n0 < 6176) return 13312;
    return n0 - 32;
}

struct Args { const float* in[22]; float* out; unsigned char* ws; int ph_lo, ph_hi, li, pad; };
#define AS4 __attribute__((address_space(4)))
typedef const AS4 unsigned char* kargp;
#define KARG ((kargp)__builtin_amdgcn_kernarg_segment_ptr())
__device__ __forceinline__ const float* arg_in(kargp ka, int i) { return *(const float* const AS4*)(ka + 8 * i); }
__device__ __forceinline__ float* arg_out(kargp ka) { return *(float* const AS4*)(ka + 176); }
__device__ __forceinline__ unsigned char* arg_ws(kargp ka) { return *(unsigned char* const AS4*)(ka + 184); }
__device__ __forceinline__ int arg_i(kargp ka, int off) { return *(const int AS4*)(ka + off); }

template <bool FIRST, bool LAST>
__device__ __forceinline__ void norm_rows(kargp ka, int gw, int NGW, int lane, const bf16* Y, const float* post, int li, int gi, float resw, const float* pre, int ln, int gn, int row_lo, int row_hi) {
    const float* MOD = (const float*)(arg_ws(ka) + WS_MOD);
    bf16* H = (bf16*)(arg_ws(ka) + WS_H);
    for (int row = row_lo + gw; row < row_hi; row += NGW) {
        const int v = row < MCTX ? 0 : 1 + ((row - MCTX) >> 11);
        const float* xin = FIRST ? (row < MCTX ? arg_in(ka, 0) + (size_t)row * DM : arg_in(ka, 1) + (size_t)(row - MCTX) * DM) : arg_out(ka) + (size_t)row * DM;
        const f32x4* xr = (const f32x4*)xin + lane;
        f32x4 x[8];
#pragma unroll
        for (int j = 0; j < 8; ++j) x[j] = xr[64 * j];
        if (!FIRST) {
            const v2u* y0 = (const v2u*)(Y + (size_t)row * DM) + lane;
            const f32x4* pg = (const f32x4*)post + lane; const f32x4* gt = (const f32x4*)(MOD + (size_t)((v * 2 + li) * NMOD + 3 * gi + 2) * DM) + lane;
            v2u yw[8]; f32x4 vg[8], vp[8];
#pragma unroll
            for (int j = 0; j < 8; ++j) { yw[j] = y0[64 * j]; vg[j] = gt[64 * j]; vp[j] = pg[64 * j]; }
            f32x4 y[8]; float ss = 0.f;
#pragma unroll
            for (int j = 0; j < 8; ++j) { const v2u a = yw[j];
                y[j].x = bflo(a.x); y[j].y = bfhi(a.x); y[j].z = bflo(a.y); y[j].w = bfhi(a.y);
                ss += (y[j].x * y[j].x + y[j].y * y[j].y) + (y[j].z * y[j].z + y[j].w * y[j].w); }
            const float rstd = 1.0f / sqrtf(wave_sum(ss) * (1.f / DM) + EPS);
#pragma unroll
            for (int j = 0; j < 8; ++j) x[j] = x[j] + (vg[j] * resw) * (y[j] * rstd * vp[j]);
        }
        f32x4 cb[8], cs[8];
        if (!LAST) {
            const f32x4* pg = (const f32x4*)pre + lane;
            const f32x4* sh = (const f32x4*)(MOD + (size_t)((v * 2 + ln) * NMOD + 3 * gn + 0) * DM) + lane;
            const f32x4* sc = (const f32x4*)(MOD + (size_t)((v * 2 + ln) * NMOD + 3 * gn + 1) * DM) + lane;
            f32x4 t0[8], t1[8];
#pragma unroll
            for (int j = 0; j < 8; ++j) { t0[j] = pg[64 * j]; t1[j] = sc[64 * j]; cs[j] = sh[64 * j]; }
#pragma unroll
            for (int j = 0; j < 8; ++j) cb[j] = t0[j] * (t1[j] + 1.0f);
        }
        f32x4* xo = (f32x4*)(arg_out(ka) + (size_t)row * DM) + lane;
#pragma unroll
        for (int j = 0; j < 8; ++j) xo[64 * j] = x[j];
        if (!LAST) {
            float ss = 0.f;
#pragma unroll
            for (int j = 0; j < 8; ++j) ss += (x[j].x * x[j].x + x[j].y * x[j].y) + (x[j].z * x[j].z + x[j].w * x[j].w);
            const float rstd = 1.0f / sqrtf(wave_sum(ss) * (1.f / DM) + EPS);
            v2u* ho = (v2u*)(H + (size_t)row * DM) + lane;
#pragma unroll
            for (int j = 0; j < 8; ++j) { const f32x4 h = (x[j] * rstd) * cb[j] + cs[j];
                v2u w; w.x = cvt_pk_bf16(h.x, h.y); w.y = cvt_pk_bf16(h.z, h.w); ho[64 * j] = w; }
        }
    }
}

typedef short bf16x8v __attribute__((ext_vector_type(8)));
__device__ __forceinline__ float swz16(float v) { return __builtin_bit_cast(float, __builtin_amdgcn_ds_swizzle(__builtin_bit_cast(int, v), 0x401F)); }
__device__ __forceinline__ void pl32swap(unsigned& a, unsigned& b) { asm volatile("s_nop 1\n\tv_permlane32_swap_b32 %0, %1" : "+v"(a), "+v"(b)); }
__device__ __forceinline__ float xmax32(float v) { unsigned a = __builtin_bit_cast(unsigned, v), b = a; pl32swap(a, b); return fmaxf(__builtin_bit_cast(float, a), __builtin_bit_cast(float, b)); }
__device__ __forceinline__ float xsum32(float v) { unsigned a = __builtin_bit_cast(unsigned, v), b = a; pl32swap(a, b); return __builtin_bit_cast(float, a) + __builtin_bit_cast(float, b); }
template <int NQT, bool LATENT>
__device__ __forceinline__ void attn_block(LAS unsigned char* lds, int wave, int lane, const bf16* NQ, const float* rpbh, bf16* BR1,
                                           int q0, int h, int rs, int r, int ct0, int qc0, int Rlo, int nloc,
                                           const char* lksrc, const char* lvsrc  ,
                                           const char* ksrc, unsigned krs, const char* vsrc, unsigned vrs, int nshared) {
    asm volatile("" : "+v"(lane));
    const int fr = lane & 15, g = lane >> 4;
    const int nstage = nloc + nshared;
#define AT_DMA(bufi, st_) do { int ln_ = lane; asm volatile("" : "+v"(ln_));   \
        const bool lc_ = (st_) < nloc; const int si_ = lc_ ? (st_) : (st_) - nloc; const bool kw_ = wave < 4; \
        const unsigned strd_ = kw_ ? (lc_ ? 2048u : krs) : (lc_ ? (unsigned)(MTOK * 2) : vrs); \
        const char* sb_ = kw_ ? (lc_ ? lksrc + (size_t)si_ * 128u * 2048u : ksrc + (size_t)si_ * 128u * krs) : (lc_ ? lvsrc : vsrc) + (size_t)si_ * 256u; \
        const char* lb_ = sb_ + (size_t)(32 * (wave & 3) + (ln_ >> 4)) * strd_; \
        _Pragma("unroll") for (int j_ = 0; j_ < 8; ++j_) { const int c_ = (ln_ & 15) ^ ((4 * j_ + (ln_ >> 4)) & 15); \
        __builtin_amdgcn_global_load_lds((const unsigned*)(lb_ + (size_t)(4 * j_) * strd_ + c_ * 16), (LAS unsigned*)(lds + (bufi) * 65536 + (wave * 8 + j_) * 1024), 16, 0, 0); } } while (0)
    AT_DMA(0, 0);
    if (nstage > 1) AT_DMA(1, 1);
    LAS float* rpbl = (LAS float*)(lds + TS_OFF);
    if (LATENT) { for (int e = wave * 64 + lane; e < 465; e += NTHR) rpbl[e] = rpbh[e] * 1.4426950408889634f; asm volatile("s_waitcnt lgkmcnt(0)" ::: "memory"); }
    bf16x8v Qf[NQT][4];
#pragma unroll
    for (int qt = 0; qt < NQT; ++qt)
#pragma unroll
        for (int kk = 0; kk < 4; ++kk) Qf[qt][kk] = *(const bf16x8v*)(NQ + (size_t)(q0 + qt * 16 + fr) * 1024 + h * 128 + kk * 32 + g * 8);
    f32x4 O[NQT][8]; float m[NQT], lsum[NQT];
#pragma unroll
    for (int qt = 0; qt < NQT; ++qt) { m[qt] = -1e30f; lsum[qt] = 0.f;
#pragma unroll
        for (int d = 0; d < 8; ++d) O[qt][d] = (f32x4){0.f, 0.f, 0.f, 0.f}; }
#define AT_STEP(MASKED, ka0_, kb0_, ria, cta, rib, ctb, bok_) do { \
        f32x4 sa[NQT], sb[NQT]; \
        _Pragma("unroll") for (int qt = 0; qt < NQT; ++qt) { sa[qt] = (f32x4){0.f, 0.f, 0.f, 0.f}; sb[qt] = (f32x4){0.f, 0.f, 0.f, 0.f}; } \
        _Pragma("unroll") for (int kk = 0; kk < 4; ++kk) { const int ra = (ka0_) + fr, rb = (kb0_) + fr; \
            const bf16x8v Ka = *(const LAS bf16x8v*)(Kimg + ra * 256 + (((kk * 4 + g) ^ (ra & 15)) * 16)), Kb = *(const LAS bf16x8v*)(Kimg + rb * 256 + (((kk * 4 + g) ^ (rb & 15)) * 16)); \
            __builtin_amdgcn_s_setprio(1); _Pragma("unroll") for (int qt = 0; qt < NQT; ++qt) { sa[qt] = __builtin_amdgcn_mfma_f32_16x16x32_bf16(Ka, Qf[qt][kk], sa[qt], 0, 0, 0); sb[qt] = __builtin_amdgcn_mfma_f32_16x16x32_bf16(Kb, Qf[qt][kk], sb[qt], 0, 0, 0); } __builtin_amdgcn_s_setprio(0); } \
        bf16x8v P[NQT]; \
        _Pragma("unroll") for (int qt = 0; qt < NQT; ++qt) { \
            bool va[4] = {true, true, true, true}, vb[4] = {true, true, true, true}; \
            if (MASKED) { \
                const int c = qc0 + qt * 16 + fr; int cs = c - 8; cs = cs < 0 ? 0 : (cs > 48 ? 48 : cs); \
                _Pragma("unroll") for (int i = 0; i < 4; ++i) { \
                    const int kca = (cta) * 16 + 4 * g + i, kcb = (ctb) * 16 + 4 * g + i; \
                    va[i] = (kca >= cs) && (kca < cs + 16); vb[i] = (bok_) && (kcb >= cs) && (kcb < cs + 16); \
                    const float ba = va[i] ? rpbl[((ria) - r + 7) * 31 + (kca - c + 15)] : 0.f; \
                    const float bb = vb[i] ? rpbl[((rib) - r + 7) * 31 + (kcb - c + 15)] : 0.f; \
                    sa[qt][i] = va[i] ? sa[qt][i] + ba : -1e30f; sb[qt][i] = vb[i] ? sb[qt][i] + bb : -1e30f; } } \
            float mx = fmaxf(fmaxf(fmaxf(sa[qt][0], sa[qt][1]), fmaxf(sa[qt][2], sa[qt][3])), fmaxf(fmaxf(sb[qt][0], sb[qt][1]), fmaxf(sb[qt][2], sb[qt][3]))); \
            mx = fmaxf(mx, swz16(mx)); mx = xmax32(mx); \
            const float mn = fmaxf(m[qt], mx), alpha = exp2f(m[qt] - mn); m[qt] = mn; \
            float pa[4], pb[4], ps = 0.f; \
            _Pragma("unroll") for (int i = 0; i < 4; ++i) { pa[i] = va[i] ? exp2f(sa[qt][i] - mn) : 0.f; pb[i] = vb[i] ? exp2f(sb[qt][i] - mn) : 0.f; ps += pa[i] + pb[i]; } \
            lsum[qt] = lsum[qt] * alpha + ps; \
            _Pragma("unroll") for (int d = 0; d < 8; ++d) O[qt][d] *= alpha; \
            v4u pw; pw.x = cvt_pk_bf16(pa[0], pa[1]); pw.y = cvt_pk_bf16(pa[2], pa[3]); pw.z = cvt_pk_bf16(pb[0], pb[1]); pw.w = cvt_pk_bf16(pb[2], pb[3]); \
            P[qt] = __builtin_bit_cast(bf16x8v, pw); } \
        _Pragma("unroll") for (int d = 0; d < 8; ++d) { const int rv = 16 * d + fr; \
            const v2u Va = *(const LAS v2u*)(Vimg + rv * 256 + (((((ka0_) >> 3) + (g >> 1)) ^ (rv & 15)) * 16) + 8 * (g & 1)); \
            const v2u Vb = *(const LAS v2u*)(Vimg + rv * 256 + (((((kb0_) >> 3) + (g >> 1)) ^ (rv & 15)) * 16) + 8 * (g & 1)); \
            v4u vw; vw.x = Va.x; vw.y = Va.y; vw.z = Vb.x; vw.w = Vb.y; const bf16x8v Vf = __builtin_bit_cast(bf16x8v, vw); \
            __builtin_amdgcn_s_setprio(1); _Pragma("unroll") for (int qt = 0; qt < NQT; ++qt) O[qt][d] = __builtin_amdgcn_mfma_f32_16x16x32_bf16(Vf, P[qt], O[qt][d], 0, 0, 0); __builtin_amdgcn_s_setprio(0); } } while (0)
    for (int sg = 0; sg < nstage; ++sg) {
        asm volatile("s_waitcnt vmcnt(0)" ::: "memory");
        __builtin_amdgcn_s_barrier();
        const LAS unsigned char* Kimg = lds + (sg & 1) * 65536; const LAS unsigned char* Vimg = Kimg + 32768;
        if (LATENT && sg < nloc) {
            const int R0 = Rlo + 2 * sg; const bool act0 = (R0 >= rs) && (R0 <= rs + 7), act1 = (R0 + 1 >= rs) && (R0 + 1 <= rs + 7);
            const int nt = 3 * ((act0 ? 1 : 0) + (act1 ? 1 : 0)), rsel1 = act0 ? 0 : 1;
#pragma unroll 1
            for (int k = 0; k < nt; k += 2) {
                const int ka = k, kb = (k + 1 < nt) ? k + 1 : k;
                const int rowa = (act0 && act1) ? ka / 3 : rsel1, cta = ct0 + ((act0 && act1) ? ka % 3 : ka);
                const int rowb = (act0 && act1) ? kb / 3 : rsel1, ctb = ct0 + ((act0 && act1) ? kb % 3 : kb);
                const bool bok = k + 1 < nt;
                AT_STEP(true, rowa * 64 + cta * 16, rowb * 64 + ctb * 16, R0 + rowa, cta, R0 + rowb, ctb, bok);
            }
        } else {
#pragma unroll 1
            for (int j = 0; j < 4; ++j) AT_STEP(false, 32 * j, 32 * j + 16, 0, 0, 0, 0, true);
        }
        asm volatile("s_waitcnt lgkmcnt(0)" ::: "memory");
        __builtin_amdgcn_s_barrier();
        if (sg + 2 < nstage) AT_DMA(sg & 1, sg + 2);
    }
#undef AT_STEP
#undef AT_DMA
#pragma unroll
    for (int qt = 0; qt < NQT; ++qt) {
        float lt = lsum[qt]; lt += swz16(lt); lt = xsum32(lt);
        const float iv = 1.0f / lt;
        bf16* op = BR1 + (size_t)(q0 + qt * 16 + fr) * 1024 + h * 128 + 4 * g;
#pragma unroll
        for (int d = 0; d < 8; ++d) { v2u w; w.x = cvt_pk_bf16(O[qt][d][0] * iv, O[qt][d][1] * iv); w.y = cvt_pk_bf16(O[qt][d][2] * iv, O[qt][d][3] * iv); *(v2u*)(op + d * 16) = w; }
    }
}

template <int DIR>
__device__ __forceinline__ void gla_g1_item(LAS float* zs, LAS float* xch, int tid, int blk, const float* wg, const float* bg, const bf16* GQ, const bf16* GK, bf16* QI, bf16* KI, bf16* KDT, float* DEC) {
    const int tok0 = blk * 64, half = tid >> 8, c0 = 2 * (tid & 255);
    f32x2 wv[16];
#pragma unroll
    for (int r = 0; r < 16; ++r) wv[r] = *(const f32x2*)(wg + r * 512 + c0);
    const f32x2 bgv = *(const f32x2*)(bg + c0);
    f32x2 b[32];
#pragma unroll
    for (int p = 0; p < 32; ++p) {
        const LAS f32x4* zp = (const LAS f32x4*)(zs + (half * 32 + p) * 16);
        f32x2 lg = bgv;
#pragma unroll
        for (int r4 = 0; r4 < 4; ++r4) { const f32x4 z = zp[r4]; lg += z.x * wv[4 * r4]; lg += z.y * wv[4 * r4 + 1]; lg += z.z * wv[4 * r4 + 2]; lg += z.w * wv[4 * r4 + 3]; }
        b[p].x = (fminf(lg.x, 0.f) - __builtin_amdgcn_logf(1.f + __expf(-fabsf(lg.x))) * 0.6931471805599453f) * (1.0f / 16.0f);
        b[p].y = (fminf(lg.y, 0.f) - __builtin_amdgcn_logf(1.f + __expf(-fabsf(lg.y))) * 0.6931471805599453f) * (1.0f / 16.0f);
    }
    if (DIR == 0) {
#pragma unroll
        for (int p = 1; p < 32; ++p) b[p] += b[p - 1];
    } else {
#pragma unroll
        for (int p = 30; p >= 0; --p) b[p] += b[p + 1];
    }
    const f32x2 T = DIR == 0 ? b[31] : b[0];
    *(LAS f32x2*)(xch + half * 512 + c0) = T;
    __syncthreads();
    const f32x2 To = *(const LAS f32x2*)(xch + (half ^ 1) * 512 + c0);
    const bool addo = DIR == 0 ? (half == 1) : (half == 0);
    const f32x2 off = addo ? To : (f32x2){0.f, 0.f};
    const f32x2 bend = T + To;
    f32x2 ebend; ebend.x = __expf(bend.x); ebend.y = __expf(bend.y);
    if (half == 0) *(f32x2*)(DEC + (size_t)blk * 512 + c0) = ebend;
    int c2 = c0; asm volatile("" : "+v"(c2));
    const size_t rb = (size_t)(tok0 + half * 32) * 512 + c2;
    const bf16* gq = GQ + rb; const bf16* gk = GK + rb; bf16* qi = QI + rb; bf16* ki = KI + rb;
    unsigned char* kdrec = (unsigned char*)KDT + ((size_t)(blk * 4 + (c2 >> 7)) * 8 + ((c2 & 127) >> 4)) * 2048 + (size_t)(c2 & 15) * 32 + half * 16;
    unsigned qw[32], kw[32];
#pragma unroll
    for (int p = 0; p < 32; ++p) { qw[p] = *(const unsigned*)(gq + (size_t)p * 512); kw[p] = *(const unsigned*)(gk + (size_t)p * 512); }
#pragma unroll
    for (int g = 0; g < 4; ++g) {
        unsigned r0[4], r1[4];
#pragma unroll
        for (int jj = 0; jj < 2; ++jj)
#pragma unroll
            for (int i2 = 0; i2 < 2; ++i2) {
                const int p = 16 * jj + 4 * g + 2 * i2;
                const unsigned qa = qw[p], qb = qw[p + 1];
                const unsigned ka_ = kw[p], kb_ = kw[p + 1];
                const f32x2 ba = b[p] + off, bb = b[p + 1] + off;
                f32x2 ea, eb; ea.x = __expf(ba.x); ea.y = __expf(ba.y); eb.x = __expf(bb.x); eb.y = __expf(bb.y);
                f32x2 ra, rbv; ra.x = __builtin_amdgcn_rcpf(ea.x); ra.y = __builtin_amdgcn_rcpf(ea.y); rbv.x = __builtin_amdgcn_rcpf(eb.x); rbv.y = __builtin_amdgcn_rcpf(eb.y);
                f32x2 qfa, qfb, kfa, kfb; qfa.x = bflo(qa); qfa.y = bfhi(qa); qfb.x = bflo(qb); qfb.y = bfhi(qb); kfa.x = bflo(ka_); kfa.y = bfhi(ka_); kfb.x = bflo(kb_); kfb.y = bfhi(kb_);
                qfa *= ea; qfb *= eb; kfa *= ra; kfb *= rbv;
                *(unsigned*)(qi + (size_t)p * 512) = cvt_pk_bf16(qfa.x, qfa.y); *(unsigned*)(qi + (size_t)(p + 1) * 512) = cvt_pk_bf16(qfb.x, qfb.y);
                *(unsigned*)(ki + (size_t)p * 512) = cvt_pk_bf16(kfa.x, kfa.y); *(unsigned*)(ki + (size_t)(p + 1) * 512) = cvt_pk_bf16(kfb.x, kfb.y);
                kfa *= ebend; kfb *= ebend;
                r0[jj * 2 + i2] = cvt_pk_bf16(kfa.x, kfb.x); r1[jj * 2 + i2] = cvt_pk_bf16(kfa.y, kfb.y);
            }
        v4u w0, w1; w0.x = r0[0]; w0.y = r0[1]; w0.z = r0[2]; w0.w = r0[3]; w1.x = r1[0]; w1.y = r1[1]; w1.z = r1[2]; w1.w = r1[3];
        *(v4u*)(kdrec + g * 512) = w0; *(v4u*)(kdrec + g * 512 + 32) = w1;
    }
}
__device__ __forceinline__ void gld16(bf16x8v& d, const void* p) { asm volatile("global_load_dwordx4 %0, %1, off" : "=&v"(d) : "v"(p) : "memory"); }
__device__ __forceinline__ void gld8(v2u& d, const void* p) { asm volatile("global_load_dwordx2 %0, %1, off" : "=&v"(d) : "v"(p) : "memory"); }
__device__ __forceinline__ void gld4(float& d, const void* p) { asm volatile("global_load_dword %0, %1, off" : "=&v"(d) : "v"(p) : "memory"); }
template <int OFF> __device__ __forceinline__ void gld16s(bf16x8v& d, unsigned vo, const void* sb) { asm volatile("global_load_dwordx4 %0, %1, %2 offset:%3" : "=&v"(d) : "v"(vo), "s"(sb), "n"(OFF) : "memory"); }
template <int OFF> __device__ __forceinline__ void gld8s(v2u& d, unsigned vo, const void* sb) { asm volatile("global_load_dwordx2 %0, %1, %2 offset:%3" : "=&v"(d) : "v"(vo), "s"(sb), "n"(OFF) : "memory"); }
template <int OFF> __device__ __forceinline__ void gld4s(float& d, unsigned vo, const void* sb) { asm volatile("global_load_dword %0, %1, %2 offset:%3" : "=&v"(d) : "v"(vo), "s"(sb), "n"(OFF) : "memory"); }
struct G2Regs { bf16x8v Vf[2][2]; bf16x8v Kf[2][2]; float dec[2]; bf16x8v Pf[2]; };
__device__ __forceinline__ int gla_g2_unit4(kargp ka, LAS unsigned char* ldsg, int tt, int lane, int l, int u) {
    asm volatile("" : "+v"(lane));
    unsigned char* ws = arg_ws(ka);
    const bool latent = u < 256; const int uu = latent ? u : u - 256;
    const int slice = uu & 7, cj = uu >> 3, b = cj >> 3, h = (cj >> 1) & 3, dir = cj & 1;
    const int nchunk = latent ? 32 : 4, base = latent ? MCTX + b * 2048 : b * 256;
    const bf16* QI = (const bf16*)(ws + WS_QI) + (size_t)dir * MTOK * 512; const unsigned char* PT = ws + WS_PT + (size_t)dir * 192 * 32768;
    const bf16* KDT = (const bf16*)(ws + WS_KDT) + (size_t)dir * 512 * MTOK; const float* DEC = (const float*)(ws + WS_DEC) + (size_t)dir * 192 * 512;
    const bf16* GVT = (const bf16*)(ws + WS_A + PA_GV);
    float* OUT = (float*)(ws + WS_B) + (size_t)dir * MTOK * 1024;
    const int fr = lane & 15, g = lane >> 4;
    const int e0 = h * 256 + slice * 32;
    LAS unsigned char* S16 = ldsg;
    LAS unsigned char* QR = ldsg + 16384;
    f32x4 ST[2][2];
    const size_t sidx = ((((size_t)b * 2 + l) * 2 + dir) * 4 + h) * 128 * 256;
    unsigned dsrc[4];
#pragma unroll
    for (int j = 0; j < 4; ++j) { const int pcs = 4 * tt + j, r = 4 * pcs + (lane >> 4), c = (lane & 15) ^ (r & 15); dsrc[j] = (unsigned)(r * 1024 + h * 256 + c * 16); }
#define G2_DMA(bufi, tok) do { const char* qb_ = (const char*)(QI + (size_t)(tok) * 512); \
        _Pragma("unroll") for (int j_ = 0; j_ < 4; ++j_) \
            __builtin_amdgcn_global_load_lds((const unsigned*)(qb_ + dsrc[j_]), (LAS unsigned*)(QR + (bufi) * 16384 + (4 * tt + j_) * 1024), 16, 0, 0); } while (0)
    unsigned offd[2];
#pragma unroll
    for (int j = 0; j < 2; ++j) offd[j] = (unsigned)((h * 128 + (2 * tt + j) * 16 + fr) * 4);
    const unsigned offp = (unsigned)(tt * 2048 + lane * 16), offr = (unsigned)(lane * 32);
#define G2_LOADR(R, tok) do { const int ck_ = __builtin_amdgcn_readfirstlane((tok) >> 6); \
        const char* vb_ = (const char*)GVT + ((size_t)ck_ * 64 + (e0 >> 4)) * 2048; const char* kb_ = (const char*)KDT + (((size_t)ck_ * 4 + h) * 8 + 2 * tt) * 2048; \
        const char* db_ = (const char*)(DEC + (size_t)ck_ * 512); const char* pb_ = (const char*)(PT + ((size_t)ck_ * 4 + h) * 8192); \
        gld16s<0>(R.Vf[0][0], offr, vb_); gld16s<16>(R.Vf[0][1], offr, vb_); gld16s<2048>(R.Vf[1][0], offr, vb_); gld16s<2064>(R.Vf[1][1], offr, vb_); \
        gld16s<0>(R.Kf[0][0], offr, kb_); gld16s<16>(R.Kf[0][1], offr, kb_); gld16s<2048>(R.Kf[1][0], offr, kb_); gld16s<2064>(R.Kf[1][1], offr, kb_); \
        gld4s<0>(R.dec[0], offd[0], db_); gld4s<0>(R.dec[1], offd[1], db_); \
        gld16s<0>(R.Pf[0], offp, pb_); gld16s<1024>(R.Pf[1], offp, pb_); } while (0)
#define G2_TOK(c) (base + 64 * (dir ? nchunk - 1 - ((c) < nchunk ? (c) : nchunk - 1) : ((c) < nchunk ? (c) : nchunk - 1)))
#define G2_S16OFF(e_, d_) ((e_) * 256 + ((((d_) >> 3) ^ ((e_) & 15)) * 16) + ((d_) & 7) * 2)
    G2_DMA(0, G2_TOK(0));
    G2Regs R0; G2_LOADR(R0, G2_TOK(0));
    G2_DMA(1, G2_TOK(1));
    G2Regs R1; G2_LOADR(R1, G2_TOK(1));
#pragma unroll
    for (int et = 0; et < 2; ++et)
#pragma unroll
        for (int dt = 0; dt < 2; ++dt) {
            const int d = (2 * tt + dt) * 16 + fr;
            if (latent) ST[et][dt] = *(const f32x4*)(arg_in(ka, 5) + sidx + (size_t)d * 256 + slice * 32 + et * 16 + 4 * g); else ST[et][dt] = (f32x4){0.f, 0.f, 0.f, 0.f};
#pragma unroll
            for (int i = 0; i < 4; ++i) *(LAS bf16*)(S16 + G2_S16OFF(et * 16 + 4 * g + i, d)) = (bf16)f2bf(ST[et][dt][i]);
        }
    asm volatile("s_waitcnt vmcnt(0) lgkmcnt(0)" ::: "memory");
    __builtin_amdgcn_s_barrier();
#define G2_STEP(RC, RF, BC, BF, cn_) do { \
        const int tok0 = G2_TOK(cn_); \
        const LAS unsigned char* Sr = S16 + ((cn_) & 1) * 8192; LAS unsigned char* Sw = S16 + (((cn_) + 1) & 1) * 8192; \
        const LAS unsigned char* Qs = QR + (BC) * 16384; \
        G2_DMA(BF, G2_TOK((cn_) + 2)); \
        G2_LOADR(RF, G2_TOK((cn_) + 2)); \
        bf16x8v Qf[4]; \
        _Pragma("unroll") for (int kk = 0; kk < 4; ++kk) { const int r = 16 * tt + fr; Qf[kk] = *(const LAS bf16x8v*)(Qs + r * 256 + (((kk * 4 + g) ^ (r & 15)) * 16)); } \
        _Pragma("unroll") for (int et = 0; et < 2; ++et) { \
            f32x4 o = (f32x4){0.f, 0.f, 0.f, 0.f}; \
            _Pragma("unroll") for (int pr = 0; pr < 2; ++pr) o = __builtin_amdgcn_mfma_f32_16x16x32_bf16(RC.Vf[et][pr], RC.Pf[pr], o, 0, 0, 0); \
            _Pragma("unroll") for (int kk = 0; kk < 4; ++kk) { const int er = et * 16 + fr; const bf16x8v Sf = *(const LAS bf16x8v*)(Sr + er * 256 + (((kk * 4 + g) ^ (er & 15)) * 16)); \
                o = __builtin_amdgcn_mfma_f32_16x16x32_bf16(Sf, Qf[kk], o, 0, 0, 0); } \
            *(f32x4*)(OUT + (size_t)(tok0 + 16 * tt + fr) * 1024 + e0 + et * 16 + 4 * g) = o; } \
        _Pragma("unroll") for (int dt = 0; dt < 2; ++dt) { \
            const int d = (2 * tt + dt) * 16 + fr; \
            _Pragma("unroll") for (int et = 0; et < 2; ++et) { \
                ST[et][dt] *= RC.dec[dt]; \
                _Pragma("unroll") for (int hf = 0; hf < 2; ++hf) ST[et][dt] = __builtin_amdgcn_mfma_f32_16x16x32_bf16(RC.Vf[et][hf], RC.Kf[dt][hf], ST[et][dt], 0, 0, 0); \
                _Pragma("unroll") for (int i = 0; i < 4; ++i) *(LAS bf16*)(Sw + G2_S16OFF(et * 16 + 4 * g + i, d)) = (bf16)f2bf(ST[et][dt][i]); } } \
          \
        asm volatile("s_waitcnt vmcnt(18) lgkmcnt(0)" ::: "memory"); \
        __builtin_amdgcn_s_barrier(); } while (0)
    G2Regs R2;
    for (int cn = 0; cn < nchunk; cn += 3) {
        G2_STEP(R0, R2, 0, 2, cn);
        if (cn + 1 < nchunk) G2_STEP(R1, R0, 1, 0, cn + 1);
        if (cn + 2 < nchunk) G2_STEP(R2, R1, 2, 1, cn + 2);
    }
#undef G2_STEP
#undef G2_TOK
#undef G2_DMA
#undef G2_LOADR
    if (!latent) {
#pragma unroll
        for (int et = 0; et < 2; ++et)
#pragma unroll
            for (int dt = 0; dt < 2; ++dt) { const int d = (2 * tt + dt) * 16 + fr;
                *(f32x4*)(arg_out(ka) + (size_t)41943040 + sidx + (size_t)d * 256 + slice * 32 + et * 16 + 4 * g) = ST[et][dt]; }
    }
#undef G2_S16OFF
    asm volatile("s_waitcnt vmcnt(0)" ::: "memory");
    return 1 + nchunk;
}

#define PHASE_FN static __device__ __forceinline__ void
#define PH_BEGIN \
    LAS unsigned char* lds = lds_; \
    int wave = wave_, G = gridDim.x, bx = blockIdx.x; kargp ka = KARG; asm volatile("" : "+s"(wave), "+s"(G), "+s"(bx), "+s"(ka)); \
    unsigned zz_ = 0u; asm volatile("" : "+v"(zz_)); const int lane = (int)__builtin_amdgcn_mbcnt_hi(~0u, __builtin_amdgcn_mbcnt_lo(~0u, zz_)); \
    const int tid = wave * 64 + lane; const int vcu = (G % 8 == 0) ? (bx % 8) * (G / 8) + bx / 8 : bx; \
    const int gw = vcu * NWAVES + wave, NGW = G * NWAVES; unsigned char* ws = arg_ws(ka); \
    (void)lane; (void)gw; (void)NGW; (void)ws; (void)tid; (void)lds;
#define WSP(T, name, off) T* name = (T*)(ws + (off))

template<int FI0, int FI1, int FO0, int FO1, int IN0, int IN1, int BR0, int BR1, int OUT0, int OUT1, int SMALL>
__device__ __forceinline__ void cvt_run(kargp ka, unsigned char* ws, LAS float* scr, int lane, int w, int NW, int rep) {
    WSP(bf16, WFI, WS_WFI); WSP(bf16, WFO, WS_WFO); WSP(bf16, WIN, WS_WIN); WSP(bf16, WBR, WS_WBR); WSP(bf16, WOUT, WS_WOUT); WSP(bf16, WPOOL, WS_WPOOL);
    constexpr int I_FI = FI1 - FI0, I_FO = FO1 - FO0, I_IN = IN1 - IN0, I_BR = BR1 - BR0, I_OUT = OUT1 - OUT0, I_PW = SMALL ? 256 : 0, I_CV = SMALL ? 2048 : 0, NITEMS = I_FI + I_FO + I_IN + I_BR + I_OUT + I_PW + I_CV;
    for (int it = w, k_ = 0; it < NITEMS; (++k_ < rep) ? ++it : (k_ = 0, it += NW - rep + 1)) {
        int r = it;
        if (r < I_FI) { r += FI0; const int mat = r / 11008, rr = r % 11008, kb = rr / 344, nb = rr % 344, n0 = nb * 32, half = n0 / FF, j0 = n0 % FF;
            p0_transpose_item(arg_in(ka, 11) + (size_t)mat * 2048 * FF2, 2048, FF2, WFI + (size_t)mat * FF2 * 2048, 256 * (j0 >> 7) + 128 * half + (j0 & 127), scr, kb, nb, lane); continue; }
        r -= I_FI;
        if (r < I_FO) { r += FO0; const int mat = r / 5504, rr = r % 5504, kb = rr / 64, nb = rr % 64;
            p0_transpose_item(arg_in(ka, 12) + (size_t)mat * FF * 2048, FF, 2048, WFO + (size_t)mat * 2048 * FF, nb * 32, scr, kb, nb, lane); continue; }
        r -= I_FO;
        if (r < I_IN) { r += IN0; const int l = r / 13344, rr = r % 13344, kb = rr / 417, nb = rr % 417;
            p0_transpose_item(arg_in(ka, 13) + (size_t)l * 2048 * INC, 2048, INC, WIN + (size_t)l * INP * 2048, win_dst(nb * 32), scr, kb, nb, lane); continue; }
        r -= I_IN;
        if (r < I_BR) { r += BR0; const int mat = r / 1024, rr = r % 1024, kb = rr / 64, nb = rr % 64;
            p0_transpose_item(arg_in(ka, 20) + (size_t)mat * 1024 * 2048, 1024, 2048, WBR + (size_t)mat * 2048 * 1024, nb * 32, scr, kb, nb, lane); continue; }
        r -= I_BR;
        if (r < I_OUT) { r += OUT0; const int l = r / 2048, rr = r % 2048, kb = rr / 64, nb = rr % 64;
            p0_transpose_item(arg_in(ka, 21) + (size_t)l * 2048 * 2048, 2048, 2048, WOUT + (size_t)l * 2048 * 2048, nb * 32, scr, kb, nb, lane); continue; }
        if (SMALL) {
            r -= I_OUT;
            if (r < I_PW) { const int mat = r / 32, rr = r % 32, kb = rr / 8, nb = rr % 8;
                p0_transpose_item(arg_in(ka, 14) + (size_t)mat * 65536, 256, 256, WPOOL + (size_t)mat * 65536, nb * 32, scr, kb, nb, lane); continue; }
            r -= I_PW;
            { const int mat = r / 32, rr = r % 32, kb = rr / 4, nb = rr % 4;
                p0_transpose_item(arg_in(ka, 4) + (size_t)mat * 65536, 512, 128, (bf16*)(ws + WS_CVT) + (size_t)mat * 65536, nb * 32, scr, kb, nb, lane); }
        }
    }
}

__device__ __forceinline__ void mod_gemv(kargp ka, LAS unsigned char* lds, int tid, float* MOD, int it_end, int start, int stride) {
    LAS float* sc = (LAS float*)lds; LAS float* red = sc + 5 * 2048;
    for (int e = tid; e < 5 * 2048; e += NTHR) { const int v = e >> 11, k = e & 2047; const float c = v == 0 ? arg_in(ka, 6)[k] : arg_in(ka, 2)[(v - 1) * 2048 + k]; sc[e] = c / (1.f + expf(-c)); }
    __syncthreads();
    for (int it = start; it < it_end; it += stride) {
        const int l = it / 288, j0 = (it % 288) * 64, cg = tid & 15, kg = tid >> 4;
        const float* w = arg_in(ka, 7) + ((size_t)l * 2048 + kg * 64) * 18432 + j0 + cg * 4;
        f32x4 a0 = (f32x4){0.f, 0.f, 0.f, 0.f}, a1 = a0, a2 = a0, a3 = a0, a4 = a0;
#pragma unroll 16
        for (int k = 0; k < 64; ++k) { const f32x4 wv = *(const f32x4*)(w + (size_t)k * 18432); const int kk = kg * 64 + k;
            a0 += sc[kk] * wv; a1 += sc[2048 + kk] * wv; a2 += sc[4096 + kk] * wv; a3 += sc[6144 + kk] * wv; a4 += sc[8192 + kk] * wv; }
        *(LAS f32x4*)(red + (kg * 5 + 0) * 64 + cg * 4) = a0; *(LAS f32x4*)(red + (kg * 5 + 1) * 64 + cg * 4) = a1; *(LAS f32x4*)(red + (kg * 5 + 2) * 64 + cg * 4) = a2;
        *(LAS f32x4*)(red + (kg * 5 + 3) * 64 + cg * 4) = a3; *(LAS f32x4*)(red + (kg * 5 + 4) * 64 + cg * 4) = a4;
        __syncthreads();
        if (tid < 320) { const int v = tid >> 6, c2 = tid & 63; float s = 0.f;
#pragma unroll
            for (int k8 = 0; k8 < 32; ++k8) s += red[(k8 * 5 + v) * 64 + c2];
            const int j = j0 + c2; MOD[(size_t)(v * 2 + l) * 18432 + j] = s + arg_in(ka, 8)[(size_t)l * 18432 + j]; }
        __syncthreads();
    }
}

PHASE_FN ph_prologue(LAS unsigned char* lds_, int wave_) {
    PH_BEGIN
    WSP(float, MOD, WS_MOD); WSP(f32x2, ROPE, WS_ROPE); WSP(bf16, WFI, WS_WFI); WSP(bf16, WFO, WS_WFO); WSP(bf16, WIN, WS_WIN); WSP(bf16, WBR, WS_WBR); WSP(bf16, WOUT, WS_WOUT); WSP(bf16, WPOOL, WS_WPOOL);
    if (tid == 0) {
        const int r0 = 384 - G, n1_ = (r0 > 0 && 2 * r0 <= G) ? r0 : 0; const unsigned myx = xb_xcc_id() & 15u; unsigned* cw = (unsigned*)(ws + WS_CTL) + CW_MFLAG;
        if (bx < 384) __hip_atomic_store(cw + bx, myx, __ATOMIC_RELAXED, __HIP_MEMORY_SCOPE_AGENT);
        if (bx >= n1_ && bx < 2 * n1_) (void)__hip_atomic_fetch_add(cw + 384 + myx, 1u, __ATOMIC_RELAXED, __HIP_MEMORY_SCOPE_AGENT);
    }
    mod_gemv(ka, lds, tid, MOD, 576, bx, G);
    if (bx == G - 1) {
        for (int e = tid; e < 2048; e += NTHR) { const int pos = e >> 5, j = e & 31; const float invf = exp2f(-(float)j * (13.287712379549449f / 32.f)); const float ang = (float)pos * invf;
            f32x2 cs; cs.x = cosf(ang); cs.y = sinf(ang); ROPE[e] = cs; }
    }
    {
        const int gt = vcu * NTHR + tid, NGT = G * NTHR;
        for (int i = gt; i < 2 * 57344; i += NGT) { const int l = i / 57344, r = i % 57344; ((v4u*)(WIN + ((size_t)l * INP + INC) * 2048))[r] = (v4u){0u, 0u, 0u, 0u}; }
    }
    cvt_run<0, 22016, 0, 11008, 0, 13344, 0, 3072, 0, 2048, 1>(ka, ws, (LAS float*)(lds + wave * 16384), lane, gw, NGW, 1);
    {
        const int gt = vcu * NTHR + tid, NGT = G * NTHR; const float* ck = arg_in(ka, 3); bf16* CKB = (bf16*)(ws + WS_CKB);
        for (int i = gt; i < 4194304 / 8; i += NGT) { const f32x4 a = ((const f32x4*)ck)[2 * i], b2 = ((const f32x4*)ck)[2 * i + 1];
            v4u w; w.x = pk2(a.x, a.y); w.y = pk2(a.z, a.w); w.z = pk2(b2.x, b2.y); w.w = pk2(b2.z, b2.w); ((v4u*)CKB)[i] = w; }
    }
}
PHASE_FN ph_norm(LAS unsigned char* lds_, int wave_, int mode_, int l_, int i_, int part_, int lfp_) {
    PH_BEGIN
    const int mode = mode_, l = l_, i = i_, part = part_;
    pg8::FfnPreOrder SP; SP.init(G, bx, 2048);
    const int npre = part == 2 ? SP.nblk() : 0;
    if (part == 2 && bx < npre) {
        WSP(bf16, H, WS_H); WSP(bf16, WFI, WS_WFI); WSP(bf16, ACT, WS_A);
        pg8::Gemm g{H, WFI + (size_t)lfp_ * FF2 * 2048, 2048, 2048, 1024, 1024, 2048, 2048, (unsigned*)(ws + WS_CTL + 524288)};
        EpiSwiGLUPre E{ACT, (bf16*)(ws + WS_B + 64 * MiB) + (size_t)(bx & 15) * 65536, (unsigned*)(ws + WS_CTL) + CW_MFLAG + 656 + lfp_ * 16 + (bx & 15), SP.split ? (bx < 16 ? 1 : 2) : 0};
        pg8::gemm_phase<EpiSwiGLUPre, pg8::FfnPreOrder>(lds, g, SP, E, tid);
        return;
    }
    WSP(bf16, YB, WS_B);
    const int ln = (i == 2) ? l + 1 : l, gn = (i == 2) ? 0 : i + 1;
    const float resw = (i == 1) ? 1.0f : 0.5f;
    const int row_lo = part == 2 ? MCTX : 0, row_hi = part == 1 ? MCTX : MTOK;
    const int gwe = part == 2 ? (bx - npre) * NWAVES + wave : gw, NGWe = part == 2 ? (G - npre) * NWAVES : NGW;
    if (mode == 0) norm_rows<true, false>(ka, gwe, NGWe, lane, nullptr, nullptr, 0, 0, 0.f, arg_in(ka, 9), 0, 0, row_lo, row_hi);
    else if (mode == 1) norm_rows<false, false>(ka, gwe, NGWe, lane, YB, arg_in(ka, 10) + (size_t)(l * 3 + i) * DM, l, i, resw, arg_in(ka, 9) + (size_t)(ln * 3 + gn) * DM, ln, gn, row_lo, row_hi);
    else norm_rows<false, true>(ka, gwe, NGWe, lane, YB, arg_in(ka, 10) + (size_t)(l * 3 + i) * DM, l, i, resw, nullptr, 0, 0, row_lo, row_hi);
}
PHASE_FN ph_ffn_in(LAS unsigned char* lds_, int wave_, int lf_) {
    PH_BEGIN
    const int lf = lf_;
    WSP(bf16, H, WS_H); WSP(bf16, WFI, WS_WFI); WSP(bf16, ACT, WS_A);
    pg8::Gemm g{H, WFI + (size_t)lf * FF2 * 2048, 2048, 2048, 0, 0, 2048, 2048, (unsigned*)(ws + WS_CTL + 524288)}; pg8::FfnOrder S; S.init(G, bx, 0);
    EpiSwiGLU E{ACT}; pg8::gemm_phase<EpiSwiGLU, pg8::FfnOrder>(lds, g, S, E, tid);
}
PHASE_FN ph_ffn_out(LAS unsigned char* lds_, int wave_, int lf_) {
    PH_BEGIN
    const int lf = lf_;
    WSP(bf16, ACT, WS_A); WSP(bf16, WFO, WS_WFO); WSP(bf16, YB, WS_B);
    pg8::Gemm g{ACT, WFO + (size_t)lf * 2048 * FF, FF, FF, 2944, 2944, 2944, 2560, (unsigned*)(ws + WS_CTL + 524288)}; pg8::SplitKOrder S; S.init(G, bx, FF, 2944);
    const int n1 = S.n1, jt = (bx < n1 ? bx : bx - n1) & 127;
    EpiY E{YB, DM, ws, 2 + lf, jt, n1, (n1 > 0 && bx < 2 * n1) ? (bx < n1 ? 1 : 2) : 0, S.pm2, S.pn2}; pg8::gemm_phase<EpiY, pg8::SplitKOrder>(lds, g, S, E, tid);
}
PHASE_FN ph_inproj(LAS unsigned char* lds_, int wave_, int l_) {
    PH_BEGIN
    const int l = l_;
    WSP(bf16, H, WS_H); WSP(bf16, WIN, WS_WIN); WSP(f32x2, ROPE, WS_ROPE);
    pg8::Gemm g{H, WIN + (size_t)l * INP * 2048, 2048, 2048, 0, 0, 2048, 2048, (unsigned*)(ws + WS_CTL + 524288)}; pg8::ZOrder S; S.init(48, 53, 1, G, bx, 0);
    EpiInProj E{ws + WS_A, arg_out(ka) + 25165824, arg_out(ka) + 33554432, ROPE, l, lds + TS_OFF};
    pg8::gemm_phase<EpiInProj, pg8::ZOrder>(lds, g, S, E, tid);
}
PHASE_FN ph_mix1(LAS unsigned char* lds_, int wave_, int l_) {
    PH_BEGIN
    const int l = l_;
    unsigned char* PA = ws + WS_A; WSP(bf16, PL, WS_PL); WSP(bf16, BR, WS_BR);
    const bf16* U = (const bf16*)(PA + PA_U);
    {
        const int gt = vcu * NTHR + tid, NGT = G * NTHR;
#define PL_ACC(w_, f_) { s[0] += f_ * bflo(w_.x); s[1] += f_ * bfhi(w_.x); s[2] += f_ * bflo(w_.y); s[3] += f_ * bfhi(w_.y); s[4] += f_ * bflo(w_.z); s[5] += f_ * bfhi(w_.z); s[6] += f_ * bflo(w_.w); s[7] += f_ * bfhi(w_.w); }
        for (int idx = gt; idx < (MTOK / 16) * 128; idx += NGT) {
            const int run = idx >> 7, cc = idx & 127, col0 = cc * 8, g4 = col0 >> 8, win = 2 << g4, lo = win / 2, hi = win - 1 - lo;
            const int row0 = run * 16;
            const int base = row0 < MCTX ? (row0 & ~255) : MCTX + ((row0 - MCTX) & ~2047), L = row0 < MCTX ? 256 : 2048, t0 = row0 - base;
            const bf16* Ub = U + (size_t)base * 1024 + col0; bf16* Pb = PL + (size_t)base * 1024 + col0;
            float s[8] = {0.f, 0.f, 0.f, 0.f, 0.f, 0.f, 0.f, 0.f};
            {
                v4u wq[16];
#pragma unroll
                for (int k = 0; k < 16; ++k) { int r = t0 - lo + k; r = r < 0 ? 0 : (r > L - 1 ? L - 1 : r); wq[k] = *(const v4u*)(Ub + (size_t)r * 1024); }
#pragma unroll
                for (int k = 0; k < 16; ++k) { const int r = t0 - lo + k; const float f = (k < win && r >= 0 && r <= L - 1) ? 1.f : 0.f; PL_ACC(wq[k], f) }
            }
#pragma unroll
            for (int jg = 0; jg < 4; ++jg) {
                v4u wn[4], wo[4], wc[4];
#pragma unroll
                for (int jj = 0; jj < 4; ++jj) { const int t = t0 + 4 * jg + jj; int tn = t + hi, to = t - lo - 1; tn = tn > L - 1 ? L - 1 : tn; to = to < 0 ? 0 : to;
                    wn[jj] = *(const v4u*)(Ub + (size_t)tn * 1024); wo[jj] = *(const v4u*)(Ub + (size_t)to * 1024); wc[jj] = *(const v4u*)(Ub + (size_t)t * 1024); }
#pragma unroll
                for (int jj = 0; jj < 4; ++jj) { const int j = 4 * jg + jj, t = t0 + j;
                    if (j > 0) { const float fn = (t + hi <= L - 1) ? 1.f : 0.f, fo = (t - lo - 1 >= 0) ? -1.f : 0.f; PL_ACC(wn[jj], fn) PL_ACC(wo[jj], fo) }
                    const int tlo = t - lo < 0 ? 0 : t - lo, thi = t + hi > L - 1 ? L - 1 : t + hi;
                    const float ic = 1.0f / (float)(thi - tlo + 1);
                    const v4u w = wc[jj];
                    v4u o; o.x = cvt_pk_bf16(s[0] * ic - bflo(w.x), s[1] * ic - bfhi(w.x)); o.y = cvt_pk_bf16(s[2] * ic - bflo(w.y), s[3] * ic - bfhi(w.y));
                    o.z = cvt_pk_bf16(s[4] * ic - bflo(w.z), s[5] * ic - bfhi(w.z)); o.w = cvt_pk_bf16(s[6] * ic - bflo(w.w), s[7] * ic - bfhi(w.w));
                    *(v4u*)(Pb + (size_t)t * 1024) = o; }
            }
        }
#undef PL_ACC
    }
    {
        LAS float* zs = (LAS float*)lds;
        const bf16* GQ = (const bf16*)(PA + PA_GQ); const bf16* GK = (const bf16*)(PA + PA_GK); const float* GZ = (const float*)(PA + PA_GZ);
        for (int it = bx; it < 384; it += G) {
            const int dir = it & 1, blk = it >> 1;
            __syncthreads();
            for (int e = tid; e < 1024; e += NTHR) zs[e] = GZ[(size_t)(blk * 64 + (e >> 4)) * 32 + dir * 16 + (e & 15)];
            __syncthreads();
            const float* wg = arg_in(ka, 17) + (size_t)(l * 2 + dir) * 16 * 512; const float* bg = arg_in(ka, 18) + (size_t)(l * 2 + dir) * 512;
            bf16* QI = (bf16*)(ws + WS_QI) + (size_t)dir * MTOK * 512; bf16* KI = (bf16*)(ws + WS_KI) + (size_t)dir * MTOK * 512;
            bf16* KDT = (bf16*)(ws + WS_KDT) + (size_t)dir * 512 * MTOK; float* DEC = (float*)(ws + WS_DEC) + (size_t)dir * 192 * 512;
            if (dir == 0) gla_g1_item<0>(zs, zs + 1024, tid, blk, wg, bg, GQ, GK, QI, KI, KDT, DEC); else gla_g1_item<1>(zs, zs + 1024, tid, blk, wg, bg, GQ, GK, QI, KI, KDT, DEC);
            asm volatile("s_waitcnt vmcnt(0)" ::: "memory");
            __syncthreads();
            {
                const int hh = wave >> 1, pr = wave & 1, fr = lane & 15, g = lane >> 4, tok0 = blk * 64;
                bf16x8v Kf[2][4];
#pragma unroll
                for (int sl = 0; sl < 2; ++sl)
#pragma unroll
                    for (int kk = 0; kk < 4; ++kk) Kf[sl][kk] = *(const bf16x8v*)(KI + (size_t)(tok0 + 16 * (2 * pr + sl) + fr) * 512 + hh * 128 + kk * 32 + g * 8);
                unsigned char* pt = ws + WS_PT + ((size_t)(dir * 192 + blk) * 4 + hh) * 8192 + pr * 1024 + lane * 16;
                bf16x8v Qa[4][4];
#pragma unroll
                for (int t4 = 0; t4 < 4; ++t4)
#pragma unroll
                    for (int kk = 0; kk < 4; ++kk) Qa[t4][kk] = *(const bf16x8v*)(QI + (size_t)(tok0 + 16 * t4 + fr) * 512 + hh * 128 + kk * 32 + g * 8);
#pragma unroll
                for (int t4 = 0; t4 < 4; ++t4) {
                    f32x4 a0 = (f32x4){0.f, 0.f, 0.f, 0.f}, a1 = (f32x4){0.f, 0.f, 0.f, 0.f};
#pragma unroll
                    for (int kk = 0; kk < 4; ++kk) { const bf16x8v Qf = Qa[t4][kk];
                        a0 = __builtin_amdgcn_mfma_f32_16x16x32_bf16(Kf[0][kk], Qf, a0, 0, 0, 0); a1 = __builtin_amdgcn_mfma_f32_16x16x32_bf16(Kf[1][kk], Qf, a1, 0, 0, 0); }
#pragma unroll
                    for (int i = 0; i < 4; ++i) { const int tp = 16 * t4 + fr, s0 = 32 * pr + 4 * g + i, s1 = s0 + 16;
                        a0[i] = (dir ? (s0 >= tp) : (s0 <= tp)) ? a0[i] : 0.f; a1[i] = (dir ? (s1 >= tp) : (s1 <= tp)) ? a1[i] : 0.f; }
                    v4u pw; pw.x = cvt_pk_bf16(a0[0], a0[1]); pw.y = cvt_pk_bf16(a0[2], a0[3]); pw.z = cvt_pk_bf16(a1[0], a1[1]); pw.w = cvt_pk_bf16(a1[2], a1[3]);
                    *(v4u*)(pt + t4 * 2048) = pw;
                }
            }
        }
    }
    {
        const bf16* NQ = (const bf16*)(PA + PA_NQ); const bf16* NK = (const bf16*)(PA + PA_NK); const bf16* NVT = (const bf16*)(PA + PA_NV);
        bf16* BR1 = BR + (size_t)MTOK * 1024;
        const float* rpb = arg_in(ka, 16) + (size_t)l * 8 * 15 * 31;
        const bf16* CKB = (const bf16*)(ws + WS_CKB); const bf16* CVT = (const bf16*)(ws + WS_CVT);
        __syncthreads();
        for (int rep_ = 0; rep_ < REP_ATT; ++rep_) {
        for (int ub = vcu; ub < 256; ub += G) {
            const int u = ub * 8 + wave, half = u & 1, r = (u >> 1) & 31, h = (u >> 6) & 7, b = u >> 9;
            int rs = r - 4; rs = rs < 0 ? 0 : (rs > 24 ? 24 : rs);
            const int r0 = r & ~3; int Rlo = r0 - 4; Rlo = Rlo < 0 ? 0 : (Rlo > 24 ? 24 : Rlo); int rs3 = r0 + 3 - 4; rs3 = rs3 < 0 ? 0 : (rs3 > 24 ? 24 : rs3);
            const int nR = rs3 + 7 - Rlo + 1, nloc = (nR + 1) >> 1;
            const int base = MCTX + b * 2048; const size_t co = (((size_t)b * 2 + l) * 8 + h) * 512 * 128;
            attn_block<2, true>(lds, wave, lane, NQ, rpb + h * 465, BR1, base + r * 64 + half * 32, h, rs, r, half, half * 32, Rlo, nloc,
                                (const char*)(NK + (size_t)(base + Rlo * 64) * 1024 + h * 128), (const char*)(NVT + (size_t)(h * 128) * MTOK + base + Rlo * 64),
                                (const char*)(CKB + co), 256u, (const char*)(CVT + co), 1024u, 4);
        }
        for (int ub = bx; ub < 256; ub += G) {
            const int qh = ub & 1, h = (ub >> 1) & 7, b = ub >> 4;
            attn_block<1, false>(lds, wave, lane, NQ, nullptr, BR1, b * 256 + qh * 128 + wave * 16, h, 0, 0, 0, 0, 0, 0, nullptr, nullptr,
                                 (const char*)(NK + (size_t)(b * 256) * 1024 + h * 128), 2048u, (const char*)(NVT + (size_t)(h * 128) * MTOK + b * 256), (unsigned)(MTOK * 2), 2);
        }
        }
    }
}
PHASE_FN ph_mix1b(LAS unsigned char* lds_, int wave_, int l_) {
    PH_BEGIN
    const int l = l_;
    int nb0 = 0, nb1 = 0;
    for (int u = vcu; u < 256; u += G) nb0 += 33;
    for (int u = 256 + vcu; u < 1280; u += G) nb1 += 5;
    const int nbmax = nb0 > nb1 ? nb0 : nb1;
    int done = 0;
    if (wave < 4) { for (int u = vcu; u < 256; u += G) done += gla_g2_unit4(ka, lds, wave, lane, l, u); }
    else { for (int u = 256 + vcu; u < 1280; u += G) done += gla_g2_unit4(ka, lds + 65536, wave - 4, lane, l, u); }
    for (; done < nbmax; ++done) __builtin_amdgcn_s_barrier();
}
PHASE_FN ph_mix2(LAS unsigned char* lds_, int wave_, int l_) {
    PH_BEGIN
    const int l = l_;
    unsigned char* PA = ws + WS_A; WSP(bf16, PL, WS_PL); WSP(bf16, BR, WS_BR); WSP(float, YB, WS_B); WSP(bf16, WPOOL, WS_WPOOL);
    {
        const float* OF = YB; const float* OB = YB + (size_t)MTOK * 1024; const bf16* GR = (const bf16*)(PA + PA_GR); bf16* BR2 = BR + (size_t)2 * MTOK * 1024;
        const float* gn = arg_in(ka, 19) + (size_t)l * 1024;
        const int hh = lane >> 4, sub = lane & 15;
        for (int row = gw; row < MTOK; row += NGW) {
            f32x4 o[4], gv[4]; v2u rv[4]; float ss = 0.f;
#pragma unroll
            for (int j = 0; j < 4; ++j) { const int c = hh * 256 + (sub + 16 * j) * 4; const size_t off = (size_t)row * 1024 + c; o[j] = *(const f32x4*)(OF + off) + *(const f32x4*)(OB + off);
                gv[j] = *(const f32x4*)(gn + c); rv[j] = *(const v2u*)(GR + off); }
#pragma unroll
            for (int j = 0; j < 4; ++j) ss += (o[j].x * o[j].x + o[j].y * o[j].y) + (o[j].z * o[j].z + o[j].w * o[j].w);
            ss = row16_sum(ss);
            const float rstd = 1.0f / sqrtf(ss * (1.f / 256.f) + EPS);
#pragma unroll
            for (int j = 0; j < 4; ++j) { const int c = hh * 256 + (sub + 16 * j) * 4; const f32x4 g4 = gv[j]; const v2u rw = rv[j];
                v2u w; w.x = cvt_pk_bf16(o[j].x * rstd * g4.x * bflo(rw.x), o[j].y * rstd * g4.y * bfhi(rw.x)); w.y = cvt_pk_bf16(o[j].z * rstd * g4.z * bflo(rw.y), o[j].w * rstd * g4.w * bfhi(rw.y));
                *(v2u*)(BR2 + (size_t)row * 1024 + c) = w; }
        }
    }
    {
        pg8::Gemm g{PL, WPOOL + (size_t)l * 4 * 65536, 1024, 256, 256, 65536, 256, 256, (unsigned*)(ws + WS_CTL + 524288)}; pg8::ZOrder S; S.init(48, 1, 4, G, bx, 0);
        EpiPool E{BR, arg_in(ka, 15) + (size_t)l * 1024};
        pg8::gemm_phase<EpiPool, pg8::ZOrder>(lds, g, S, E, tid);
    }
}
PHASE_FN ph_merge(LAS unsigned char* lds_, int wave_, int l_) {
    PH_BEGIN
    const int l = l_;
    WSP(bf16, BR, WS_BR); WSP(bf16, WBR, WS_WBR); WSP(bf16, YB, WS_B); WSP(bf16, MG, WS_MG);
    pg8::Gemm g{BR, WBR + (size_t)l * 3 * 2048 * 1024, 1024, 1024, (size_t)MTOK * 1024, (size_t)2048 * 1024, 1024, 1024, (unsigned*)(ws + WS_CTL + 524288)}; pg8::MergeOrder S; S.init(G, bx); if (l == 0) S.n1 = 0;
    const int n1 = S.n1, jt = bx < n1 ? bx : bx - n1;
    pg8::Unit u2; u2.pm = -1; u2.pn = -1; if (n1 > 0 && bx < 2 * n1) S.Z.map(G + jt, u2);
    EpiMerge E{(const bf16*)(ws + WS_A + PA_GL), YB, MG, ws, l, jt & 127, n1, (n1 > 0 && bx < 2 * n1) ? (bx < n1 ? 1 : 2) : 0, u2.pm, u2.pn};
    pg8::gemm_phase<EpiMerge, pg8::MergeOrder>(lds, g, S, E, tid);
    {
        int w0, rep = 1, NV; bool act;
        if (n1 > 0) {
            if (l == 0) { NV = n1 * NWAVES * 4; act = bx < 2 * n1; if (bx < n1) w0 = bx * NWAVES + wave; else { w0 = n1 * NWAVES + ((bx - n1) * NWAVES + wave) * 3; rep = 3; } }
            else { NV = n1 * NWAVES; act = bx >= n1 && bx < 2 * n1; w0 = (bx - n1) * NWAVES + wave; }
        } else { const int first = 384 % G; act = bx >= first; w0 = (bx - first) * NWAVES + wave; NV = (G - first) * NWAVES; }
        if (act) {
            __syncthreads();
            if (l == 0) cvt_run<22016, 33024, 11008, 16512, 13344, 26688, 3072, 6144, 2048, 4096, 0>(ka, ws, (LAS float*)(lds + wave * 16384), lane, w0, NV, rep);
            else        cvt_run<33024, 44032, 16512, 22016, 0, 0, 0, 0, 0, 0, 0>(ka, ws, (LAS float*)(lds + wave * 16384), lane, w0, NV, rep);
        }
    }
}
PHASE_FN ph_out(LAS unsigned char* lds_, int wave_, int l_) {
    PH_BEGIN
    const int l = l_;
    WSP(bf16, MG, WS_MG); WSP(bf16, WOUT, WS_WOUT); WSP(bf16, YB, WS_B);
    pg8::Gemm g{MG, WOUT + (size_t)l * 2048 * 2048, 2048, 2048, 1152, 1152, 1152, 896, (unsigned*)(ws + WS_CTL + 524288)}; pg8::SplitKOrder S; S.init(G, bx, 2048, 1152);
    const int n1 = S.n1, jt = (bx < n1 ? bx : bx - n1) & 127;
    EpiY E{YB, DM, ws, 6 + l, jt, n1, (n1 > 0 && bx < 2 * n1) ? (bx < n1 ? 1 : 2) : 0, S.pm2, S.pn2};
    pg8::gemm_phase<EpiY, pg8::SplitKOrder>(lds, g, S, E, tid);
}

__global__ void __launch_bounds__(NTHR, 2) mk_fwd(Args args) {
    extern __shared__ __attribute__((aligned(16))) unsigned char lds_raw[];
    LAS unsigned char* lds = (LAS unsigned char*)lds_raw;
    volatile LAS unsigned* MISC = (volatile LAS unsigned*)(lds + MISC_OFF);
    const int wave0 = __builtin_amdgcn_readfirstlane((int)(threadIdx.x >> 6));
    unsigned char* ws0 = arg_ws(KARG);
    gu32* ctl = (gu32*)(ws0 + WS_CTL);
    for (int u = threadIdx.x; u < (LDS_BYTES - LDSCTL_OFF) / 4; u += NTHR) ((LAS unsigned*)(lds + LDSCTL_OFF))[u] = 0u;
    __syncthreads();
    XcdBarrier bar = xcd_barrier_post((unsigned*)(ctl + CW_BAR) + arg_i(KARG, 200) * XCD_BAR_WORDS, MISC + 8);
#if MK_PER_PHASE
    const int lo = arg_i(KARG, 192), hi = arg_i(KARG, 196);
#define IN(k) (lo <= (k) && (k) < hi)
#else
#define IN(k) ((k) < NPH)
#endif
#define SEAM(k) do { if (IN(k) && IN((k) + 1)) { unsigned* bb_ = bar.bar; unsigned bx_ = bar.x; int w_ = wave0; asm volatile("" : "+s"(bb_), "+s"(bx_), "+s"(w_)); \
        unsigned zz_ = 0u; asm volatile("" : "+v"(zz_)); const int ln_ = (int)__builtin_amdgcn_mbcnt_hi(~0u, __builtin_amdgcn_mbcnt_lo(~0u, zz_)); xcd_barrier_impl(bb_, bx_, bar.st, w_ * 64 + ln_); } } while (0)
    if (IN(0)) { ph_prologue(lds, wave0); if (REP_PRO > 1) { __syncthreads(); ph_prologue(lds, wave0); } }
    SEAM(0);
    if (IN(1)) ph_norm(lds, wave0, 0, 0, 0, 1, 0);
    SEAM(1);
    if (IN(2)) ph_norm(lds, wave0, 0, 0, 0, 2, 0);
    SEAM(2);
#define LAYER(l) { constexpr int k0 = 3 + 16 * (l); \
        if (IN(k0 + 0)) { ph_ffn_in(lds, wave0, l * 2 + 0); if (REP_GEMM > 1 || REP_FFI > 1) { __syncthreads(); ph_ffn_in(lds, wave0, l * 2 + 0); } } \
        SEAM(k0 + 0); \
        if (IN(k0 + 1)) { ph_ffn_out(lds, wave0, l * 2 + 0); if (REP_GEMM > 1 || REP_FFO > 1) { __syncthreads(); ph_ffn_out(lds, wave0, l * 2 + 0); } } \
        SEAM(k0 + 1); \
        if (IN(k0 + 2)) ph_norm(lds, wave0, 1, l, 0, 0, 0); \
        SEAM(k0 + 2); \
        if (IN(k0 + 3)) { ph_inproj(lds, wave0, l); if (REP_GEMM > 1 || REP_INP > 1) { __syncthreads(); ph_inproj(lds, wave0, l); } } \
        SEAM(k0 + 3); \
        if (IN(k0 + 4)) { ph_mix1(lds, wave0, l); if (REP_MIX1 > 1) { __syncthreads(); ph_mix1(lds, wave0, l); } } \
        SEAM(k0 + 4); \
        if (IN(k0 + 5)) { ph_mix1b(lds, wave0, l); if (REP_SCAN > 1) { __syncthreads(); ph_mix1b(lds, wave0, l); } } \
        SEAM(k0 + 5); \
        if (IN(k0 + 6)) { ph_mix2(lds, wave0, l); if (REP_GEMM > 1) { __syncthreads(); ph_mix2(lds, wave0, l); } } \
        SEAM(k0 + 6); \
        if (IN(k0 + 7)) { ph_merge(lds, wave0, l); if (REP_GEMM > 1) { __syncthreads(); ph_merge(lds, wave0, l); } } \
        SEAM(k0 + 7); \
        if (IN(k0 + 8)) { ph_out(lds, wave0, l); if (REP_GEMM > 1) { __syncthreads(); ph_out(lds, wave0, l); } } \
        SEAM(k0 + 8); \
        if (IN(k0 + 9)) ph_norm(lds, wave0, 1, l, 1, 1, 0); \
        SEAM(k0 + 9); \
        if (IN(k0 + 10)) ph_norm(lds, wave0, 1, l, 1, 2, l * 2 + 1); \
        SEAM(k0 + 10); \
        if (IN(k0 + 11)) { ph_ffn_in(lds, wave0, l * 2 + 1); if (REP_GEMM > 1 || REP_FFI > 1) { __syncthreads(); ph_ffn_in(lds, wave0, l * 2 + 1); } } \
        SEAM(k0 + 11); \
        if (IN(k0 + 12)) { ph_ffn_out(lds, wave0, l * 2 + 1); if (REP_GEMM > 1 || REP_FFO > 1) { __syncthreads(); ph_ffn_out(lds, wave0, l * 2 + 1); } } \
        SEAM(k0 + 12); \
        if (l == 0) { \
            if (IN(k0 + 13)) ph_norm(lds, wave0, 1, l, 2, 1, 0); \
            SEAM(k0 + 13); \
            if (IN(k0 + 14)) ph_norm(lds, wave0, 1, l, 2, 2, 2); \
            SEAM(k0 + 14); \
        } else { \
            if (IN(k0 + 13)) ph_norm(lds, wave0, 2, l, 2, 0, 0); \
        } \
    }
    LAYER(0)
    LAYER(1)
#undef LAYER
#undef IN
#undef SEAM
}

extern "C" void kernel_launch(void* const* d_in, const int* in_sizes, int n_in, void* d_out, int out_size, void* d_ws, size_t ws_size, hipStream_t stream) {
    static int grid = 0;
    if (grid == 0) {
        if (n_in != 22 || out_size != 50331648 || ws_size < WS_END) { fprintf(stderr, "kernel_launch: unexpected shapes (n_in %d, out %d, ws %zu); nothing launched\n", n_in, out_size, ws_size); grid = -1; return; }
        int dev = 0, cus = 0, per_cu = 0;
        if (hipGetDevice(&dev) != hipSuccess || hipDeviceGetAttribute(&cus, hipDeviceAttributeMultiprocessorCount, dev) != hipSuccess) { grid = -1; return; }
        if (hipFuncSetAttribute((const void*)mk_fwd, hipFuncAttributeMaxDynamicSharedMemorySize, LDS_BYTES) != hipSuccess) { fprintf(stderr, "kernel_launch: hipFuncSetAttribute failed\n"); grid = -1; return; }
        if (hipOccupancyMaxActiveBlocksPerMultiprocessor(&per_cu, (const void*)mk_fwd, NTHR, LDS_BYTES) != hipSuccess || per_cu < 1)
            fprintf(stderr, "kernel_launch: note: occupancy query reports %d workgroups per CU\n", per_cu);
        (void)hipGetLastError();
        grid = cus;
    }
    if (grid < 0) return;
    if (hipMemsetAsync((char*)d_ws + WS_CTL, 0, CTL_ZERO_BYTES, stream) != hipSuccess) { fprintf(stderr, "kernel_launch: memset failed\n"); return; }
    Args a{};
    for (int i = 0; i < 22; ++i) a.in[i] = (const float*)d_in[i];
    a.out = (float*)d_out; a.ws = (unsigned char*)d_ws;
#if MK_PER_PHASE
    for (int k = 0; k < NPH; ++k) { a.ph_lo = k; a.ph_hi = k + 1; a.li = k;
        hipLaunchKernelGGL(mk_fwd, dim3(grid), dim3(NTHR), LDS_BYTES, stream, a); }
#else
    a.ph_lo = 0; a.ph_hi = NPH; a.li = 0;
    hipLaunchKernelGGL(mk_fwd, dim3(grid), dim3(NTHR), LDS_BYTES, stream, a);
#endif
    const hipError_t le = hipPeekAtLastError();
    if (le != hipSuccess) fprintf(stderr, "kernel_launch: launch failed: %s\n", hipGetErrorName(le));
}
```

```cpp
#include <hip/hip_runtime.h>
#include <cstdio>
#include <cstdint>

namespace pg8 {
#define PG8_LAS __attribute__((address_space(3)))
typedef unsigned short bf16_t;
typedef short bf16x8 __attribute__((ext_vector_type(8)));
typedef float f32x4 __attribute__((ext_vector_type(4)));
typedef unsigned u32x4 __attribute__((ext_vector_type(4)));
typedef unsigned u32x2 __attribute__((ext_vector_type(2)));
constexpr int BM = 256, BK = 64, HALF = 128, HTB = HALF * BK * 2, STAGE_BYTES = 8 * HTB, NXCD = 8, WGM = 8;

__host__ __device__ __forceinline__ int lds_byte(int r, int c) { const int st = (r >> 4) * 2 + (c >> 5), rr = r & 15, cc = c & 31, ob = rr * 64 + cc * 2; return st * 1024 + (ob ^ (((ob >> 9) & 1) << 5)); }
__host__ __device__ __forceinline__ void stage_rc(int b, int& R, int& C) { const int st = b / 1024, sb = b % 1024, swz = sb ^ (((sb >> 9) & 1) << 5); R = (st >> 1) * 16 + swz / 64; C = (st & 1) * 32 + (swz % 64) / 2; }
__host__ __device__ __forceinline__ int perm32(int rho) { const int n = rho >> 4, i = rho & 15; return 8 * (i >> 2) + 4 * n + (i & 3); }

struct Unit { int pm, pn, z; };
struct Gemm { const bf16_t* A; const bf16_t* Bt; int lda, ldb; size_t zA, zB; int K0, K1; unsigned* dummy; };

struct ZOrder {
    static constexpr bool CUSTOM_NT = false;
    int nM, nN, nZ, ntile, G, c, zinner;
    __device__ void init(int nM_, int nN_, int nZ_, int G_, int c_, int zinner_) { nM = nM_; nN = nN_; nZ = nZ_; ntile = nM_ * nN_; G = G_; c = c_; zinner = zinner_; }
    __device__ void map(int wgid, Unit& u) const {
        { const int q = ntile / NXCD, r = ntile % NXCD, xcd = wgid % NXCD, off = wgid / NXCD; wgid = (xcd < r ? xcd * (q + 1) : r * (q + 1) + (xcd - r) * q) + off; }
        const int nig = WGM * nN, gid = wgid / nig, fm = gid * WGM, gsz = (nM - fm) < WGM ? (nM - fm) : WGM;
        u.pm = fm + ((wgid % nig) % gsz); u.pn = (wgid % nig) / gsz;
    }
    __device__ bool next(int i, Unit& u) const {
        long L; int z;
        if (zinner) { const int ti = i / nZ; z = i - ti * nZ; L = (long)ti * G + c; if (L >= ntile) return false; }
        else { L = (long)i * G + c; if (L >= (long)ntile * nZ) return false; z = (int)(L / ntile); L -= (long)z * ntile; }
        int wgid = (int)L; { const int q = ntile / NXCD, r = ntile % NXCD, xcd = wgid % NXCD, off = wgid / NXCD; wgid = (xcd < r ? xcd * (q + 1) : r * (q + 1) + (xcd - r) * q) + off; }
        const int nig = WGM * nN, gid = wgid / nig, fm = gid * WGM, gsz = (nM - fm) < WGM ? (nM - fm) : WGM;
        u.pm = fm + ((wgid % nig) % gsz); u.pn = (wgid % nig) / gsz; u.z = z; return true;
    }
};

struct MergeOrder {
    static constexpr bool CUSTOM_NT = false;
    ZOrder Z; int G, c, n1;
    __device__ void init(int G_, int c_) { G = G_; c = c_; Z.init(48, 8, 3, G_, c_, 1); const int r = 384 - G_; n1 = (r > 0 && 2 * r <= G_) ? r : 0; }
    __device__ bool next(int i, Unit& u) const {
        bool ok;
        if (n1 == 0 || i < 3) ok = Z.next(i, u);
        else if (c < n1) { ok = i < 5; Z.map(G + c, u); u.z = i - 3; }
        else if (c < 2 * n1) { ok = i < 4; Z.map(G + c - n1, u); u.z = 2; }
        else ok = false;
        u.pm = __builtin_amdgcn_readfirstlane(u.pm); u.pn = __builtin_amdgcn_readfirstlane(u.pn); u.z = __builtin_amdgcn_readfirstlane(u.z);
        return ok;
    }
};

struct SplitKOrder {
    static constexpr bool CUSTOM_NT = true;
    ZOrder Z; int G, c, n1, pm2, pn2, ntf, nt0, nt1;
    __device__ void init(int G_, int c_, int Kfull, int K0h) { G = G_; c = c_; Z.init(48, 8, 1, G_, c_, 0); const int r = 384 - G_; n1 = (r > 0 && 2 * r <= G_) ? r : 0; ntf = Kfull / BK; nt0 = K0h / BK; nt1 = (Kfull - K0h) / BK;
        Unit u2; u2.pm = -1; u2.pn = -1; if (n1 > 0 && c_ < 2 * n1) Z.map(G_ + (c_ < n1 ? c_ : c_ - n1), u2); pm2 = __builtin_amdgcn_readfirstlane(u2.pm); pn2 = __builtin_amdgcn_readfirstlane(u2.pn); }
    __device__ bool next(int i, Unit& u) const {
        bool ok;
        if (n1 == 0) { const int L = i * G + c; ok = L < 384; if (ok) Z.map(L, u); u.z = 0; }
        else if (i == 0) { ok = c < 384; Z.map(c < 384 ? c : 0, u); u.z = 0; }
        else if (i == 1 && c < n1) { ok = true; Z.map(G + c, u); u.z = 0; }
        else if (i == 1 && c < 2 * n1) { ok = true; Z.map(G + c - n1, u); u.z = 1; }
        else ok = false;
        u.pm = __builtin_amdgcn_readfirstlane(u.pm); u.pn = __builtin_amdgcn_readfirstlane(u.pn); u.z = __builtin_amdgcn_readfirstlane(u.z);
        return ok;
    }
    __device__ int nt(const Unit& u) const { const int z1 = (u.z == 1) ? 1 : 0, sp = (u.pm == pm2 && u.pn == pn2) ? 1 : 0; return z1 * nt1 + (1 - z1) * (sp * nt0 + (1 - sp) * ntf); }
};

struct FfnOrder {
    static constexpr bool CUSTOM_NT = false;
    ZOrder Z; int G, c, pre;
    __device__ void init(int G_, int c_, int pre_) { G = G_; c = c_; pre = pre_; Z.init(48, 42, 1, G_, c_, 0); }
    __device__ bool next(int i, Unit& u) const {
        if (pre) { if (i > 0 || c >= 16) return false; u.pm = c; u.pn = 42; u.z = 0; return true; }
        const long L = (long)i * G + c;
        if (L < 2016) return Z.next(i, u);
        if (L >= 2048) return false;
        u.pm = 16 + (int)(L - 2016); u.pn = 42; u.z = 0; return true;
    }
};

struct FfnPreOrder {
    static constexpr bool CUSTOM_NT = true;
    int c, split, ntk;
    __device__ void init(int G_, int c_, int K) { c = c_; split = G_ >= 64 ? 1 : 0; ntk = K / BK; }
    __device__ int nblk() const { return split ? 32 : 16; }
    __device__ bool next(int i, Unit& u) const { if (i > 0 || c >= nblk()) return false; u.pm = c & 15; u.pn = 42; u.z = c >> 4; return true; }
    __device__ int nt(const Unit&) const { return split ? ntk / 2 : ntk; }
};

__device__ __forceinline__ unsigned cvt_pk_bf16(float lo, float hi) { unsigned r; asm volatile("v_cvt_pk_bf16_f32 %0, %1, %2" : "=v"(r) : "v"(lo), "v"(hi)); return r; }

template <class Epi, class Sched>
__device__ __forceinline__ void gemm_phase(PG8_LAS unsigned char* lds, const Gemm g, const Sched& S, const Epi& E, const int tid) {
    const int wid = __builtin_amdgcn_readfirstlane(tid >> 6), lane = tid & 63, wr = wid >> 2, wc = wid & 3, fr = lane & 15, fq = lane >> 4;
    unsigned voffA[2], voffB[2];
#pragma unroll
    for (int i = 0; i < 2; ++i) { int R, C; stage_rc(tid * 16 + i * 8192, R, C); const int Rb = Epi::PERM ? ((R & ~31) + perm32(R & 31)) : R;
        voffA[i] = (unsigned)(R * g.lda + C) * 2u; voffB[i] = (unsigned)(Rb * g.ldb + C) * 2u; }
    const size_t kstep = (size_t)(BK * 2);
    const size_t hA = (size_t)HALF * g.lda * 2, hB = (size_t)HALF * g.ldb * 2;
    const unsigned ldsw = (unsigned)wid * 1024u;
    const int aoff = lds_byte(wr * 64 + fr, fq * 8), boff = lds_byte(wc * 32 + fr, fq * 8);
#define PG8_SA(b, h) (((b) * 2 + (h)) * HTB)
#define PG8_SB(b, h) ((4 + (b) * 2 + (h)) * HTB)
#define PG8_STAGE(bufoff, gbase, voff) do { _Pragma("unroll") for (int _i = 0; _i < 2; ++_i) \
        __builtin_amdgcn_global_load_lds((const unsigned*)((const char*)(gbase) + (voff)[_i]), (PG8_LAS unsigned*)(lds + (bufoff) + ldsw + _i * 8192), 16, 0, 0); } while (0)
#define PG8_LDA(dst, b, h) do { _Pragma("unroll") for (int m = 0; m < 4; ++m) _Pragma("unroll") for (int k = 0; k < 2; ++k) dst[m][k] = *(const PG8_LAS bf16x8*)(lds + PG8_SA(b, h) + aoff + m * 2048 + k * 1024); } while (0)
#define PG8_LDB(dst, b, h) do { _Pragma("unroll") for (int n = 0; n < 2; ++n) _Pragma("unroll") for (int k = 0; k < 2; ++k) dst[n][k] = *(const PG8_LAS bf16x8*)(lds + PG8_SB(b, h) + boff + n * 2048 + k * 1024); } while (0)
#define PG8_MMA(ai, bj, At, Bt) do { __builtin_amdgcn_s_setprio(1); _Pragma("unroll") for (int m = 0; m < 4; ++m) _Pragma("unroll") for (int n = 0; n < 2; ++n) _Pragma("unroll") for (int k = 0; k < 2; ++k) \
        acc[ai][bj][m][n] = __builtin_amdgcn_mfma_f32_16x16x32_bf16(Bt[n][k], At[m][k], acc[ai][bj][m][n], 0, 0, 0); __builtin_amdgcn_s_setprio(0); } while (0)
#define PG8_WAIT_V(n) asm volatile("s_waitcnt vmcnt(" #n ")" ::: "memory")
#define PG8_WAIT_VN(n) asm volatile("s_waitcnt vmcnt(%0)" :: "n"(n) : "memory")
#define PG8_WAIT_L(n) asm volatile("s_waitcnt lgkmcnt(" #n ")" ::: "memory")
#define PG8_BAR __builtin_amdgcn_s_barrier()
#define PG8_SCHED __builtin_amdgcn_sched_barrier(0)
#define PG8_ABASE(u) ((const char*)g.A + ((size_t)(u).z * g.zA) * 2 + (size_t)(u).pm * 2 * hA)
#define PG8_BBASE(u) ((const char*)g.Bt + ((size_t)(u).z * g.zB) * 2 + (size_t)(u).pn * 2 * hB)
    Unit cur, nxt; int ui = 0;
    if (!S.next(0, cur)) return;
    f32x4 acc[2][2][4][2];
#pragma unroll
    for (int a = 0; a < 2; ++a)
#pragma unroll
        for (int b = 0; b < 2; ++b)
#pragma unroll
            for (int m = 0; m < 4; ++m)
#pragma unroll
                for (int n = 0; n < 2; ++n) acc[a][b][m][n] = (f32x4){0.f, 0.f, 0.f, 0.f};
    bf16x8 At[4][2], B0[2][2], B1[2][2];
    const char* cA = PG8_ABASE(cur); const char* cB = PG8_BBASE(cur);
    int nt; if constexpr (Sched::CUSTOM_NT) nt = S.nt(cur); else nt = (cur.z == 0 ? g.K0 : g.K1) / BK;
    PG8_STAGE(PG8_SB(0, 0), cB, voffB); PG8_STAGE(PG8_SB(0, 1), cB + hB, voffB); PG8_STAGE(PG8_SA(0, 0), cA, voffA); PG8_STAGE(PG8_SA(0, 1), cA + hA, voffA);
    if (wr == 1) PG8_BAR;
    PG8_WAIT_V(2); PG8_BAR;
    PG8_STAGE(PG8_SB(1, 0), cB + kstep, voffB); PG8_STAGE(PG8_SA(1, 0), cA + kstep, voffA); PG8_STAGE(PG8_SB(1, 1), cB + hB + kstep, voffB);
    PG8_WAIT_V(6); PG8_BAR;
    if (Epi::NSTORE > 0) { unsigned* dp = g.dummy + blockIdx.x * 512 + tid;
#pragma unroll
        for (int i = 0; i < Epi::NSTORE; ++i) asm volatile("global_store_dword %0, %1, off" :: "v"(dp), "v"(i) : "memory"); }
    for (;;) {
        const bool has_next = S.next(ui + 1, nxt);
        const char* nA = has_next ? PG8_ABASE(nxt) : cA; const char* nB = has_next ? PG8_BBASE(nxt) : cB;
#define PG8_KBODY(WV) do { \
              \
            PG8_LDB(B0, 0, 0); PG8_LDB(B1, 0, 1); PG8_SCHED; PG8_LDA(At, 0, 0); PG8_STAGE(PG8_SA(1, 1), a1 + hA, voffA); \
            PG8_WAIT_VN(WV); PG8_WAIT_L(0); PG8_BAR; PG8_MMA(0, 0, At, B0); PG8_MMA(0, 1, At, B1); PG8_BAR; PG8_SCHED; \
              \
            PG8_LDA(At, 0, 1); PG8_STAGE(PG8_SB(0, 0), b2, voffB); PG8_STAGE(PG8_SB(0, 1), b2 + hB, voffB); PG8_STAGE(PG8_SA(0, 0), a2, voffA); \
            PG8_WAIT_VN(WV); PG8_WAIT_L(0); PG8_BAR; PG8_MMA(1, 0, At, B0); PG8_MMA(1, 1, At, B1); PG8_BAR; PG8_SCHED; \
              \
            PG8_LDB(B0, 1, 0); PG8_LDB(B1, 1, 1); PG8_SCHED; PG8_LDA(At, 1, 0); PG8_STAGE(PG8_SA(0, 1), a2 + hA, voffA); \
            PG8_WAIT_VN(WV); PG8_WAIT_L(0); PG8_BAR; PG8_MMA(0, 0, At, B0); PG8_MMA(0, 1, At, B1); PG8_BAR; PG8_SCHED; \
              \
            PG8_LDA(At, 1, 1); PG8_STAGE(PG8_SB(1, 0), b3, voffB); PG8_STAGE(PG8_SB(1, 1), b3 + hB, voffB); PG8_STAGE(PG8_SA(1, 0), a3, voffA); \
            PG8_WAIT_VN(WV); PG8_WAIT_L(0); PG8_BAR; PG8_MMA(1, 0, At, B0); PG8_MMA(1, 1, At, B1); PG8_BAR; PG8_SCHED; } while (0)
        int t = 0;
        if (Epi::NSTORE > 0) {
            const char* a1 = cA + kstep; const char* a2 = cA + 2 * kstep; const char* b2 = cB + 2 * kstep; const char* a3 = a2 + kstep; const char* b3 = b2 + kstep;
            PG8_KBODY(8 + Epi::NSTORE); t = 2;
        }
        for (; t < nt; t += 2) {
            const bool last = (t == nt - 2);
            const char* a1 = cA + (size_t)(t + 1) * kstep;
            const char* a2 = last ? nA : cA + (size_t)(t + 2) * kstep; const char* b2 = last ? nB : cB + (size_t)(t + 2) * kstep;
            const char* a3 = a2 + kstep; const char* b3 = b2 + kstep;
            PG8_KBODY(8);
        }
#undef PG8_KBODY
        if (wr == 0) PG8_BAR;
        {
            unsigned zz_ = 0u; asm volatile("" : "+v"(zz_)); const int ln_ = (int)__builtin_amdgcn_mbcnt_hi(~0u, __builtin_amdgcn_mbcnt_lo(~0u, zz_));
            E(acc, cur, wr, wc, ln_ & 15, ln_ >> 4);
        }
        if (!has_next) break;
#pragma unroll
        for (int a = 0; a < 2; ++a)
#pragma unroll
            for (int b = 0; b < 2; ++b)
#pragma unroll
                for (int m = 0; m < 4; ++m)
#pragma unroll
                    for (int n = 0; n < 2; ++n) acc[a][b][m][n] = (f32x4){0.f, 0.f, 0.f, 0.f};
        cur = nxt; cA = nA; cB = nB; ++ui; if constexpr (Sched::CUSTOM_NT) nt = S.nt(cur); else nt = (cur.z == 0 ? g.K0 : g.K1) / BK;
        if (wr == 1) PG8_BAR;
    }
    PG8_WAIT_V(0);
    PG8_BAR;
#undef PG8_SA
#undef PG8_SB
#undef PG8_STAGE
#undef PG8_LDA
#undef PG8_LDB
#undef PG8_MMA
#undef PG8_WAIT_V
#undef PG8_WAIT_VN
#undef PG8_WAIT_L
#undef PG8_BAR
#undef PG8_SCHED
#undef PG8_ABASE
#undef PG8_BBASE
}
}

constexpr int DM = 2048, MCTX = 4096, MLAT = 8192, MTOK = 12288;
constexpr int FF = 5504, FF2 = 11008, INC = 13344, INP = 13568;
constexpr int NMOD = 9;
constexpr float EPS = 1e-6f;
constexpr int NWAVES = 8, NTHR = 512;

constexpr size_t MiB = 1u << 20;
constexpr size_t WS_CTL = 0, CTL_ZERO_BYTES = 65536;
constexpr size_t WS_MOD = 1 * MiB;
constexpr size_t WS_ROPE = 1 * MiB + 768 * 1024;
constexpr size_t WS_WFI = 2 * MiB;
constexpr size_t WS_WFO = 174 * MiB;
constexpr size_t WS_WIN = 260 * MiB;
constexpr size_t WS_WBR = 366 * MiB;
constexpr size_t WS_WOUT = 390 * MiB;
constexpr size_t WS_WPOOL = 406 * MiB;
constexpr size_t WS_H = 408 * MiB;
constexpr size_t WS_A = 456 * MiB;
constexpr size_t WS_B = 776 * MiB;
constexpr size_t WS_PL = 968 * MiB;
constexpr size_t WS_BR = 992 * MiB;
constexpr size_t WS_MG = 1064 * MiB;
constexpr size_t WS_CKB = 1112 * MiB;
constexpr size_t WS_CVT = 1120 * MiB;
constexpr size_t WS_QI = 1128 * MiB;
constexpr size_t WS_KI = 1152 * MiB;
constexpr size_t WS_KDT = 1176 * MiB;
constexpr size_t WS_DEC = 1200 * MiB;
constexpr size_t WS_PT = 1202 * MiB;
constexpr size_t WS_END = 1216 * MiB;
constexpr size_t PA_U = 0, PA_NQ = 24 * MiB, PA_NK = 48 * MiB, PA_NV = 72 * MiB, PA_GV = 96 * MiB, PA_GR = 120 * MiB, PA_GQ = 144 * MiB, PA_GK = 156 * MiB, PA_GL = 168 * MiB, PA_GZ = 312 * MiB;

constexpr int CW_MFLAG = 8192;
constexpr int CW_BAR = 4096;
constexpr int RING_BYTES = 131072;
constexpr int LDSCTL_OFF = RING_BYTES, MISC_OFF = LDSCTL_OFF + 320;
constexpr int LDS_BYTES = 155648, TS_OFF = RING_BYTES + 1024, TS_WAVE = 2688;

constexpr int NPH = 34;
#define REP_MIX1 1
#define REP_GEMM 1
#define REP_PRO 1
#define REP_SCAN 1
#define REP_ATT 1
#define REP_FFI 1
#define REP_INP 1
#define REP_FFO 1
#ifndef MK_PER_PHASE
#define MK_PER_PHASE 0
#endif

#define GAS __attribute__((address_space(1)))
#define LAS __attribute__((address_space(3)))
typedef unsigned short bf16;
typedef unsigned v4u __attribute__((ext_vector_type(4)));
typedef unsigned v2u __attribute__((ext_vector_type(2)));
typedef float f32x4 __attribute__((ext_vector_type(4)));
typedef float f32x2 __attribute__((ext_vector_type(2)));
typedef GAS unsigned gu32;
#define RLX_AGENT __ATOMIC_RELAXED, __HIP_MEMORY_SCOPE_AGENT
#define LDS_WAIT() asm volatile("s_waitcnt lgkmcnt(0)" ::: "memory")
__device__ __forceinline__ unsigned f2bf(float f) { unsigned u = __builtin_bit_cast(unsigned, f); return (u + 0x7fffu + ((u >> 16) & 1u)) >> 16; }
__device__ __forceinline__ unsigned pk2(float lo, float hi) { return f2bf(lo) | (f2bf(hi) << 16); }
__device__ __forceinline__ float bflo(unsigned w) { return __builtin_bit_cast(float, w << 16); }
__device__ __forceinline__ float bfhi(unsigned w) { return __builtin_bit_cast(float, w & 0xffff0000u); }
__device__ __forceinline__ float bf2f(bf16 b) { return __builtin_bit_cast(float, ((unsigned)b) << 16); }
__device__ __forceinline__ float sigmoid_f(float x) { return __builtin_amdgcn_rcpf(1.f + __builtin_amdgcn_exp2f(x * -1.4426950408889634f)); }
__device__ __forceinline__ float silu_f(float x) { return x * sigmoid_f(x); }
__device__ __forceinline__ f32x4 sigmoid4(f32x4 x) { const f32x4 t = x * -1.4426950408889634f; f32x4 e; e.x = __builtin_amdgcn_exp2f(t.x); e.y = __builtin_amdgcn_exp2f(t.y); e.z = __builtin_amdgcn_exp2f(t.z); e.w = __builtin_amdgcn_exp2f(t.w);
    const f32x4 d = e + 1.0f; f32x4 r; r.x = __builtin_amdgcn_rcpf(d.x); r.y = __builtin_amdgcn_rcpf(d.y); r.z = __builtin_amdgcn_rcpf(d.z); r.w = __builtin_amdgcn_rcpf(d.w); return r; }

#define XB_TMO      128
#define XB_XCNT(j)  (256  + 64 * (j))
#define XB_XSUB(j)  (1280 + 64 * (j))
#define XB_XGEN(j)  (2304 + 64 * (j))
#define XB_TOP      3328
#define XB_TOPGEN   3392
#define XCD_BAR_WORDS 3456
#define XB_SPIN_CAP (1u << 18)
__device__ __forceinline__ unsigned xb_ld(unsigned* p)              { return __hip_atomic_load(p, __ATOMIC_RELAXED, __HIP_MEMORY_SCOPE_AGENT); }
__device__ __forceinline__ unsigned xb_add(unsigned* p, unsigned v) { return __hip_atomic_fetch_add(p, v, __ATOMIC_RELAXED, __HIP_MEMORY_SCOPE_AGENT); }
__device__ __forceinline__ unsigned xb_xcc_id() { return (unsigned)__builtin_amdgcn_s_getreg((3 << 11) | 20) & 0xFu; }
#define XB_SPIN(cond, bar) do { unsigned _sp = 0; while (cond) { __builtin_amdgcn_s_sleep(1); \
    if ((++_sp & 255u) == 0u) { if (xb_ld(&(bar)[XB_TMO])) break; if (_sp > XB_SPIN_CAP) { atomicAdd(&(bar)[XB_TMO], 1u); break; } } } } while (0)
struct XcdBarrier { unsigned* bar; unsigned x; volatile LAS unsigned* st; };
__device__ __forceinline__ XcdBarrier xcd_barrier_post(unsigned* bar, volatile LAS unsigned* st) {
    XcdBarrier b; b.bar = bar; b.x = (unsigned)__builtin_amdgcn_readfirstlane((int)xb_xcc_id()); b.st = st;
    if (threadIdx.x == 0) (void)xb_add(&bar[XB_XCNT(b.x)], 1u);
    return b;
}
__device__ __forceinline__ void xcd_barrier_complete(unsigned* bar, unsigned x, unsigned& nloc, unsigned& nx) {
    const unsigned G = gridDim.x * gridDim.y * gridDim.z;
    unsigned sum, cnt, mine, sp = 0u;
    for (;;) {
        sum = 0u; cnt = 0u;
#pragma unroll 1
        for (unsigned j = 0; j < 16; ++j) { const unsigned c = xb_ld(&bar[XB_XCNT(j)]); sum += c; cnt += (c > 0u) ? 1u : 0u; }
        if (sum == G) break;
        __builtin_amdgcn_s_sleep(1);
        if ((++sp & 255u) == 0u) { if (xb_ld(&bar[XB_TMO])) break; if (sp > XB_SPIN_CAP) { atomicAdd(&bar[XB_TMO], 1u); break; } }
    }
    mine = xb_ld(&bar[XB_XCNT(x)]);
    nloc = mine > 0u ? mine : 1u; nx = cnt > 0u ? cnt : 1u;
}
static __device__ __forceinline__ void xcd_barrier_impl(unsigned* bar_, unsigned x_, volatile LAS unsigned* st_, int tid_) {
    XcdBarrier b; b.bar = bar_; b.x = x_; b.st = st_;
    asm volatile("s_waitcnt vmcnt(0)" ::: "memory");
    __syncthreads();
    if (tid_ == 0) {
        unsigned* bar = b.bar;
        __builtin_amdgcn_s_waitcnt(0);
        unsigned nloc = b.st[0], nx = b.st[1];
        if (nloc == 0u) { xcd_barrier_complete(bar, b.x, nloc, nx); b.st[0] = nloc; b.st[1] = nx; }
        const unsigned old = xb_add(&bar[XB_XSUB(b.x)], 1u);
        const unsigned gen = old / nloc;
        if (old + 1u == (gen + 1u) * nloc) {
            __builtin_amdgcn_fence(__ATOMIC_RELEASE, "agent");
            asm volatile("s_waitcnt vmcnt(0)" ::: "memory");
            const unsigned og = xb_add(&bar[XB_TOP], 1u);
            const unsigned tg = og / nx;
            if (og + 1u == (tg + 1u) * nx) xb_add(&bar[XB_TOPGEN], 1u);
            else XB_SPIN(xb_ld(&bar[XB_TOPGEN]) == tg, bar);
            __builtin_amdgcn_fence(__ATOMIC_ACQUIRE, "agent");
            xb_add(&bar[XB_XGEN(b.x)], 1u);
            asm volatile("s_waitcnt vmcnt(0)" ::: "memory");
        } else {
            XB_SPIN(xb_ld(&bar[XB_XGEN(b.x)]) == gen, bar);
            __builtin_amdgcn_fence(__ATOMIC_ACQUIRE, "agent");
            asm volatile("s_waitcnt vmcnt(0)" ::: "memory");
        }
    }
    __syncthreads();
}

using pg8::Unit; using pg8::cvt_pk_bf16;
struct EpiSwiGLU {
    static constexpr bool PERM = true; static constexpr int NSTORE = 8;
    bf16* ACT;
    __device__ __forceinline__ void operator()(const f32x4 (&acc)[2][2][4][2], const Unit& u, int wr, int wc, int fr, int fq) const {
        const int row0 = u.pm * 256 + wr * 64 + fr, col0 = u.pn * 128 + wc * 32 + 8 * fq;
#pragma unroll
        for (int ai = 0; ai < 2; ++ai)
#pragma unroll
            for (int m = 0; m < 4; ++m) {
                bf16* rowp = ACT + (size_t)(row0 + ai * 128 + m * 16) * FF + col0;
                const f32x4 v0 = (acc[ai][0][m][0] * acc[ai][1][m][0]) * sigmoid4(acc[ai][0][m][0]), v1 = (acc[ai][0][m][1] * acc[ai][1][m][1]) * sigmoid4(acc[ai][0][m][1]);
                v4u w; w.x = cvt_pk_bf16(v0[0], v0[1]); w.y = cvt_pk_bf16(v0[2], v0[3]); w.z = cvt_pk_bf16(v1[0], v1[1]); w.w = cvt_pk_bf16(v1[2], v1[3]);
                *(v4u*)rowp = w;
            }
    }
};
struct EpiSwiGLUPre {
    static constexpr bool PERM = true; static constexpr int NSTORE = 0;
    bf16* ACT; bf16* P; unsigned* flag; int role;
    __device__ __forceinline__ void operator()(const f32x4 (&acc)[2][2][4][2], const Unit& u, int wr, int wc, int fr, int fq) const {
        const int row0 = u.pm * 256 + wr * 64 + fr, col0 = u.pn * 128 + wc * 32 + 8 * fq;
        const int tidl = (wr * 4 + wc) * 64 + fq * 16 + fr;
        bf16* Pt = P + (size_t)tidl * 8;
        if (role == 2) {
#pragma unroll
            for (int ai = 0; ai < 2; ++ai)
#pragma unroll
                for (int m = 0; m < 4; ++m)
#pragma unroll
                    for (int bj = 0; bj < 2; ++bj) { const f32x4 v0 = acc[ai][bj][m][0], v1 = acc[ai][bj][m][1];
                        v4u w; w.x = cvt_pk_bf16(v0[0], v0[1]); w.y = cvt_pk_bf16(v0[2], v0[3]); w.z = cvt_pk_bf16(v1[0], v1[1]); w.w = cvt_pk_bf16(v1[2], v1[3]);
                        *(v4u*)(Pt + (size_t)(((ai * 4 + m) * 2 + bj) * 512) * 8) = w; }
            asm volatile("s_waitcnt vmcnt(0)" ::: "memory");
            __builtin_amdgcn_s_barrier();
            if (tidl == 0) { __builtin_amdgcn_fence(__ATOMIC_RELEASE, "agent"); asm volatile("s_waitcnt vmcnt(0)" ::: "memory"); __hip_atomic_store(flag, 1u, __ATOMIC_RELAXED, __HIP_MEMORY_SCOPE_AGENT); }
            return;
        }
        if (role == 1) {
            if (tidl == 0) { unsigned sp = 0u; while (__hip_atomic_load(flag, __ATOMIC_RELAXED, __HIP_MEMORY_SCOPE_AGENT) == 0u) { __builtin_amdgcn_s_sleep(2); if (++sp > (1u << 26)) break; }
                __builtin_amdgcn_fence(__ATOMIC_ACQUIRE, "agent"); }
            asm volatile("s_waitcnt vmcnt(0) lgkmcnt(0)" ::: "memory");
            __builtin_amdgcn_s_barrier();
        }
#pragma unroll
        for (int ai = 0; ai < 2; ++ai) {
            v4u hw[4][2];
#pragma unroll
            for (int m = 0; m < 4; ++m)
#pragma unroll
                for (int bj = 0; bj < 2; ++bj) hw[m][bj] = role == 1 ? *(const v4u*)(Pt + (size_t)(((ai * 4 + m) * 2 + bj) * 512) * 8) : (v4u){0u, 0u, 0u, 0u};
#pragma unroll
            for (int m = 0; m < 4; ++m) {
                bf16* rowp = ACT + (size_t)(row0 + ai * 128 + m * 16) * FF + col0;
                const v4u hg = hw[m][0], hu = hw[m][1];
                f32x4 g0 = acc[ai][0][m][0], g1 = acc[ai][0][m][1], u0 = acc[ai][1][m][0], u1 = acc[ai][1][m][1];
                g0[0] += bflo(hg.x); g0[1] += bfhi(hg.x); g0[2] += bflo(hg.y); g0[3] += bfhi(hg.y); g1[0] += bflo(hg.z); g1[1] += bfhi(hg.z); g1[2] += bflo(hg.w); g1[3] += bfhi(hg.w);
                u0[0] += bflo(hu.x); u0[1] += bfhi(hu.x); u0[2] += bflo(hu.y); u0[3] += bfhi(hu.y); u1[0] += bflo(hu.z); u1[1] += bfhi(hu.z); u1[2] += bflo(hu.w); u1[3] += bfhi(hu.w);
                const f32x4 v0 = (g0 * u0) * sigmoid4(g0), v1 = (g1 * u1) * sigmoid4(g1);
                v4u w; w.x = cvt_pk_bf16(v0[0], v0[1]); w.y = cvt_pk_bf16(v0[2], v0[3]); w.z = cvt_pk_bf16(v1[0], v1[1]); w.w = cvt_pk_bf16(v1[2], v1[3]);
                *(v4u*)rowp = w;
            }
            asm volatile("" ::: "memory");
        }
    }
};
struct EpiY {
    static constexpr bool PERM = true; static constexpr int NSTORE = 16;
    bf16* Y; int ldc; unsigned char* ws; int slot, jt, n1, role, pm2, pn2;
    __device__ __forceinline__ void operator()(const f32x4 (&acc)[2][2][4][2], const Unit& u, int wr, int wc, int fr, int fq) const {
        const int row0 = u.pm * 256 + wr * 64 + fr, col0 = u.pn * 256 + wc * 32 + 8 * fq;
        const int tidl = (wr * 4 + wc) * 64 + fq * 16 + fr;
        const bool split = role != 0 && u.pm == pm2 && u.pn == pn2; const int uf = !split ? 0 : role;
        bf16* P = (bf16*)(ws + WS_B + 64 * MiB) + (size_t)jt * 65536 + (size_t)tidl * 8;
        unsigned* cw = (unsigned*)(ws + WS_CTL) + CW_MFLAG;
        if (uf == 1) {
            if (tidl == 0) { const unsigned hx = __hip_atomic_load(cw + n1 + jt, __ATOMIC_RELAXED, __HIP_MEMORY_SCOPE_AGENT) & 15u; unsigned* xflag = cw + 528 + slot * 16 + hx;
                unsigned sp = 0u; while (__hip_atomic_load(xflag, __ATOMIC_RELAXED, __HIP_MEMORY_SCOPE_AGENT) == 0u) { __builtin_amdgcn_s_sleep(2); if (++sp > (1u << 26)) break; }
                __builtin_amdgcn_fence(__ATOMIC_ACQUIRE, "agent"); }
            asm volatile("s_waitcnt vmcnt(0) lgkmcnt(0)" ::: "memory");
            __builtin_amdgcn_s_barrier();
        }
#pragma unroll
        for (int ai = 0; ai < 2; ++ai) {
            v4u hw[4][2];
#pragma unroll
            for (int m = 0; m < 4; ++m)
#pragma unroll
                for (int bj = 0; bj < 2; ++bj) hw[m][bj] = uf == 1 ? *(const v4u*)(P + (size_t)(((ai * 4 + m) * 2 + bj) * 512) * 8) : (v4u){0u, 0u, 0u, 0u};
#pragma unroll
            for (int m = 0; m < 4; ++m) { bf16* rowp = Y + (size_t)(row0 + ai * 128 + m * 16) * ldc + col0;
#pragma unroll
                for (int bj = 0; bj < 2; ++bj) { f32x4 v0 = acc[ai][bj][m][0], v1 = acc[ai][bj][m][1]; const v4u h = hw[m][bj];
                    v0[0] += bflo(h.x); v0[1] += bfhi(h.x); v0[2] += bflo(h.y); v0[3] += bfhi(h.y); v1[0] += bflo(h.z); v1[1] += bfhi(h.z); v1[2] += bflo(h.w); v1[3] += bfhi(h.w);
                    v4u w; w.x = cvt_pk_bf16(v0[0], v0[1]); w.y = cvt_pk_bf16(v0[2], v0[3]); w.z = cvt_pk_bf16(v1[0], v1[1]); w.w = cvt_pk_bf16(v1[2], v1[3]);
                    if (uf == 2) *(v4u*)(P + (size_t)(((ai * 4 + m) * 2 + bj) * 512) * 8) = w;
                    else *(v4u*)(rowp + bj * 128) = w; } }
            asm volatile("" ::: "memory");
        }
        if (uf == 2) {
            asm volatile("s_waitcnt vmcnt(0)" ::: "memory");
            __builtin_amdgcn_s_barrier();
            if (tidl == 0) {
                const unsigned hx = __hip_atomic_load(cw + n1 + jt, __ATOMIC_RELAXED, __HIP_MEMORY_SCOPE_AGENT) & 15u, hcnt = __hip_atomic_load(cw + 384 + hx, __ATOMIC_RELAXED, __HIP_MEMORY_SCOPE_AGENT);
                const unsigned old = __hip_atomic_fetch_add(cw + 400 + slot * 16 + hx, 1u, __ATOMIC_RELAXED, __HIP_MEMORY_SCOPE_AGENT);
                if (old + 1u == hcnt) { __builtin_amdgcn_fence(__ATOMIC_RELEASE, "agent"); asm volatile("s_waitcnt vmcnt(0)" ::: "memory"); __hip_atomic_store(cw + 528 + slot * 16 + hx, 1u, __ATOMIC_RELAXED, __HIP_MEMORY_SCOPE_AGENT); }
            }
        }
    }
};
struct EpiPool {
    static constexpr bool PERM = true; static constexpr int NSTORE = 0;
    bf16* O; const float* scale;
    __device__ __forceinline__ void operator()(const f32x4 (&acc)[2][2][4][2], const Unit& u, int wr, int wc, int fr, int fq) const {
        const int row0 = u.pm * 256 + wr * 64 + fr, col0 = u.z * 256 + wc * 32 + 8 * fq;
        f32x4 sc[2][2];
#pragma unroll
        for (int bj = 0; bj < 2; ++bj)
#pragma unroll
            for (int n = 0; n < 2; ++n) sc[bj][n] = *(const f32x4*)(scale + col0 + bj * 128 + 4 * n);
#pragma unroll
        for (int ai = 0; ai < 2; ++ai)
#pragma unroll
            for (int m = 0; m < 4; ++m) { bf16* rowp = O + (size_t)(row0 + ai * 128 + m * 16) * 1024 + col0;
#pragma unroll
                for (int bj = 0; bj < 2; ++bj) { const f32x4 v0 = acc[ai][bj][m][0] * sc[bj][0], v1 = acc[ai][bj][m][1] * sc[bj][1];
                    v4u w; w.x = cvt_pk_bf16(v0[0], v0[1]); w.y = cvt_pk_bf16(v0[2], v0[3]); w.z = cvt_pk_bf16(v1[0], v1[1]); w.w = cvt_pk_bf16(v1[2], v1[3]);
                    *(v4u*)(rowp + bj * 128) = w; } }
    }
};
struct EpiMerge {
    static constexpr bool PERM = true; static constexpr int NSTORE = 0;
    const bf16* GL; bf16* MS; bf16* MG; unsigned char* ws; int l, jt, n1, role, pm2, pn2;
    __device__ __forceinline__ void operator()(const f32x4 (&acc)[2][2][4][2], const Unit& u, int wr, int wc, int fr, int fq) const {
        const int row0 = u.pm * 256 + wr * 64 + fr, col0 = u.pn * 256 + wc * 32 + 8 * fq;
        const int tidl = (wr * 4 + wc) * 64 + fq * 16 + fr;
        const bool split = role != 0 && u.pm == pm2 && u.pn == pn2; const int uf = !split ? 0 : (role == 1 ? (u.z == 1 ? 1 : 0) : 2);
        const bool first = (u.z == 0) || (uf == 2), fin = (u.z == 2) && (uf == 0);
        bf16* mst = MS + ((size_t)u.pm * 8 + u.pn) * 65536;
        bf16* MS2 = (bf16*)(ws + WS_B + 64 * MiB) + (size_t)jt * 65536;
        bf16* msd = uf == 2 ? MS2 : mst;
#pragma unroll
        for (int ai = 0; ai < 2; ++ai) {
            v4u gw[4][2], mw[4][2];
#pragma unroll
            for (int m = 0; m < 4; ++m)
#pragma unroll
                for (int bj = 0; bj < 2; ++bj) { const size_t cidx = (size_t)(((ai * 4 + m) * 2 + bj) * 512 + tidl) * 8;
                    gw[m][bj] = *(const v4u*)(GL + ((size_t)u.pm * 24 + u.z * 8 + u.pn) * 65536 + cidx);
                    mw[m][bj] = !first ? *(const v4u*)(mst + cidx) : (v4u){0u, 0u, 0u, 0u}; }
#pragma unroll
            for (int m = 0; m < 4; ++m)
#pragma unroll
                for (int bj = 0; bj < 2; ++bj) { const size_t row = (size_t)(row0 + ai * 128 + m * 16); const int col = col0 + bj * 128; const size_t cidx = (size_t)(((ai * 4 + m) * 2 + bj) * 512 + tidl) * 8;
                    const v4u g = gw[m][bj], q = mw[m][bj];
                    f32x4 v0 = acc[ai][bj][m][0], v1 = acc[ai][bj][m][1];
                    v0[0] = v0[0] * bflo(g.x) + bflo(q.x); v0[1] = v0[1] * bfhi(g.x) + bfhi(q.x); v0[2] = v0[2] * bflo(g.y) + bflo(q.y); v0[3] = v0[3] * bfhi(g.y) + bfhi(q.y);
                    v1[0] = v1[0] * bflo(g.z) + bflo(q.z); v1[1] = v1[1] * bfhi(g.z) + bfhi(q.z); v1[2] = v1[2] * bflo(g.w) + bflo(q.w); v1[3] = v1[3] * bfhi(g.w) + bfhi(q.w);
                    v4u w; w.x = cvt_pk_bf16(v0[0], v0[1]); w.y = cvt_pk_bf16(v0[2], v0[3]); w.z = cvt_pk_bf16(v1[0], v1[1]); w.w = cvt_pk_bf16(v1[2], v1[3]);
                    if (!fin) *(v4u*)(msd + cidx) = w;
                    else *(v4u*)(MG + row * DM + col) = w; }
            asm volatile("" ::: "memory");
        }
        if (uf == 2) {
            asm volatile("s_waitcnt vmcnt(0)" ::: "memory");
            __builtin_amdgcn_s_barrier();
            if (tidl == 0) {
                unsigned* cw = (unsigned*)(ws + WS_CTL) + CW_MFLAG;
                const unsigned hx = __hip_atomic_load(cw + n1 + jt, __ATOMIC_RELAXED, __HIP_MEMORY_SCOPE_AGENT) & 15u, hcnt = __hip_atomic_load(cw + 384 + hx, __ATOMIC_RELAXED, __HIP_MEMORY_SCOPE_AGENT);
                unsigned* done = cw + 400 + l * 16 + hx; unsigned* xflag = cw + 528 + l * 16 + hx;
                const unsigned old = __hip_atomic_fetch_add(done, 1u, __ATOMIC_RELAXED, __HIP_MEMORY_SCOPE_AGENT);
                if (old + 1u == hcnt) { __builtin_amdgcn_fence(__ATOMIC_RELEASE, "agent"); asm volatile("s_waitcnt vmcnt(0)" ::: "memory"); __hip_atomic_store(xflag, 1u, __ATOMIC_RELAXED, __HIP_MEMORY_SCOPE_AGENT); }
            }
        }
        if (uf == 1) {
            if (tidl == 0) { unsigned* cw = (unsigned*)(ws + WS_CTL) + CW_MFLAG; const unsigned hx = __hip_atomic_load(cw + n1 + jt, __ATOMIC_RELAXED, __HIP_MEMORY_SCOPE_AGENT) & 15u; unsigned* xflag = cw + 528 + l * 16 + hx;
                unsigned sp = 0u; while (__hip_atomic_load(xflag, __ATOMIC_RELAXED, __HIP_MEMORY_SCOPE_AGENT) == 0u) { __builtin_amdgcn_s_sleep(2); if (++sp > (1u << 26)) break; }
                __builtin_amdgcn_fence(__ATOMIC_ACQUIRE, "agent"); }
            asm volatile("s_waitcnt vmcnt(0) lgkmcnt(0)" ::: "memory");
            __builtin_amdgcn_s_barrier();
#pragma unroll
            for (int ai = 0; ai < 2; ++ai) {
                v4u mw[4][2], hw[4][2];
#pragma unroll
                for (int m = 0; m < 4; ++m)
#pragma unroll
                    for (int bj = 0; bj < 2; ++bj) { const size_t cidx = (size_t)(((ai * 4 + m) * 2 + bj) * 512 + tidl) * 8; mw[m][bj] = *(const v4u*)(mst + cidx); hw[m][bj] = *(const v4u*)(MS2 + cidx); }
#pragma unroll
                for (int m = 0; m < 4; ++m)
#pragma unroll
                    for (int bj = 0; bj < 2; ++bj) { const size_t row = (size_t)(row0 + ai * 128 + m * 16); const int col = col0 + bj * 128; const v4u q = mw[m][bj], h = hw[m][bj];
                        v4u w; w.x = cvt_pk_bf16(bflo(q.x) + bflo(h.x), bfhi(q.x) + bfhi(h.x)); w.y = cvt_pk_bf16(bflo(q.y) + bflo(h.y), bfhi(q.y) + bfhi(h.y));
                        w.z = cvt_pk_bf16(bflo(q.z) + bflo(h.z), bfhi(q.z) + bfhi(h.z)); w.w = cvt_pk_bf16(bflo(q.w) + bflo(h.w), bfhi(q.w) + bfhi(h.w));
                        *(v4u*)(MG + row * DM + col) = w; }
                asm volatile("" ::: "memory");
            }
        }
    }
};
struct EpiInProj {
    static constexpr bool PERM = true; static constexpr int NSTORE = 0;
    unsigned char* PA; float* outK; float* outV; const f32x2* rope; int l; LAS unsigned char* ts;
    __device__ __forceinline__ void operator()(const f32x4 (&acc)[2][2][4][2], const Unit& u, int wr, int wc, int fr, int fq) const {
        const int pn = u.pn;
        const int rl0 = wr * 64 + fr;
        const int cl = wc * 32 + 8 * fq;
        if (pn >= 16 && pn < 20) {
            const bool isq = pn < 18; const int hp = (pn - 16) & 1;
            bf16* G = (bf16*)(PA + (isq ? PA_GQ : PA_GK));
            const float qs = isq ? 0.08838834764831845f : 1.0f;
            const int head = 2 * hp + (wc >> 1), axis = wc & 1, j0 = 8 * fq;
            const bool lat = u.pm >= 16;
#pragma unroll
            for (int ai = 0; ai < 2; ++ai)
#pragma unroll
                for (int m = 0; m < 4; ++m) {
                    const int row = u.pm * 256 + rl0 + ai * 128 + m * 16;
                    float o1[8], o2[8];
                    int pos = 0;
                    if (lat) { const int t = (row - MCTX) & 2047; pos = axis ? (t & 63) : (t >> 6); }
#pragma unroll
                    for (int n = 0; n < 2; ++n)
#pragma unroll
                        for (int i = 0; i < 4; ++i) {
                            const float x1 = acc[ai][0][m][n][i], x2 = acc[ai][1][m][n][i];
                            float c = 1.f, s = 0.f;
                            if (lat) { const f32x2 cs = rope[pos * 32 + j0 + 4 * n + i]; c = cs.x; s = cs.y; }
                            o1[n * 4 + i] = (x1 * c - x2 * s) * qs; o2[n * 4 + i] = (x2 * c + x1 * s) * qs;
                        }
                    bf16* p1 = G + (size_t)row * 512 + head * 128 + axis * 64 + j0;
                    v4u w; w.x = cvt_pk_bf16(o1[0], o1[1]); w.y = cvt_pk_bf16(o1[2], o1[3]); w.z = cvt_pk_bf16(o1[4], o1[5]); w.w = cvt_pk_bf16(o1[6], o1[7]);
                    *(v4u*)p1 = w;
                    w.x = cvt_pk_bf16(o2[0], o2[1]); w.y = cvt_pk_bf16(o2[2], o2[3]); w.z = cvt_pk_bf16(o2[4], o2[5]); w.w = cvt_pk_bf16(o2[6], o2[7]);
                    *(v4u*)(p1 + 32) = w;
                    asm volatile("" ::: "memory");
                }
            return;
        }
        if (pn == 52) {
            if (wc == 0) {
                float* GZ = (float*)(PA + PA_GZ);
#pragma unroll
                for (int ai = 0; ai < 2; ++ai)
#pragma unroll
                    for (int m = 0; m < 4; ++m) { float* rowp = GZ + (size_t)(u.pm * 256 + rl0 + ai * 128 + m * 16) * 32 + 8 * fq;
                        *(f32x4*)rowp = acc[ai][0][m][0]; *(f32x4*)(rowp + 4) = acc[ai][0][m][1]; }
            }
            return;
        }
        const size_t rowb = (size_t)u.pm * 256 + rl0;
#define IP_LOOP(...) do { _Pragma("unroll") for (int ai = 0; ai < 2; ++ai) _Pragma("unroll") for (int m = 0; m < 4; ++m) { const int rl = rl0 + ai * 128 + m * 16; const size_t row = rowb + ai * 128 + m * 16; (void)rl; \
            _Pragma("unroll") for (int bj = 0; bj < 2; ++bj) { f32x4 v0 = acc[ai][bj][m][0], v1 = acc[ai][bj][m][1]; __VA_ARGS__ } asm volatile("" ::: "memory"); } } while (0)
#define IP_PACK_STORE(ptr) do { v4u w_; w_.x = cvt_pk_bf16(v0[0], v0[1]); w_.y = cvt_pk_bf16(v0[2], v0[3]); w_.z = cvt_pk_bf16(v1[0], v1[1]); w_.w = cvt_pk_bf16(v1[2], v1[3]); __builtin_nontemporal_store(w_, (v4u*)(ptr)); } while (0)
#define IP_F32_COPY(fout, tcol_) do { float* fp_ = (fout) + ((((size_t)u.pm * 2 + l) * 8 + ((tcol_) >> 7) + bj) * 256 + rl) * 128 + cl; __builtin_nontemporal_store(v0, (f32x4*)fp_); __builtin_nontemporal_store(v1, (f32x4*)(fp_ + 4)); } while (0)
#define IP_TRANS_STORE(O_, tcol_) do { bf16* tp_ = (O_) + (size_t)((tcol_) + bj * 128 + cl) * MTOK + row; const unsigned p0_ = cvt_pk_bf16(v0[0], v0[1]), p1_ = cvt_pk_bf16(v0[2], v0[3]), p2_ = cvt_pk_bf16(v1[0], v1[1]), p3_ = cvt_pk_bf16(v1[2], v1[3]); \
            tp_[0] = (bf16)p0_; tp_[(size_t)MTOK] = (bf16)(p0_ >> 16); tp_[(size_t)2 * MTOK] = (bf16)p1_; tp_[(size_t)3 * MTOK] = (bf16)(p1_ >> 16); \
            tp_[(size_t)4 * MTOK] = (bf16)p2_; tp_[(size_t)5 * MTOK] = (bf16)(p2_ >> 16); tp_[(size_t)6 * MTOK] = (bf16)p3_; tp_[(size_t)7 * MTOK] = (bf16)(p3_ >> 16); } while (0)
#define IP_TRANSPOSE(KIND, ...) do { LAS bf16* T_ = (LAS bf16*)(ts + (wr * 4 + wc) * TS_WAVE); const int ln_ = fq * 16 + fr; \
            _Pragma("unroll") for (int ai = 0; ai < 2; ++ai) _Pragma("unroll") for (int bj = 0; bj < 2; ++bj) _Pragma("unroll") for (int mp = 0; mp < 2; ++mp) { \
                _Pragma("unroll") for (int ml = 0; ml < 2; ++ml) { const f32x4 v0 = acc[ai][bj][2 * mp + ml][0], v1 = acc[ai][bj][2 * mp + ml][1]; \
                    const unsigned p0_ = cvt_pk_bf16(v0[0], v0[1]), p1_ = cvt_pk_bf16(v0[2], v0[3]), p2_ = cvt_pk_bf16(v1[0], v1[1]), p3_ = cvt_pk_bf16(v1[2], v1[3]); \
                    LAS bf16* d_ = T_ + (8 * fq) * 40 + fq * 16 + ((KIND) == 0 ? ml * 16 + fr : (fr >> 2) * 8 + ml * 4 + (fr & 3)); \
                    d_[0] = (bf16)p0_; d_[40] = (bf16)(p0_ >> 16); d_[80] = (bf16)p1_; d_[120] = (bf16)(p1_ >> 16); d_[160] = (bf16)p2_; d_[200] = (bf16)(p2_ >> 16); d_[240] = (bf16)p3_; d_[280] = (bf16)(p3_ >> 16); } \
                _Pragma("unroll") for (int h_ = 0; h_ < 2; ++h_) { const int q_ = ln_ + 64 * h_, c_ = q_ >> 2, k_ = q_ & 3; const v4u w_ = *(const LAS v4u*)(T_ + c_ * 40 + (c_ >> 3) * 16 + 8 * k_); __VA_ARGS__ } \
                asm volatile("" ::: "memory"); } } while (0)
        if (pn < 8) {
            bf16* O = (bf16*)(PA + (pn < 4 ? PA_U : PA_NQ)); const int tcol = (pn & 3) * 256; const float scl = pn < 4 ? 1.0f : 0.08838834764831845f * 1.4426950408889634f;
            IP_LOOP({ v0 *= scl; v1 *= scl; IP_PACK_STORE(O + row * 1024 + tcol + bj * 128 + cl); });
        } else if (pn < 12) {
            bf16* O = (bf16*)(PA + PA_NK); const int tcol = (pn - 8) * 256;
            if (u.pm < 16) IP_LOOP({ IP_F32_COPY(outK, tcol); IP_PACK_STORE(O + row * 1024 + tcol + bj * 128 + cl); });
            else IP_LOOP({ IP_PACK_STORE(O + row * 1024 + tcol + bj * 128 + cl); });
        } else if (pn < 16) {
            bf16* O = (bf16*)(PA + PA_NV); const int tcol = (pn - 12) * 256;
            if (u.pm < 16) IP_LOOP({ IP_F32_COPY(outV, tcol); });
            IP_TRANSPOSE(0, { *(v4u*)(O + (size_t)(tcol + bj * 128 + wc * 32 + c_) * MTOK + ((size_t)u.pm * 256 + ai * 128 + wr * 64 + 32 * mp + 8 * k_)) = w_; });
        } else if (pn < 24) {
            bf16* O = (bf16*)(PA + PA_GV); const int tcol = (pn - 20) * 256;
            IP_TRANSPOSE(1, { const int e_ = tcol + bj * 128 + wc * 32 + c_, chunk_ = u.pm * 4 + ai * 2 + wr;
                *(v4u*)((unsigned char*)O + ((size_t)chunk_ * 64 + (e_ >> 4)) * 2048 + (size_t)((k_ * 16 + (e_ & 15)) * 32) + mp * 16) = w_; });
        } else if (pn < 28) {
            bf16* O = (bf16*)(PA + PA_GR); const int tcol = (pn - 24) * 256;
            IP_LOOP({ v0 = v0 * sigmoid4(v0); v1 = v1 * sigmoid4(v1); IP_PACK_STORE(O + row * 1024 + tcol + bj * 128 + cl); });
        } else {
            bf16* O = (bf16*)(PA + PA_GL) + ((size_t)u.pm * 24 + (pn - 28)) * 65536 + (size_t)((wr * 4 + wc) * 64 + fq * 16 + fr) * 8;
            IP_LOOP({ v0 = sigmoid4(v0); v1 = sigmoid4(v1); IP_PACK_STORE(O + (size_t)(((ai * 4 + m) * 2 + bj) * 512) * 8); });
        }
#undef IP_TRANSPOSE
#undef IP_LOOP
#undef IP_PACK_STORE
#undef IP_F32_COPY
#undef IP_TRANS_STORE
    }
};

template <int CTRL> __device__ __forceinline__ float dpp_mov(float v) { return __builtin_bit_cast(float, __builtin_amdgcn_update_dpp(0, __builtin_bit_cast(int, v), CTRL, 0xf, 0xf, false)); }
__device__ __forceinline__ float rdlane(float v, int l) { return __builtin_bit_cast(float, __builtin_amdgcn_readlane(__builtin_bit_cast(int, v), l)); }
__device__ __forceinline__ float row16_sum(float v) {
    v += dpp_mov<0xB1>(v); v += dpp_mov<0x4E>(v); v += dpp_mov<0x141>(v); v += dpp_mov<0x140>(v); return v; }
__device__ __forceinline__ float row16_max(float v) {
    v = fmaxf(v, dpp_mov<0xB1>(v)); v = fmaxf(v, dpp_mov<0x4E>(v)); v = fmaxf(v, dpp_mov<0x141>(v)); v = fmaxf(v, dpp_mov<0x140>(v)); return v; }
__device__ __forceinline__ float wave_sum(float v) { v = row16_sum(v); return (rdlane(v, 0) + rdlane(v, 16)) + (rdlane(v, 32) + rdlane(v, 48)); }
__device__ __forceinline__ float wave_max(float v) { v = row16_max(v); return fmaxf(fmaxf(rdlane(v, 0), rdlane(v, 16)), fmaxf(rdlane(v, 32), rdlane(v, 48))); }
__device__ __forceinline__ void p0_transpose_item(const float* W, int K, int N, bf16* WT, int dst_row0, LAS float* scr, int kb, int nb, int lane) {
    const int k0 = 64 * kb, n0 = 32 * nb;
#pragma unroll 8
    for (int i = 0; i < 32; ++i) { const int kk = 2 * i + (lane >> 5); scr[kk * 33 + (lane & 31)] = W[(size_t)(k0 + kk) * N + n0 + (lane & 31)]; }
    LDS_WAIT(); asm volatile("" ::: "memory");
    const int c = lane & 7;
#pragma unroll
    for (int j = 0; j < 4; ++j) { const int n = (lane >> 3) + 8 * j; const LAS float* s = scr + (8 * c) * 33 + n;
        v4u o; o.x = pk2(s[0 * 33], s[1 * 33]); o.y = pk2(s[2 * 33], s[3 * 33]); o.z = pk2(s[4 * 33], s[5 * 33]); o.w = pk2(s[6 * 33], s[7 * 33]);
        *(GAS v4u*)(WT + (size_t)(dst_row0 + n) * K + k0 + 8 * c) = o; }
    LDS_WAIT(); asm volatile("" ::: "memory");
}
__device__ __forceinline__ int win_dst(int n0) {
    if (n0 < 4096) return n0;
    if (n0 < 5120) { const int base = n0 < 4608 ? 4096 : 4608, dd = n0 - base, hh = dd >> 7, w = dd & 127, axis = w >> 6, half = (w >> 5) & 1;
        return base + 256 * (hh >> 1) + 128 * half + (hh & 1) * 64 + axis * 32; }
    if (n0 < 6144) return n0;
    if (n0 < 6176) return 13312;
    return n0 - 32;
}

struct Args { const float* in[22]; float* out; unsigned char* ws; int ph_lo, ph_hi, li, pad; };
#define AS4 __attribute__((address_space(4)))
typedef const AS4 unsigned char* kargp;
#define KARG ((kargp)__builtin_amdgcn_kernarg_segment_ptr())
__device__ __forceinline__ const float* arg_in(kargp ka, int i) { return *(const float* const AS4*)(ka + 8 * i); }
__device__ __forceinline__ float* arg_out(kargp ka) { return *(float* const AS4*)(ka + 176); }
__device__ __forceinline__ unsigned char* arg_ws(kargp ka) { return *(unsigned char* const AS4*)(ka + 184); }
__device__ __forceinline__ int arg_i(kargp ka, int off) { return *(const int AS4*)(ka + off); }

template <bool FIRST, bool LAST>
__device__ __forceinline__ void norm_rows(kargp ka, int gw, int NGW, int lane, const bf16* Y, const float* post, int li, int gi, float resw, const float* pre, int ln, int gn, int row_lo, int row_hi) {
    const float* MOD = (const float*)(arg_ws(ka) + WS_MOD);
    bf16* H = (bf16*)(arg_ws(ka) + WS_H);
    const int R = (row_hi - row_lo + NGW - 1) / NGW, r0 = row_lo + gw * R, r1 = r0 + R < row_hi ? r0 + R : row_hi;
    int vcur = -1;
    f32x4 cg[8], cb[8], cs[8];
#pragma unroll
    for (int j = 0; j < 8; ++j) { cg[j] = (f32x4){0.f, 0.f, 0.f, 0.f}; cb[j] = cg[j]; cs[j] = cg[j]; }
    for (int row = r0; row < r1; ++row) {
        const int v = row < MCTX ? 0 : 1 + ((row - MCTX) >> 11);
        const float* xin = FIRST ? (row < MCTX ? arg_in(ka, 0) + (size_t)row * DM : arg_in(ka, 1) + (size_t)(row - MCTX) * DM) : arg_out(ka) + (size_t)row * DM;
        const f32x4* xr = (const f32x4*)xin + lane;
        f32x4 x[8]; v2u yw[8];
#pragma unroll
        for (int j = 0; j < 8; ++j) x[j] = xr[64 * j];
        if (!FIRST) { const v2u* y0 = (const v2u*)(Y + (size_t)row * DM) + lane;
#pragma unroll
            for (int j = 0; j < 8; ++j) yw[j] = y0[64 * j]; }
        if (v != vcur) {
            vcur = v;
            if (!FIRST) { const f32x4* pg = (const f32x4*)post + lane; const f32x4* gt = (const f32x4*)(MOD + (size_t)((v * 2 + li) * NMOD + 3 * gi + 2) * DM) + lane;
#pragma unroll
                for (int j = 0; j < 8; ++j) cg[j] = (gt[64 * j] * resw) * pg[64 * j]; }
            if (!LAST) { const f32x4* pg = (const f32x4*)pre + lane;
                const f32x4* sh = (const f32x4*)(MOD + (size_t)((v * 2 + ln) * NMOD + 3 * gn + 0) * DM) + lane;
                const f32x4* sc = (const f32x4*)(MOD + (size_t)((v * 2 + ln) * NMOD + 3 * gn + 1) * DM) + lane;
#pragma unroll
                for (int j = 0; j < 8; ++j) { cb[j] = pg[64 * j] * (sc[64 * j] + 1.0f); cs[j] = sh[64 * j]; } }
        }
        if (!FIRST) {
            float ss = 0.f;
#pragma unroll
            for (int j = 0; j < 8; ++j) { const v2u a = yw[j]; const float y0f = bflo(a.x), y1f = bfhi(a.x), y2f = bflo(a.y), y3f = bfhi(a.y);
                ss += (y0f * y0f + y1f * y1f) + (y2f * y2f + y3f * y3f); }
            const float rstd = 1.0f / sqrtf(wave_sum(ss) * (1.f / DM) + EPS);
#pragma unroll
            for (int j = 0; j < 8; ++j) { const v2u a = yw[j]; f32x4 yj; yj.x = bflo(a.x); yj.y = bfhi(a.x); yj.z = bflo(a.y); yj.w = bfhi(a.y);
                x[j] = x[j] + cg[j] * (yj * rstd); }
        }
        f32x4* xo = (f32x4*)(arg_out(ka) + (size_t)row * DM) + lane;
#pragma unroll
        for (int j = 0; j < 8; ++j) xo[64 * j] = x[j];
        if (!LAST) {
            float ss = 0.f;
#pragma unroll
            for (int j = 0; j < 8; ++j) ss += (x[j].x * x[j].x + x[j].y * x[j].y) + (x[j].z * x[j].z + x[j].w * x[j].w);
            const float rstd = 1.0f / sqrtf(wave_sum(ss) * (1.f / DM) + EPS);
            v2u* ho = (v2u*)(H + (size_t)row * DM) + lane;
#pragma unroll
            for (int j = 0; j < 8; ++j) { const f32x4 h = (x[j] * rstd) * cb[j] + cs[j];
                v2u w; w.x = cvt_pk_bf16(h.x, h.y); w.y = cvt_pk_bf16(h.z, h.w); ho[64 * j] = w; }
        }
    }
}

typedef short bf16x8v __attribute__((ext_vector_type(8)));
__device__ __forceinline__ float swz16(float v) { return __builtin_bit_cast(float, __builtin_amdgcn_ds_swizzle(__builtin_bit_cast(int, v), 0x401F)); }
__device__ __forceinline__ void pl32swap(unsigned& a, unsigned& b) { asm volatile("s_nop 1\n\tv_permlane32_swap_b32 %0, %1" : "+v"(a), "+v"(b)); }
__device__ __forceinline__ float xmax32(float v) { unsigned a = __builtin_bit_cast(unsigned, v), b = a; pl32swap(a, b); return fmaxf(__builtin_bit_cast(float, a), __builtin_bit_cast(float, b)); }
__device__ __forceinline__ float xsum32(float v) { unsigned a = __builtin_bit_cast(unsigned, v), b = a; pl32swap(a, b); return __builtin_bit_cast(float, a) + __builtin_bit_cast(float, b); }
template <int NQT, bool LATENT>
__device__ __forceinline__ void attn_block(LAS unsigned char* lds, int wave, int lane, const bf16* NQ, const float* rpbh, bf16* BR1,
                                           int q0, int h, int rs, int r, int ct0, int qc0, int Rlo, int nloc,
                                           const char* lksrc, const char* lvsrc  ,
                                           const char* ksrc, unsigned krs, const char* vsrc, unsigned vrs, int nshared) {
    asm volatile("" : "+v"(lane));
    const int fr = lane & 15, g = lane >> 4;
    const int nstage = nloc + nshared;
#define AT_DMA(bufi, st_) do { int ln_ = lane; asm volatile("" : "+v"(ln_));   \
        const bool lc_ = (st_) < nloc; const int si_ = lc_ ? (st_) : (st_) - nloc; const bool kw_ = wave < 4; \
        const unsigned strd_ = kw_ ? (lc_ ? 2048u : krs) : (lc_ ? (unsigned)(MTOK * 2) : vrs); \
        const char* sb_ = kw_ ? (lc_ ? lksrc + (size_t)si_ * 128u * 2048u : ksrc + (size_t)si_ * 128u * krs) : (lc_ ? lvsrc : vsrc) + (size_t)si_ * 256u; \
        const char* lb_ = sb_ + (size_t)(32 * (wave & 3) + (ln_ >> 4)) * strd_; \
        _Pragma("unroll") for (int j_ = 0; j_ < 8; ++j_) { const int c_ = (ln_ & 15) ^ ((4 * j_ + (ln_ >> 4)) & 15); \
        __builtin_amdgcn_global_load_lds((const unsigned*)(lb_ + (size_t)(4 * j_) * strd_ + c_ * 16), (LAS unsigned*)(lds + (bufi) * 65536 + (wave * 8 + j_) * 1024), 16, 0, 0); } } while (0)
    AT_DMA(0, 0);
    if (nstage > 1) AT_DMA(1, 1);
    LAS float* rpbl = (LAS float*)(lds + TS_OFF);
    if (LATENT) { for (int e = wave * 64 + lane; e < 465; e += NTHR) rpbl[e] = rpbh[e] * 1.4426950408889634f; asm volatile("s_waitcnt lgkmcnt(0)" ::: "memory"); }
    bf16x8v Qf[NQT][4];
#pragma unroll
    for (int qt = 0; qt < NQT; ++qt)
#pragma unroll
        for (int kk = 0; kk < 4; ++kk) Qf[qt][kk] = *(const bf16x8v*)(NQ + (size_t)(q0 + qt * 16 + fr) * 1024 + h * 128 + kk * 32 + g * 8);
    f32x4 O[NQT][8]; float m[NQT], lsum[NQT];
#pragma unroll
    for (int qt = 0; qt < NQT; ++qt) { m[qt] = -1e30f; lsum[qt] = 0.f;
#pragma unroll
        for (int d = 0; d < 8; ++d) O[qt][d] = (f32x4){0.f, 0.f, 0.f, 0.f}; }
#define AT_STEP(MASKED, ka0_, kb0_, ria, cta, rib, ctb, bok_) do { \
        f32x4 sa[NQT], sb[NQT]; \
        _Pragma("unroll") for (int qt = 0; qt < NQT; ++qt) { sa[qt] = (f32x4){0.f, 0.f, 0.f, 0.f}; sb[qt] = (f32x4){0.f, 0.f, 0.f, 0.f}; } \
        _Pragma("unroll") for (int kk = 0; kk < 4; ++kk) { const int ra = (ka0_) + fr, rb = (kb0_) + fr; \
            const bf16x8v Ka = *(const LAS bf16x8v*)(Kimg + ra * 256 + (((kk * 4 + g) ^ (ra & 15)) * 16)), Kb = *(const LAS bf16x8v*)(Kimg + rb * 256 + (((kk * 4 + g) ^ (rb & 15)) * 16)); \
            __builtin_amdgcn_s_setprio(1); _Pragma("unroll") for (int qt = 0; qt < NQT; ++qt) { sa[qt] = __builtin_amdgcn_mfma_f32_16x16x32_bf16(Ka, Qf[qt][kk], sa[qt], 0, 0, 0); sb[qt] = __builtin_amdgcn_mfma_f32_16x16x32_bf16(Kb, Qf[qt][kk], sb[qt], 0, 0, 0); } __builtin_amdgcn_s_setprio(0); } \
        bf16x8v P[NQT]; \
        _Pragma("unroll") for (int qt = 0; qt < NQT; ++qt) { \
            bool va[4] = {true, true, true, true}, vb[4] = {true, true, true, true}; \
            if (MASKED) { \
                const int c = qc0 + qt * 16 + fr; int cs = c - 8; cs = cs < 0 ? 0 : (cs > 48 ? 48 : cs); \
                _Pragma("unroll") for (int i = 0; i < 4; ++i) { \
                    const int kca = (cta) * 16 + 4 * g + i, kcb = (ctb) * 16 + 4 * g + i; \
                    va[i] = (kca >= cs) && (kca < cs + 16); vb[i] = (bok_) && (kcb >= cs) && (kcb < cs + 16); \
                    const float ba = va[i] ? rpbl[((ria) - r + 7) * 31 + (kca - c + 15)] : 0.f; \
                    const float bb = vb[i] ? rpbl[((rib) - r + 7) * 31 + (kcb - c + 15)] : 0.f; \
                    sa[qt][i] = va[i] ? sa[qt][i] + ba : -1e30f; sb[qt][i] = vb[i] ? sb[qt][i] + bb : -1e30f; } } \
            float mx = fmaxf(fmaxf(fmaxf(sa[qt][0], sa[qt][1]), fmaxf(sa[qt][2], sa[qt][3])), fmaxf(fmaxf(sb[qt][0], sb[qt][1]), fmaxf(sb[qt][2], sb[qt][3]))); \
            mx = fmaxf(mx, swz16(mx)); mx = xmax32(mx); \
            const float mn = fmaxf(m[qt], mx), alpha = exp2f(m[qt] - mn); m[qt] = mn; \
            float pa[4], pb[4], ps = 0.f; \
            _Pragma("unroll") for (int i = 0; i < 4; ++i) { pa[i] = va[i] ? exp2f(sa[qt][i] - mn) : 0.f; pb[i] = vb[i] ? exp2f(sb[qt][i] - mn) : 0.f; ps += pa[i] + pb[i]; } \
            lsum[qt] = lsum[qt] * alpha + ps; \
            _Pragma("unroll") for (int d = 0; d < 8; ++d) O[qt][d] *= alpha; \
            v4u pw; pw.x = cvt_pk_bf16(pa[0], pa[1]); pw.y = cvt_pk_bf16(pa[2], pa[3]); pw.z = cvt_pk_bf16(pb[0], pb[1]); pw.w = cvt_pk_bf16(pb[2], pb[3]); \
            P[qt] = __builtin_bit_cast(bf16x8v, pw); } \
        _Pragma("unroll") for (int d = 0; d < 8; ++d) { const int rv = 16 * d + fr; \
            const v2u Va = *(const LAS v2u*)(Vimg + rv * 256 + (((((ka0_) >> 3) + (g >> 1)) ^ (rv & 15)) * 16) + 8 * (g & 1)); \
            const v2u Vb = *(const LAS v2u*)(Vimg + rv * 256 + (((((kb0_) >> 3) + (g >> 1)) ^ (rv & 15)) * 16) + 8 * (g & 1)); \
            v4u vw; vw.x = Va.x; vw.y = Va.y; vw.z = Vb.x; vw.w = Vb.y; const bf16x8v Vf = __builtin_bit_cast(bf16x8v, vw); \
            __builtin_amdgcn_s_setprio(1); _Pragma("unroll") for (int qt = 0; qt < NQT; ++qt) O[qt][d] = __builtin_amdgcn_mfma_f32_16x16x32_bf16(Vf, P[qt], O[qt][d], 0, 0, 0); __builtin_amdgcn_s_setprio(0); } } while (0)
    for (int sg = 0; sg < nstage; ++sg) {
        asm volatile("s_waitcnt vmcnt(0)" ::: "memory");
        __builtin_amdgcn_s_barrier();
        const LAS unsigned char* Kimg = lds + (sg & 1) * 65536; const LAS unsigned char* Vimg = Kimg + 32768;
        if (LATENT && sg < nloc) {
            const int R0 = Rlo + 2 * sg; const bool act0 = (R0 >= rs) && (R0 <= rs + 7), act1 = (R0 + 1 >= rs) && (R0 + 1 <= rs + 7);
            const int nt = 3 * ((act0 ? 1 : 0) + (act1 ? 1 : 0)), rsel1 = act0 ? 0 : 1;
#pragma unroll 1
            for (int k = 0; k < nt; k += 2) {
                const int ka = k, kb = (k + 1 < nt) ? k + 1 : k;
                const int rowa = (act0 && act1) ? ka / 3 : rsel1, cta = ct0 + ((act0 && act1) ? ka % 3 : ka);
                const int rowb = (act0 && act1) ? kb / 3 : rsel1, ctb = ct0 + ((act0 && act1) ? kb % 3 : kb);
                const bool bok = k + 1 < nt;
                AT_STEP(true, rowa * 64 + cta * 16, rowb * 64 + ctb * 16, R0 + rowa, cta, R0 + rowb, ctb, bok);
            }
        } else {
#pragma unroll 1
            for (int j = 0; j < 4; ++j) AT_STEP(false, 32 * j, 32 * j + 16, 0, 0, 0, 0, true);
        }
        asm volatile("s_waitcnt lgkmcnt(0)" ::: "memory");
        __builtin_amdgcn_s_barrier();
        if (sg + 2 < nstage) AT_DMA(sg & 1, sg + 2);
    }
#undef AT_STEP
#undef AT_DMA
#pragma unroll
    for (int qt = 0; qt < NQT; ++qt) {
        float lt = lsum[qt]; lt += swz16(lt); lt = xsum32(lt);
        const float iv = 1.0f / lt;
        bf16* op = BR1 + (size_t)(q0 + qt * 16 + fr) * 1024 + h * 128 + 4 * g;
#pragma unroll
        for (int d = 0; d < 8; ++d) { v2u w; w.x = cvt_pk_bf16(O[qt][d][0] * iv, O[qt][d][1] * iv); w.y = cvt_pk_bf16(O[qt][d][2] * iv, O[qt][d][3] * iv); *(v2u*)(op + d * 16) = w; }
    }
}

template <int DIR>
__device__ __forceinline__ void gla_g1_item(LAS float* zs, LAS float* xch, int tid, int blk, const float* wg, const float* bg, const bf16* GQ, const bf16* GK, bf16* QI, bf16* KI, bf16* KDT, float* DEC) {
    const int tok0 = blk * 64, half = tid >> 8, c0 = 2 * (tid & 255);
    f32x2 wv[16];
#pragma unroll
    for (int r = 0; r < 16; ++r) wv[r] = *(const f32x2*)(wg + r * 512 + c0);
    const f32x2 bgv = *(const f32x2*)(bg + c0);
    f32x2 b[32];
#pragma unroll
    for (int p = 0; p < 32; ++p) {
        const LAS f32x4* zp = (const LAS f32x4*)(zs + (half * 32 + p) * 16);
        f32x2 lg = bgv;
#pragma unroll
        for (int r4 = 0; r4 < 4; ++r4) { const f32x4 z = zp[r4]; lg += z.x * wv[4 * r4]; lg += z.y * wv[4 * r4 + 1]; lg += z.z * wv[4 * r4 + 2]; lg += z.w * wv[4 * r4 + 3]; }
        b[p].x = (fminf(lg.x, 0.f) - __builtin_amdgcn_logf(1.f + __expf(-fabsf(lg.x))) * 0.6931471805599453f) * (1.0f / 16.0f);
        b[p].y = (fminf(lg.y, 0.f) - __builtin_amdgcn_logf(1.f + __expf(-fabsf(lg.y))) * 0.6931471805599453f) * (1.0f / 16.0f);
    }
    if (DIR == 0) {
#pragma unroll
        for (int p = 1; p < 32; ++p) b[p] += b[p - 1];
    } else {
#pragma unroll
        for (int p = 30; p >= 0; --p) b[p] += b[p + 1];
    }
    const f32x2 T = DIR == 0 ? b[31] : b[0];
    *(LAS f32x2*)(xch + half * 512 + c0) = T;
    __syncthreads();
    const f32x2 To = *(const LAS f32x2*)(xch + (half ^ 1) * 512 + c0);
    const bool addo = DIR == 0 ? (half == 1) : (half == 0);
    const f32x2 off = addo ? To : (f32x2){0.f, 0.f};
    const f32x2 bend = T + To;
    f32x2 ebend; ebend.x = __expf(bend.x); ebend.y = __expf(bend.y);
    if (half == 0) *(f32x2*)(DEC + (size_t)blk * 512 + c0) = ebend;
    int c2 = c0; asm volatile("" : "+v"(c2));
    const size_t rb = (size_t)(tok0 + half * 32) * 512 + c2;
    const bf16* gq = GQ + rb; const bf16* gk = GK + rb; bf16* qi = QI + rb; bf16* ki = KI + rb;
    unsigned char* kdrec = (unsigned char*)KDT + ((size_t)(blk * 4 + (c2 >> 7)) * 8 + ((c2 & 127) >> 4)) * 2048 + (size_t)(c2 & 15) * 32 + half * 16;
    unsigned qw[32], kw[32];
#pragma unroll
    for (int p = 0; p < 32; ++p) { qw[p] = *(const unsigned*)(gq + (size_t)p * 512); kw[p] = *(const unsigned*)(gk + (size_t)p * 512); }
#pragma unroll
    for (int g = 0; g < 4; ++g) {
        unsigned r0[4], r1[4];
#pragma unroll
        for (int jj = 0; jj < 2; ++jj)
#pragma unroll
            for (int i2 = 0; i2 < 2; ++i2) {
                const int p = 16 * jj + 4 * g + 2 * i2;
                const unsigned qa = qw[p], qb = qw[p + 1];
                const unsigned ka_ = kw[p], kb_ = kw[p + 1];
                const f32x2 ba = b[p] + off, bb = b[p + 1] + off;
                f32x2 ea, eb; ea.x = __expf(ba.x); ea.y = __expf(ba.y); eb.x = __expf(bb.x); eb.y = __expf(bb.y);
                f32x2 ra, rbv; ra.x = __builtin_amdgcn_rcpf(ea.x); ra.y = __builtin_amdgcn_rcpf(ea.y); rbv.x = __builtin_amdgcn_rcpf(eb.x); rbv.y = __builtin_amdgcn_rcpf(eb.y);
                f32x2 qfa, qfb, kfa, kfb; qfa.x = bflo(qa); qfa.y = bfhi(qa); qfb.x = bflo(qb); qfb.y = bfhi(qb); kfa.x = bflo(ka_); kfa.y = bfhi(ka_); kfb.x = bflo(kb_); kfb.y = bfhi(kb_);
                qfa *= ea; qfb *= eb; kfa *= ra; kfb *= rbv;
                *(unsigned*)(qi + (size_t)p * 512) = cvt_pk_bf16(qfa.x, qfa.y); *(unsigned*)(qi + (size_t)(p + 1) * 512) = cvt_pk_bf16(qfb.x, qfb.y);
                *(unsigned*)(ki + (size_t)p * 512) = cvt_pk_bf16(kfa.x, kfa.y); *(unsigned*)(ki + (size_t)(p + 1) * 512) = cvt_pk_bf16(kfb.x, kfb.y);
                kfa *= ebend; kfb *= ebend;
                r0[jj * 2 + i2] = cvt_pk_bf16(kfa.x, kfb.x); r1[jj * 2 + i2] = cvt_pk_bf16(kfa.y, kfb.y);
            }
        v4u w0, w1; w0.x = r0[0]; w0.y = r0[1]; w0.z = r0[2]; w0.w = r0[3]; w1.x = r1[0]; w1.y = r1[1]; w1.z = r1[2]; w1.w = r1[3];
        *(v4u*)(kdrec + g * 512) = w0; *(v4u*)(kdrec + g * 512 + 32) = w1;
    }
}
__device__ __forceinline__ void gld16(bf16x8v& d, const void* p) { asm volatile("global_load_dwordx4 %0, %1, off" : "=&v"(d) : "v"(p) : "memory"); }
__device__ __forceinline__ void gld8(v2u& d, const void* p) { asm volatile("global_load_dwordx2 %0, %1, off" : "=&v"(d) : "v"(p) : "memory"); }
__device__ __forceinline__ void gld4(float& d, const void* p) { asm volatile("global_load_dword %0, %1, off" : "=&v"(d) : "v"(p) : "memory"); }
template <int OFF> __device__ __forceinline__ void gld16s(bf16x8v& d, unsigned vo, const void* sb) { asm volatile("global_load_dwordx4 %0, %1, %2 offset:%3" : "=&v"(d) : "v"(vo), "s"(sb), "n"(OFF) : "memory"); }
template <int OFF> __device__ __forceinline__ void gld8s(v2u& d, unsigned vo, const void* sb) { asm volatile("global_load_dwordx2 %0, %1, %2 offset:%3" : "=&v"(d) : "v"(vo), "s"(sb), "n"(OFF) : "memory"); }
template <int OFF> __device__ __forceinline__ void gld4s(float& d, unsigned vo, const void* sb) { asm volatile("global_load_dword %0, %1, %2 offset:%3" : "=&v"(d) : "v"(vo), "s"(sb), "n"(OFF) : "memory"); }
struct G2Regs { bf16x8v Vf[2][2]; bf16x8v Kf[2][2]; float dec[2]; bf16x8v Pf[2]; };
__device__ __forceinline__ int gla_g2_unit4(kargp ka, LAS unsigned char* ldsg, int tt, int lane, int l, int u) {
    asm volatile("" : "+v"(lane));
    unsigned char* ws = arg_ws(ka);
    const bool latent = u < 256; const int uu = latent ? u : u - 256;
    const int slice = uu & 7, cj = uu >> 3, b = cj >> 3, h = (cj >> 1) & 3, dir = cj & 1;
    const int nchunk = latent ? 32 : 4, base = latent ? MCTX + b * 2048 : b * 256;
    const bf16* QI = (const bf16*)(ws + WS_QI) + (size_t)dir * MTOK * 512; const unsigned char* PT = ws + WS_PT + (size_t)dir * 192 * 32768;
    const bf16* KDT = (const bf16*)(ws + WS_KDT) + (size_t)dir * 512 * MTOK; const float* DEC = (const float*)(ws + WS_DEC) + (size_t)dir * 192 * 512;
    const bf16* GVT = (const bf16*)(ws + WS_A + PA_GV);
    float* OUT = (float*)(ws + WS_B) + (size_t)dir * MTOK * 1024;
    const int fr = lane & 15, g = lane >> 4;
    const int e0 = h * 256 + slice * 32;
    LAS unsigned char* S16 = ldsg;
    LAS unsigned char* QR = ldsg + 16384;
    f32x4 ST[2][2];
    const size_t sidx = ((((size_t)b * 2 + l) * 2 + dir) * 4 + h) * 128 * 256;
    unsigned dsrc[4];
#pragma unroll
    for (int j = 0; j < 4; ++j) { const int pcs = 4 * tt + j, r = 4 * pcs + (lane >> 4), c = (lane & 15) ^ (r & 15); dsrc[j] = (unsigned)(r * 1024 + h * 256 + c * 16); }
#define G2_DMA(bufi, tok) do { const char* qb_ = (const char*)(QI + (size_t)(tok) * 512); \
        _Pragma("unroll") for (int j_ = 0; j_ < 4; ++j_) \
            __builtin_amdgcn_global_load_lds((const unsigned*)(qb_ + dsrc[j_]), (LAS unsigned*)(QR + (bufi) * 16384 + (4 * tt + j_) * 1024), 16, 0, 0); } while (0)
    unsigned offd[2];
#pragma unroll
    for (int j = 0; j < 2; ++j) offd[j] = (unsigned)((h * 128 + (2 * tt + j) * 16 + fr) * 4);
    const unsigned offp = (unsigned)(tt * 2048 + lane * 16), offr = (unsigned)(lane * 32);
#define G2_LOADR(R, tok) do { const int ck_ = __builtin_amdgcn_readfirstlane((tok) >> 6); \
        const char* vb_ = (const char*)GVT + ((size_t)ck_ * 64 + (e0 >> 4)) * 2048; const char* kb_ = (const char*)KDT + (((size_t)ck_ * 4 + h) * 8 + 2 * tt) * 2048; \
        const char* db_ = (const char*)(DEC + (size_t)ck_ * 512); const char* pb_ = (const char*)(PT + ((size_t)ck_ * 4 + h) * 8192); \
        gld16s<0>(R.Vf[0][0], offr, vb_); gld16s<16>(R.Vf[0][1], offr, vb_); gld16s<2048>(R.Vf[1][0], offr, vb_); gld16s<2064>(R.Vf[1][1], offr, vb_); \
        gld16s<0>(R.Kf[0][0], offr, kb_); gld16s<16>(R.Kf[0][1], offr, kb_); gld16s<2048>(R.Kf[1][0], offr, kb_); gld16s<2064>(R.Kf[1][1], offr, kb_); \
        gld4s<0>(R.dec[0], offd[0], db_); gld4s<0>(R.dec[1], offd[1], db_); \
        gld16s<0>(R.Pf[0], offp, pb_); gld16s<1024>(R.Pf[1], offp, pb_); } while (0)
#define G2_TOK(c) (base + 64 * (dir ? nchunk - 1 - ((c) < nchunk ? (c) : nchunk - 1) : ((c) < nchunk ? (c) : nchunk - 1)))
#define G2_S16OFF(e_, d_) ((e_) * 256 + ((((d_) >> 3) ^ ((e_) & 15)) * 16) + ((d_) & 7) * 2)
    G2_DMA(0, G2_TOK(0));
    G2Regs R0; G2_LOADR(R0, G2_TOK(0));
    G2_DMA(1, G2_TOK(1));
    G2Regs R1; G2_LOADR(R1, G2_TOK(1));
#pragma unroll
    for (int et = 0; et < 2; ++et)
#pragma unroll
        for (int dt = 0; dt < 2; ++dt) {
            const int d = (2 * tt + dt) * 16 + fr;
            if (latent) ST[et][dt] = *(const f32x4*)(arg_in(ka, 5) + sidx + (size_t)d * 256 + slice * 32 + et * 16 + 4 * g); else ST[et][dt] = (f32x4){0.f, 0.f, 0.f, 0.f};
#pragma unroll
            for (int i = 0; i < 4; ++i) *(LAS bf16*)(S16 + G2_S16OFF(et * 16 + 4 * g + i, d)) = (bf16)f2bf(ST[et][dt][i]);
        }
    asm volatile("s_waitcnt vmcnt(0) lgkmcnt(0)" ::: "memory");
    __builtin_amdgcn_s_barrier();
#define G2_STEP(RC, RF, BC, BF, cn_) do { \
        const int tok0 = G2_TOK(cn_); \
        const LAS unsigned char* Sr = S16 + ((cn_) & 1) * 8192; LAS unsigned char* Sw = S16 + (((cn_) + 1) & 1) * 8192; \
        const LAS unsigned char* Qs = QR + (BC) * 16384; \
        G2_DMA(BF, G2_TOK((cn_) + 2)); \
        G2_LOADR(RF, G2_TOK((cn_) + 2)); \
        bf16x8v Qf[4]; \
        _Pragma("unroll") for (int kk = 0; kk < 4; ++kk) { const int r = 16 * tt + fr; Qf[kk] = *(const LAS bf16x8v*)(Qs + r * 256 + (((kk * 4 + g) ^ (r & 15)) * 16)); } \
        _Pragma("unroll") for (int et = 0; et < 2; ++et) { \
            f32x4 o = (f32x4){0.f, 0.f, 0.f, 0.f}; \
            _Pragma("unroll") for (int pr = 0; pr < 2; ++pr) o = __builtin_amdgcn_mfma_f32_16x16x32_bf16(RC.Vf[et][pr], RC.Pf[pr], o, 0, 0, 0); \
            _Pragma("unroll") for (int kk = 0; kk < 4; ++kk) { const int er = et * 16 + fr; const bf16x8v Sf = *(const LAS bf16x8v*)(Sr + er * 256 + (((kk * 4 + g) ^ (er & 15)) * 16)); \
                o = __builtin_amdgcn_mfma_f32_16x16x32_bf16(Sf, Qf[kk], o, 0, 0, 0); } \
            *(f32x4*)(OUT + (size_t)(tok0 + 16 * tt + fr) * 1024 + e0 + et * 16 + 4 * g) = o; } \
        _Pragma("unroll") for (int dt = 0; dt < 2; ++dt) { \
            const int d = (2 * tt + dt) * 16 + fr; \
            _Pragma("unroll") for (int et = 0; et < 2; ++et) { \
                ST[et][dt] *= RC.dec[dt]; \
                _Pragma("unroll") for (int hf = 0; hf < 2; ++hf) ST[et][dt] = __builtin_amdgcn_mfma_f32_16x16x32_bf16(RC.Vf[et][hf], RC.Kf[dt][hf], ST[et][dt], 0, 0, 0); \
                _Pragma("unroll") for (int i = 0; i < 4; ++i) *(LAS bf16*)(Sw + G2_S16OFF(et * 16 + 4 * g + i, d)) = (bf16)f2bf(ST[et][dt][i]); } } \
          \
        asm volatile("s_waitcnt vmcnt(18) lgkmcnt(0)" ::: "memory"); \
        __builtin_amdgcn_s_barrier(); } while (0)
    G2Regs R2;
    for (int cn = 0; cn < nchunk; cn += 3) {
        G2_STEP(R0, R2, 0, 2, cn);
        if (cn + 1 < nchunk) G2_STEP(R1, R0, 1, 0, cn + 1);
        if (cn + 2 < nchunk) G2_STEP(R2, R1, 2, 1, cn + 2);
    }
#undef G2_STEP
#undef G2_TOK
#undef G2_DMA
#undef G2_LOADR
    if (!latent) {
#pragma unroll
        for (int et = 0; et < 2; ++et)
#pragma unroll
            for (int dt = 0; dt < 2; ++dt) { const int d = (2 * tt + dt) * 16 + fr;
                *(f32x4*)(arg_out(ka) + (size_t)41943040 + sidx + (size_t)d * 256 + slice * 32 + et * 16 + 4 * g) = ST[et][dt]; }
    }
#undef G2_S16OFF
    asm volatile("s_waitcnt vmcnt(0)" ::: "memory");
    return 1 + nchunk;
}

#define PHASE_FN static __device__ __forceinline__ void
#define PH_BEGIN \
    LAS unsigned char* lds = lds_; \
    int wave = wave_, G = gridDim.x, bx = blockIdx.x; kargp ka = KARG; asm volatile("" : "+s"(wave), "+s"(G), "+s"(bx), "+s"(ka)); \
    unsigned zz_ = 0u; asm volatile("" : "+v"(zz_)); const int lane = (int)__builtin_amdgcn_mbcnt_hi(~0u, __builtin_amdgcn_mbcnt_lo(~0u, zz_)); \
    const int tid = wave * 64 + lane; const int vcu = (G % 8 == 0) ? (bx % 8) * (G / 8) + bx / 8 : bx; \
    const int gw = vcu * NWAVES + wave, NGW = G * NWAVES; unsigned char* ws = arg_ws(ka); \
    (void)lane; (void)gw; (void)NGW; (void)ws; (void)tid; (void)lds;
#define WSP(T, name, off) T* name = (T*)(ws + (off))

template<int FI0, int FI1, int FO0, int FO1, int IN0, int IN1, int BR0, int BR1, int OUT0, int OUT1, int SMALL>
__device__ __forceinline__ void cvt_run(kargp ka, unsigned char* ws, LAS float* scr, int lane, int w, int NW, int rep) {
    WSP(bf16, WFI, WS_WFI); WSP(bf16, WFO, WS_WFO); WSP(bf16, WIN, WS_WIN); WSP(bf16, WBR, WS_WBR); WSP(bf16, WOUT, WS_WOUT); WSP(bf16, WPOOL, WS_WPOOL);
    constexpr int I_FI = FI1 - FI0, I_FO = FO1 - FO0, I_IN = IN1 - IN0, I_BR = BR1 - BR0, I_OUT = OUT1 - OUT0, I_PW = SMALL ? 256 : 0, I_CV = SMALL ? 2048 : 0, NITEMS = I_FI + I_FO + I_IN + I_BR + I_OUT + I_PW + I_CV;
    for (int it = w, k_ = 0; it < NITEMS; (++k_ < rep) ? ++it : (k_ = 0, it += NW - rep + 1)) {
        int r = it;
        if (r < I_FI) { r += FI0; const int mat = r / 11008, rr = r % 11008, kb = rr / 344, nb = rr % 344, n0 = nb * 32, half = n0 / FF, j0 = n0 % FF;
            p0_transpose_item(arg_in(ka, 11) + (size_t)mat * 2048 * FF2, 2048, FF2, WFI + (size_t)mat * FF2 * 2048, 256 * (j0 >> 7) + 128 * half + (j0 & 127), scr, kb, nb, lane); continue; }
        r -= I_FI;
        if (r < I_FO) { r += FO0; const int mat = r / 5504, rr = r % 5504, kb = rr / 64, nb = rr % 64;
            p0_transpose_item(arg_in(ka, 12) + (size_t)mat * FF * 2048, FF, 2048, WFO + (size_t)mat * 2048 * FF, nb * 32, scr, kb, nb, lane); continue; }
        r -= I_FO;
        if (r < I_IN) { r += IN0; const int l = r / 13344, rr = r % 13344, kb = rr / 417, nb = rr % 417;
            p0_transpose_item(arg_in(ka, 13) + (size_t)l * 2048 * INC, 2048, INC, WIN + (size_t)l * INP * 2048, win_dst(nb * 32), scr, kb, nb, lane); continue; }
        r -= I_IN;
        if (r < I_BR) { r += BR0; const int mat = r / 1024, rr = r % 1024, kb = rr / 64, nb = rr % 64;
            p0_transpose_item(arg_in(ka, 20) + (size_t)mat * 1024 * 2048, 1024, 2048, WBR + (size_t)mat * 2048 * 1024, nb * 32, scr, kb, nb, lane); continue; }
        r -= I_BR;
        if (r < I_OUT) { r += OUT0; const int l = r / 2048, rr = r % 2048, kb = rr / 64, nb = rr % 64;
            p0_transpose_item(arg_in(ka, 21) + (size_t)l * 2048 * 2048, 2048, 2048, WOUT + (size_t)l * 2048 * 2048, nb * 32, scr, kb, nb, lane); continue; }
        if (SMALL) {
            r -= I_OUT;
            if (r < I_PW) { const int mat = r / 32, rr = r % 32, kb = rr / 8, nb = rr % 8;
                p0_transpose_item(arg_in(ka, 14) + (size_t)mat * 65536, 256, 256, WPOOL + (size_t)mat * 65536, nb * 32, scr, kb, nb, lane); continue; }
            r -= I_PW;
            { const int mat = r / 32, rr = r % 32, kb = rr / 4, nb = rr % 4;
                p0_transpose_item(arg_in(ka, 4) + (size_t)mat * 65536, 512, 128, (bf16*)(ws + WS_CVT) + (size_t)mat * 65536, nb * 32, scr, kb, nb, lane); }
        }
    }
}

__device__ __forceinline__ void mod_gemv(kargp ka, LAS unsigned char* lds, int tid, float* MOD, int it_end, int start, int stride) {
    LAS float* sc = (LAS float*)lds; LAS float* red = sc + 5 * 2048;
    for (int e = tid; e < 5 * 2048; e += NTHR) { const int v = e >> 11, k = e & 2047; const float c = v == 0 ? arg_in(ka, 6)[k] : arg_in(ka, 2)[(v - 1) * 2048 + k]; sc[e] = c / (1.f + expf(-c)); }
    __syncthreads();
    for (int it = start; it < it_end; it += stride) {
        const int l = it / 288, j0 = (it % 288) * 64, cg = tid & 15, kg = tid >> 4;
        const float* w = arg_in(ka, 7) + ((size_t)l * 2048 + kg * 64) * 18432 + j0 + cg * 4;
        f32x4 a0 = (f32x4){0.f, 0.f, 0.f, 0.f}, a1 = a0, a2 = a0, a3 = a0, a4 = a0;
#pragma unroll 16
        for (int k = 0; k < 64; ++k) { const f32x4 wv = *(const f32x4*)(w + (size_t)k * 18432); const int kk = kg * 64 + k;
            a0 += sc[kk] * wv; a1 += sc[2048 + kk] * wv; a2 += sc[4096 + kk] * wv; a3 += sc[6144 + kk] * wv; a4 += sc[8192 + kk] * wv; }
        *(LAS f32x4*)(red + (kg * 5 + 0) * 64 + cg * 4) = a0; *(LAS f32x4*)(red + (kg * 5 + 1) * 64 + cg * 4) = a1; *(LAS f32x4*)(red + (kg * 5 + 2) * 64 + cg * 4) = a2;
        *(LAS f32x4*)(red + (kg * 5 + 3) * 64 + cg * 4) = a3; *(LAS f32x4*)(red + (kg * 5 + 4) * 64 + cg * 4) = a4;
        __syncthreads();
        if (tid < 320) { const int v = tid >> 6, c2 = tid & 63; float s = 0.f;
#pragma unroll
            for (int k8 = 0; k8 < 32; ++k8) s += red[(k8 * 5 + v) * 64 + c2];
            const int j = j0 + c2; MOD[(size_t)(v * 2 + l) * 18432 + j] = s + arg_in(ka, 8)[(size_t)l * 18432 + j]; }
        __syncthreads();
    }
}

PHASE_FN ph_prologue(LAS unsigned char* lds_, int wave_) {
    PH_BEGIN
    WSP(float, MOD, WS_MOD); WSP(f32x2, ROPE, WS_ROPE); WSP(bf16, WFI, WS_WFI); WSP(bf16, WFO, WS_WFO); WSP(bf16, WIN, WS_WIN); WSP(bf16, WBR, WS_WBR); WSP(bf16, WOUT, WS_WOUT); WSP(bf16, WPOOL, WS_WPOOL);
    if (tid == 0) {
        const int r0 = 384 - G, n1_ = (r0 > 0 && 2 * r0 <= G) ? r0 : 0; const unsigned myx = xb_xcc_id() & 15u; unsigned* cw = (unsigned*)(ws + WS_CTL) + CW_MFLAG;
        if (bx < 384) __hip_atomic_store(cw + bx, myx, __ATOMIC_RELAXED, __HIP_MEMORY_SCOPE_AGENT);
        if (bx >= n1_ && bx < 2 * n1_) (void)__hip_atomic_fetch_add(cw + 384 + myx, 1u, __ATOMIC_RELAXED, __HIP_MEMORY_SCOPE_AGENT);
    }
    mod_gemv(ka, lds, tid, MOD, 576, bx, G);
    if (bx == G - 1) {
        for (int e = tid; e < 2048; e += NTHR) { const int pos = e >> 5, j = e & 31; const float invf = exp2f(-(float)j * (13.287712379549449f / 32.f)); const float ang = (float)pos * invf;
            f32x2 cs; cs.x = cosf(ang); cs.y = sinf(ang); ROPE[e] = cs; }
    }
    {
        const int gt = vcu * NTHR + tid, NGT = G * NTHR;
        for (int i = gt; i < 2 * 57344; i += NGT) { const int l = i / 57344, r = i % 57344; ((v4u*)(WIN + ((size_t)l * INP + INC) * 2048))[r] = (v4u){0u, 0u, 0u, 0u}; }
    }
    cvt_run<0, 22016, 0, 11008, 0, 13344, 0, 3072, 0, 2048, 1>(ka, ws, (LAS float*)(lds + wave * 16384), lane, gw, NGW, 1);
    {
        const int gt = vcu * NTHR + tid, NGT = G * NTHR; const float* ck = arg_in(ka, 3); bf16* CKB = (bf16*)(ws + WS_CKB);
        for (int i = gt; i < 4194304 / 8; i += NGT) { const f32x4 a = ((const f32x4*)ck)[2 * i], b2 = ((const f32x4*)ck)[2 * i + 1];
            v4u w; w.x = pk2(a.x, a.y); w.y = pk2(a.z, a.w); w.z = pk2(b2.x, b2.y); w.w = pk2(b2.z, b2.w); ((v4u*)CKB)[i] = w; }
    }
}
PHASE_FN ph_norm(LAS unsigned char* lds_, int wave_, int mode_, int l_, int i_, int part_, int lfp_) {
    PH_BEGIN
    const int mode = mode_, l = l_, i = i_, part = part_;
    pg8::FfnPreOrder SP; SP.init(G, bx, 2048);
    const int npre = part == 2 ? SP.nblk() : 0;
    if (part == 2 && bx < npre) {
        WSP(bf16, H, WS_H); WSP(bf16, WFI, WS_WFI); WSP(bf16, ACT, WS_A);
        pg8::Gemm g{H, WFI + (size_t)lfp_ * FF2 * 2048, 2048, 2048, 1024, 1024, 2048, 2048, (unsigned*)(ws + WS_CTL + 524288)};
        EpiSwiGLUPre E{ACT, (bf16*)(ws + WS_B + 64 * MiB) + (size_t)(bx & 15) * 65536, (unsigned*)(ws + WS_CTL) + CW_MFLAG + 656 + lfp_ * 16 + (bx & 15), SP.split ? (bx < 16 ? 1 : 2) : 0};
        pg8::gemm_phase<EpiSwiGLUPre, pg8::FfnPreOrder>(lds, g, SP, E, tid);
        return;
    }
    WSP(bf16, YB, WS_B);
    const int ln = (i == 2) ? l + 1 : l, gn = (i == 2) ? 0 : i + 1;
    const float resw = (i == 1) ? 1.0f : 0.5f;
    const int row_lo = part == 2 ? MCTX : 0, row_hi = part == 1 ? MCTX : MTOK;
    const int gwe = part == 2 ? (bx - npre) * NWAVES + wave : gw, NGWe = part == 2 ? (G - npre) * NWAVES : NGW;
    if (mode == 0) norm_rows<true, false>(ka, gwe, NGWe, lane, nullptr, nullptr, 0, 0, 0.f, arg_in(ka, 9), 0, 0, row_lo, row_hi);
    else if (mode == 1) norm_rows<false, false>(ka, gwe, NGWe, lane, YB, arg_in(ka, 10) + (size_t)(l * 3 + i) * DM, l, i, resw, arg_in(ka, 9) + (size_t)(ln * 3 + gn) * DM, ln, gn, row_lo, row_hi);
    else norm_rows<false, true>(ka, gwe, NGWe, lane, YB, arg_in(ka, 10) + (size_t)(l * 3 + i) * DM, l, i, resw, nullptr, 0, 0, row_lo, row_hi);
}
PHASE_FN ph_ffn_in(LAS unsigned char* lds_, int wave_, int lf_) {
    PH_BEGIN
    const int lf = lf_;
    WSP(bf16, H, WS_H); WSP(bf16, WFI, WS_WFI); WSP(bf16, ACT, WS_A);
    pg8::Gemm g{H, WFI + (size_t)lf * FF2 * 2048, 2048, 2048, 0, 0, 2048, 2048, (unsigned*)(ws + WS_CTL + 524288)}; pg8::FfnOrder S; S.init(G, bx, 0);
    EpiSwiGLU E{ACT}; pg8::gemm_phase<EpiSwiGLU, pg8::FfnOrder>(lds, g, S, E, tid);
}
PHASE_FN ph_ffn_out(LAS unsigned char* lds_, int wave_, int lf_) {
    PH_BEGIN
    const int lf = lf_;
    WSP(bf16, ACT, WS_A); WSP(bf16, WFO, WS_WFO); WSP(bf16, YB, WS_B);
    pg8::Gemm g{ACT, WFO + (size_t)lf * 2048 * FF, FF, FF, 2944, 2944, 2944, 2560, (unsigned*)(ws + WS_CTL + 524288)}; pg8::SplitKOrder S; S.init(G, bx, FF, 2944);
    const int n1 = S.n1, jt = (bx < n1 ? bx : bx - n1) & 127;
    EpiY E{YB, DM, ws, 2 + lf, jt, n1, (n1 > 0 && bx < 2 * n1) ? (bx < n1 ? 1 : 2) : 0, S.pm2, S.pn2}; pg8::gemm_phase<EpiY, pg8::SplitKOrder>(lds, g, S, E, tid);
}
PHASE_FN ph_inproj(LAS unsigned char* lds_, int wave_, int l_) {
    PH_BEGIN
    const int l = l_;
    WSP(bf16, H, WS_H); WSP(bf16, WIN, WS_WIN); WSP(f32x2, ROPE, WS_ROPE);
    pg8::Gemm g{H, WIN + (size_t)l * INP * 2048, 2048, 2048, 0, 0, 2048, 2048, (unsigned*)(ws + WS_CTL + 524288)}; pg8::ZOrder S; S.init(48, 53, 1, G, bx, 0);
    EpiInProj E{ws + WS_A, arg_out(ka) + 25165824, arg_out(ka) + 33554432, ROPE, l, lds + TS_OFF};
    pg8::gemm_phase<EpiInProj, pg8::ZOrder>(lds, g, S, E, tid);
}
PHASE_FN ph_mix1(LAS unsigned char* lds_, int wave_, int l_) {
    PH_BEGIN
    const int l = l_;
    unsigned char* PA = ws + WS_A; WSP(bf16, PL, WS_PL); WSP(bf16, BR, WS_BR);
    const bf16* U = (const bf16*)(PA + PA_U);
    {
        const int gt = vcu * NTHR + tid, NGT = G * NTHR;
#define PL_ACC(w_, f_) { s[0] += f_ * bflo(w_.x); s[1] += f_ * bfhi(w_.x); s[2] += f_ * bflo(w_.y); s[3] += f_ * bfhi(w_.y); s[4] += f_ * bflo(w_.z); s[5] += f_ * bfhi(w_.z); s[6] += f_ * bflo(w_.w); s[7] += f_ * bfhi(w_.w); }
        for (int idx = gt; idx < (MTOK / 16) * 128; idx += NGT) {
            const int run = idx >> 7, cc = idx & 127, col0 = cc * 8, g4 = col0 >> 8, win = 2 << g4, lo = win / 2, hi = win - 1 - lo;
            const int row0 = run * 16;
            const int base = row0 < MCTX ? (row0 & ~255) : MCTX + ((row0 - MCTX) & ~2047), L = row0 < MCTX ? 256 : 2048, t0 = row0 - base;
            const bf16* Ub = U + (size_t)base * 1024 + col0; bf16* Pb = PL + (size_t)base * 1024 + col0;
            float s[8] = {0.f, 0.f, 0.f, 0.f, 0.f, 0.f, 0.f, 0.f};
            {
                v4u wq[16];
#pragma unroll
                for (int k = 0; k < 16; ++k) { int r = t0 - lo + k; r = r < 0 ? 0 : (r > L - 1 ? L - 1 : r); wq[k] = *(const v4u*)(Ub + (size_t)r * 1024); }
#pragma unroll
                for (int k = 0; k < 16; ++k) { const int r = t0 - lo + k; const float f = (k < win && r >= 0 && r <= L - 1) ? 1.f : 0.f; PL_ACC(wq[k], f) }
            }
#pragma unroll
            for (int jg = 0; jg < 4; ++jg) {
                v4u wn[4], wo[4], wc[4];
#pragma unroll
                for (int jj = 0; jj < 4; ++jj) { const int t = t0 + 4 * jg + jj; int tn = t + hi, to = t - lo - 1; tn = tn > L - 1 ? L - 1 : tn; to = to < 0 ? 0 : to;
                    wn[jj] = *(const v4u*)(Ub + (size_t)tn * 1024); wo[jj] = *(const v4u*)(Ub + (size_t)to * 1024); wc[jj] = *(const v4u*)(Ub + (size_t)t * 1024); }
#pragma unroll
                for (int jj = 0; jj < 4; ++jj) { const int j = 4 * jg + jj, t = t0 + j;
                    if (j > 0) { const float fn = (t + hi <= L - 1) ? 1.f : 0.f, fo = (t - lo - 1 >= 0) ? -1.f : 0.f; PL_ACC(wn[jj], fn) PL_ACC(wo[jj], fo) }
                    const int tlo = t - lo < 0 ? 0 : t - lo, thi = t + hi > L - 1 ? L - 1 : t + hi;
                    const float ic = 1.0f / (float)(thi - tlo + 1);
                    const v4u w = wc[jj];
                    v4u o; o.x = cvt_pk_bf16(s[0] * ic - bflo(w.x), s[1] * ic - bfhi(w.x)); o.y = cvt_pk_bf16(s[2] * ic - bflo(w.y), s[3] * ic - bfhi(w.y));
                    o.z = cvt_pk_bf16(s[4] * ic - bflo(w.z), s[5] * ic - bfhi(w.z)); o.w = cvt_pk_bf16(s[6] * ic - bflo(w.w), s[7] * ic - bfhi(w.w));
                    *(v4u*)(Pb + (size_t)t * 1024) = o; }
            }
        }
#undef PL_ACC
    }
    {
        LAS float* zs = (LAS float*)lds;
        const bf16* GQ = (const bf16*)(PA + PA_GQ); const bf16* GK = (const bf16*)(PA + PA_GK); const float* GZ = (const float*)(PA + PA_GZ);
        for (int it = bx; it < 384; it += G) {
            const int dir = it & 1, blk = it >> 1;
            __syncthreads();
            for (int e = tid; e < 1024; e += NTHR) zs[e] = GZ[(size_t)(blk * 64 + (e >> 4)) * 32 + dir * 16 + (e & 15)];
            __syncthreads();
            const float* wg = arg_in(ka, 17) + (size_t)(l * 2 + dir) * 16 * 512; const float* bg = arg_in(ka, 18) + (size_t)(l * 2 + dir) * 512;
            bf16* QI = (bf16*)(ws + WS_QI) + (size_t)dir * MTOK * 512; bf16* KI = (bf16*)(ws + WS_KI) + (size_t)dir * MTOK * 512;
            bf16* KDT = (bf16*)(ws + WS_KDT) + (size_t)dir * 512 * MTOK; float* DEC = (float*)(ws + WS_DEC) + (size_t)dir * 192 * 512;
            if (dir == 0) gla_g1_item<0>(zs, zs + 1024, tid, blk, wg, bg, GQ, GK, QI, KI, KDT, DEC); else gla_g1_item<1>(zs, zs + 1024, tid, blk, wg, bg, GQ, GK, QI, KI, KDT, DEC);
            asm volatile("s_waitcnt vmcnt(0)" ::: "memory");
            __syncthreads();
            {
                const int hh = wave >> 1, pr = wave & 1, fr = lane & 15, g = lane >> 4, tok0 = blk * 64;
                bf16x8v Kf[2][4];
#pragma unroll
                for (int sl = 0; sl < 2; ++sl)
#pragma unroll
                    for (int kk = 0; kk < 4; ++kk) Kf[sl][kk] = *(const bf16x8v*)(KI + (size_t)(tok0 + 16 * (2 * pr + sl) + fr) * 512 + hh * 128 + kk * 32 + g * 8);
                unsigned char* pt = ws + WS_PT + ((size_t)(dir * 192 + blk) * 4 + hh) * 8192 + pr * 1024 + lane * 16;
                bf16x8v Qa[4][4];
#pragma unroll
                for (int t4 = 0; t4 < 4; ++t4)
#pragma unroll
                    for (int kk = 0; kk < 4; ++kk) Qa[t4][kk] = *(const bf16x8v*)(QI + (size_t)(tok0 + 16 * t4 + fr) * 512 + hh * 128 + kk * 32 + g * 8);
#pragma unroll
                for (int t4 = 0; t4 < 4; ++t4) {
                    f32x4 a0 = (f32x4){0.f, 0.f, 0.f, 0.f}, a1 = (f32x4){0.f, 0.f, 0.f, 0.f};
#pragma unroll
                    for (int kk = 0; kk < 4; ++kk) { const bf16x8v Qf = Qa[t4][kk];
                        a0 = __builtin_amdgcn_mfma_f32_16x16x32_bf16(Kf[0][kk], Qf, a0, 0, 0, 0); a1 = __builtin_amdgcn_mfma_f32_16x16x32_bf16(Kf[1][kk], Qf, a1, 0, 0, 0); }
#pragma unroll
                    for (int i = 0; i < 4; ++i) { const int tp = 16 * t4 + fr, s0 = 32 * pr + 4 * g + i, s1 = s0 + 16;
                        a0[i] = (dir ? (s0 >= tp) : (s0 <= tp)) ? a0[i] : 0.f; a1[i] = (dir ? (s1 >= tp) : (s1 <= tp)) ? a1[i] : 0.f; }
                    v4u pw; pw.x = cvt_pk_bf16(a0[0], a0[1]); pw.y = cvt_pk_bf16(a0[2], a0[3]); pw.z = cvt_pk_bf16(a1[0], a1[1]); pw.w = cvt_pk_bf16(a1[2], a1[3]);
                    *(v4u*)(pt + t4 * 2048) = pw;
                }
            }
        }
    }
    {
        const bf16* NQ = (const bf16*)(PA + PA_NQ); const bf16* NK = (const bf16*)(PA + PA_NK); const bf16* NVT = (const bf16*)(PA + PA_NV);
        bf16* BR1 = BR + (size_t)MTOK * 1024;
        const float* rpb = arg_in(ka, 16) + (size_t)l * 8 * 15 * 31;
        const bf16* CKB = (const bf16*)(ws + WS_CKB); const bf16* CVT = (const bf16*)(ws + WS_CVT);
        __syncthreads();
        for (int rep_ = 0; rep_ < REP_ATT; ++rep_) {
        for (int ub = vcu; ub < 256; ub += G) {
            const int u = ub * 8 + wave, half = u & 1, r = (u >> 1) & 31, h = (u >> 6) & 7, b = u >> 9;
            int rs = r - 4; rs = rs < 0 ? 0 : (rs > 24 ? 24 : rs);
            const int r0 = r & ~3; int Rlo = r0 - 4; Rlo = Rlo < 0 ? 0 : (Rlo > 24 ? 24 : Rlo); int rs3 = r0 + 3 - 4; rs3 = rs3 < 0 ? 0 : (rs3 > 24 ? 24 : rs3);
            const int nR = rs3 + 7 - Rlo + 1, nloc = (nR + 1) >> 1;
            const int base = MCTX + b * 2048; const size_t co = (((size_t)b * 2 + l) * 8 + h) * 512 * 128;
            attn_block<2, true>(lds, wave, lane, NQ, rpb + h * 465, BR1, base + r * 64 + half * 32, h, rs, r, half, half * 32, Rlo, nloc,
                                (const char*)(NK + (size_t)(base + Rlo * 64) * 1024 + h * 128), (const char*)(NVT + (size_t)(h * 128) * MTOK + base + Rlo * 64),
                                (const char*)(CKB + co), 256u, (const char*)(CVT + co), 1024u, 4);
        }
        for (int ub = bx; ub < 256; ub += G) {
            const int qh = ub & 1, h = (ub >> 1) & 7, b = ub >> 4;
            attn_block<1, false>(lds, wave, lane, NQ, nullptr, BR1, b * 256 + qh * 128 + wave * 16, h, 0, 0, 0, 0, 0, 0, nullptr, nullptr,
                                 (const char*)(NK + (size_t)(b * 256) * 1024 + h * 128), 2048u, (const char*)(NVT + (size_t)(h * 128) * MTOK + b * 256), (unsigned)(MTOK * 2), 2);
        }
        }
    }
}
PHASE_FN ph_mix1b(LAS unsigned char* lds_, int wave_, int l_) {
    PH_BEGIN
    const int l = l_;
    int nb0 = 0, nb1 = 0;
    for (int u = vcu; u < 256; u += G) nb0 += 33;
    for (int u = 256 + vcu; u < 1280; u += G) nb1 += 5;
    const int nbmax = nb0 > nb1 ? nb0 : nb1;
    int done = 0;
    if (wave < 4) { for (int u = vcu; u < 256; u += G) done += gla_g2_unit4(ka, lds, wave, lane, l, u); }
    else { for (int u = 256 + vcu; u < 1280; u += G) done += gla_g2_unit4(ka, lds + 65536, wave - 4, lane, l, u); }
    for (; done < nbmax; ++done) __builtin_amdgcn_s_barrier();
}
PHASE_FN ph_mix2(LAS unsigned char* lds_, int wave_, int l_) {
    PH_BEGIN
    const int l = l_;
    unsigned char* PA = ws + WS_A; WSP(bf16, PL, WS_PL); WSP(bf16, BR, WS_BR); WSP(float, YB, WS_B); WSP(bf16, WPOOL, WS_WPOOL);
    {
        const float* OF = YB; const float* OB = YB + (size_t)MTOK * 1024; const bf16* GR = (const bf16*)(PA + PA_GR); bf16* BR2 = BR + (size_t)2 * MTOK * 1024;
        const float* gn = arg_in(ka, 19) + (size_t)l * 1024;
        const int hh = lane >> 4, sub = lane & 15;
        for (int row = gw; row < MTOK; row += NGW) {
            f32x4 o[4], gv[4]; v2u rv[4]; float ss = 0.f;
#pragma unroll
            for (int j = 0; j < 4; ++j) { const int c = hh * 256 + (sub + 16 * j) * 4; const size_t off = (size_t)row * 1024 + c; o[j] = *(const f32x4*)(OF + off) + *(const f32x4*)(OB + off);
                gv[j] = *(const f32x4*)(gn + c); rv[j] = *(const v2u*)(GR + off); }
#pragma unroll
            for (int j = 0; j < 4; ++j) ss += (o[j].x * o[j].x + o[j].y * o[j].y) + (o[j].z * o[j].z + o[j].w * o[j].w);
            ss = row16_sum(ss);
            const float rstd = 1.0f / sqrtf(ss * (1.f / 256.f) + EPS);
#pragma unroll
            for (int j = 0; j < 4; ++j) { const int c = hh * 256 + (sub + 16 * j) * 4; const f32x4 g4 = gv[j]; const v2u rw = rv[j];
                v2u w; w.x = cvt_pk_bf16(o[j].x * rstd * g4.x * bflo(rw.x), o[j].y * rstd * g4.y * bfhi(rw.x)); w.y = cvt_pk_bf16(o[j].z * rstd * g4.z * bflo(rw.y), o[j].w * rstd * g4.w * bfhi(rw.y));
                *(v2u*)(BR2 + (size_t)row * 1024 + c) = w; }
        }
    }
    {
        pg8::Gemm g{PL, WPOOL + (size_t)l * 4 * 65536, 1024, 256, 256, 65536, 256, 256, (unsigned*)(ws + WS_CTL + 524288)}; pg8::ZOrder S; S.init(48, 1, 4, G, bx, 0);
        EpiPool E{BR, arg_in(ka, 15) + (size_t)l * 1024};
        pg8::gemm_phase<EpiPool, pg8::ZOrder>(lds, g, S, E, tid);
    }
}
PHASE_FN ph_merge(LAS unsigned char* lds_, int wave_, int l_) {
    PH_BEGIN
    const int l = l_;
    WSP(bf16, BR, WS_BR); WSP(bf16, WBR, WS_WBR); WSP(bf16, YB, WS_B); WSP(bf16, MG, WS_MG);
    pg8::Gemm g{BR, WBR + (size_t)l * 3 * 2048 * 1024, 1024, 1024, (size_t)MTOK * 1024, (size_t)2048 * 1024, 1024, 1024, (unsigned*)(ws + WS_CTL + 524288)}; pg8::MergeOrder S; S.init(G, bx); if (l == 0) S.n1 = 0;
    const int n1 = S.n1, jt = bx < n1 ? bx : bx - n1;
    pg8::Unit u2; u2.pm = -1; u2.pn = -1; if (n1 > 0 && bx < 2 * n1) S.Z.map(G + jt, u2);
    EpiMerge E{(const bf16*)(ws + WS_A + PA_GL), YB, MG, ws, l, jt & 127, n1, (n1 > 0 && bx < 2 * n1) ? (bx < n1 ? 1 : 2) : 0, u2.pm, u2.pn};
    pg8::gemm_phase<EpiMerge, pg8::MergeOrder>(lds, g, S, E, tid);
    {
        int w0, rep = 1, NV; bool act;
        if (n1 > 0) {
            if (l == 0) { NV = n1 * NWAVES * 4; act = bx < 2 * n1; if (bx < n1) w0 = bx * NWAVES + wave; else { w0 = n1 * NWAVES + ((bx - n1) * NWAVES + wave) * 3; rep = 3; } }
            else { NV = n1 * NWAVES; act = bx >= n1 && bx < 2 * n1; w0 = (bx - n1) * NWAVES + wave; }
        } else { const int first = 384 % G; act = bx >= first; w0 = (bx - first) * NWAVES + wave; NV = (G - first) * NWAVES; }
        if (act) {
            __syncthreads();
            if (l == 0) cvt_run<22016, 33024, 11008, 16512, 13344, 26688, 3072, 6144, 2048, 4096, 0>(ka, ws, (LAS float*)(lds + wave * 16384), lane, w0, NV, rep);
            else        cvt_run<33024, 44032, 16512, 22016, 0, 0, 0, 0, 0, 0, 0>(ka, ws, (LAS float*)(lds + wave * 16384), lane, w0, NV, rep);
        }
    }
}
PHASE_FN ph_out(LAS unsigned char* lds_, int wave_, int l_) {
    PH_BEGIN
    const int l = l_;
    WSP(bf16, MG, WS_MG); WSP(bf16, WOUT, WS_WOUT); WSP(bf16, YB, WS_B);
    pg8::Gemm g{MG, WOUT + (size_t)l * 2048 * 2048, 2048, 2048, 1152, 1152, 1152, 896, (unsigned*)(ws + WS_CTL + 524288)}; pg8::SplitKOrder S; S.init(G, bx, 2048, 1152);
    const int n1 = S.n1, jt = (bx < n1 ? bx : bx - n1) & 127;
    EpiY E{YB, DM, ws, 6 + l, jt, n1, (n1 > 0 && bx < 2 * n1) ? (bx < n1 ? 1 : 2) : 0, S.pm2, S.pn2};
    pg8::gemm_phase<EpiY, pg8::SplitKOrder>(lds, g, S, E, tid);
}

__global__ void __launch_bounds__(NTHR, 2) mk_fwd(Args args) {
    extern __shared__ __attribute__((aligned(16))) unsigned char lds_raw[];
    LAS unsigned char* lds = (LAS unsigned char*)lds_raw;
    volatile LAS unsigned* MISC = (volatile LAS unsigned*)(lds + MISC_OFF);
    const int wave0 = __builtin_amdgcn_readfirstlane((int)(threadIdx.x >> 6));
    unsigned char* ws0 = arg_ws(KARG);
    gu32* ctl = (gu32*)(ws0 + WS_CTL);
    for (int u = threadIdx.x; u < (LDS_BYTES - LDSCTL_OFF) / 4; u += NTHR) ((LAS unsigned*)(lds + LDSCTL_OFF))[u] = 0u;
    __syncthreads();
    XcdBarrier bar = xcd_barrier_post((unsigned*)(ctl + CW_BAR) + arg_i(KARG, 200) * XCD_BAR_WORDS, MISC + 8);
#if MK_PER_PHASE
    const int lo = arg_i(KARG, 192), hi = arg_i(KARG, 196);
#define IN(k) (lo <= (k) && (k) < hi)
#else
#define IN(k) ((k) < NPH)
#endif
#define SEAM(k) do { if (IN(k) && IN((k) + 1)) { unsigned* bb_ = bar.bar; unsigned bx_ = bar.x; int w_ = wave0; asm volatile("" : "+s"(bb_), "+s"(bx_), "+s"(w_)); \
        unsigned zz_ = 0u; asm volatile("" : "+v"(zz_)); const int ln_ = (int)__builtin_amdgcn_mbcnt_hi(~0u, __builtin_amdgcn_mbcnt_lo(~0u, zz_)); xcd_barrier_impl(bb_, bx_, bar.st, w_ * 64 + ln_); } } while (0)
    if (IN(0)) { ph_prologue(lds, wave0); if (REP_PRO > 1) { __syncthreads(); ph_prologue(lds, wave0); } }
    SEAM(0);
    if (IN(1)) ph_norm(lds, wave0, 0, 0, 0, 1, 0);
    SEAM(1);
    if (IN(2)) ph_norm(lds, wave0, 0, 0, 0, 2, 0);
    SEAM(2);
#define LAYER(l) { constexpr int k0 = 3 + 16 * (l); \
        if (IN(k0 + 0)) { ph_ffn_in(lds, wave0, l * 2 + 0); if (REP_GEMM > 1 || REP_FFI > 1) { __syncthreads(); ph_ffn_in(lds, wave0, l * 2 + 0); } } \
        SEAM(k0 + 0); \
        if (IN(k0 + 1)) { ph_ffn_out(lds, wave0, l * 2 + 0); if (REP_GEMM > 1 || REP_FFO > 1) { __syncthreads(); ph_ffn_out(lds, wave0, l * 2 + 0); } } \
        SEAM(k0 + 1); \
        if (IN(k0 + 2)) ph_norm(lds, wave0, 1, l, 0, 0, 0); \
        SEAM(k0 + 2); \
        if (IN(k0 + 3)) { ph_inproj(lds, wave0, l); if (REP_GEMM > 1 || REP_INP > 1) { __syncthreads(); ph_inproj(lds, wave0, l); } } \
        SEAM(k0 + 3); \
        if (IN(k0 + 4)) { ph_mix1(lds, wave0, l); if (REP_MIX1 > 1) { __syncthreads(); ph_mix1(lds, wave0, l); } } \
        SEAM(k0 + 4); \
        if (IN(k0 + 5)) { ph_mix1b(lds, wave0, l); if (REP_SCAN > 1) { __syncthreads(); ph_mix1b(lds, wave0, l); } } \
        SEAM(k0 + 5); \
        if (IN(k0 + 6)) { ph_mix2(lds, wave0, l); if (REP_GEMM > 1) { __syncthreads(); ph_mix2(lds, wave0, l); } } \
        SEAM(k0 + 6); \
        if (IN(k0 + 7)) { ph_merge(lds, wave0, l); if (REP_GEMM > 1) { __syncthreads(); ph_merge(lds, wave0, l); } } \
        SEAM(k0 + 7); \
        if (IN(k0 + 8)) { ph_out(lds, wave0, l); if (REP_GEMM > 1) { __syncthreads(); ph_out(lds, wave0, l); } } \
        SEAM(k0 + 8); \
        if (IN(k0 + 9)) ph_norm(lds, wave0, 1, l, 1, 1, 0); \
        SEAM(k0 + 9); \
        if (IN(k0 + 10)) ph_norm(lds, wave0, 1, l, 1, 2, l * 2 + 1); \
        SEAM(k0 + 10); \
        if (IN(k0 + 11)) { ph_ffn_in(lds, wave0, l * 2 + 1); if (REP_GEMM > 1 || REP_FFI > 1) { __syncthreads(); ph_ffn_in(lds, wave0, l * 2 + 1); } } \
        SEAM(k0 + 11); \
        if (IN(k0 + 12)) { ph_ffn_out(lds, wave0, l * 2 + 1); if (REP_GEMM > 1 || REP_FFO > 1) { __syncthreads(); ph_ffn_out(lds, wave0, l * 2 + 1); } } \
        SEAM(k0 + 12); \
        if (l == 0) { \
            if (IN(k0 + 13)) ph_norm(lds, wave0, 1, l, 2, 1, 0); \
            SEAM(k0 + 13); \
            if (IN(k0 + 14)) ph_norm(lds, wave0, 1, l, 2, 2, 2); \
            SEAM(k0 + 14); \
        } else { \
            if (IN(k0 + 13)) ph_norm(lds, wave0, 2, l, 2, 0, 0); \
        } \
    }
    LAYER(0)
    LAYER(1)
#undef LAYER
#undef IN
#undef SEAM
}

extern "C" void kernel_launch(void* const* d_in, const int* in_sizes, int n_in, void* d_out, int out_size, void* d_ws, size_t ws_size, hipStream_t stream) {
    static int grid = 0;
    if (grid == 0) {
        if (n_in != 22 || out_size != 50331648 || ws_size < WS_END) { fprintf(stderr, "kernel_launch: unexpected shapes (n_in %d, out %d, ws %zu); nothing launched\n", n_in, out_size, ws_size); grid = -1; return; }
        int dev = 0, cus = 0, per_cu = 0;
        if (hipGetDevice(&dev) != hipSuccess || hipDeviceGetAttribute(&cus, hipDeviceAttributeMultiprocessorCount, dev) != hipSuccess) { grid = -1; return; }
        if (hipFuncSetAttribute((const void*)mk_fwd, hipFuncAttributeMaxDynamicSharedMemorySize, LDS_BYTES) != hipSuccess) { fprintf(stderr, "kernel_launch: hipFuncSetAttribute failed\n"); grid = -1; return; }
        if (hipOccupancyMaxActiveBlocksPerMultiprocessor(&per_cu, (const void*)mk_fwd, NTHR, LDS_BYTES) != hipSuccess || per_cu < 1)
            fprintf(stderr, "kernel_launch: note: occupancy query reports %d workgroups per CU\n", per_cu);
        (void)hipGetLastError();
        grid = cus;
    }
    if (grid < 0) return;
    if (hipMemsetAsync((char*)d_ws + WS_CTL, 0, CTL_ZERO_BYTES, stream) != hipSuccess) { fprintf(stderr, "kernel_launch: memset failed\n"); return; }
    Args a{};
    for (int i = 0; i < 22; ++i) a.in[i] = (const float*)d_in[i];
    a.out = (float*)d_out; a.ws = (unsigned char*)d_ws;
#if MK_PER_PHASE
    for (int k = 0; k < NPH; ++k) { a.ph_lo = k; a.ph_hi = k + 1; a.li = k;
        hipLaunchKernelGGL(mk_fwd, dim3(grid), dim3(NTHR), LDS_BYTES, stream, a); }
#else
    a.ph_lo = 0; a.ph_hi = NPH; a.li = 0;
    hipLaunchKernelGGL(mk_fwd, dim3(grid), dim3(NTHR), LDS_BYTES, stream, a);
#endif
    const hipError_t le = hipPeekAtLastError();
    if (le != hipSuccess) fprintf(stderr, "kernel_launch: launch failed: %s\n", hipGetErrorName(le));
}
```

```cpp
#include <hip/hip_runtime.h>
#include <cstdio>
#include <cstdint>

namespace pg8 {
#define PG8_LAS __attribute__((address_space(3)))
typedef unsigned short bf16_t;
typedef short bf16x8 __attribute__((ext_vector_type(8)));
typedef float f32x4 __attribute__((ext_vector_type(4)));
typedef unsigned u32x4 __attribute__((ext_vector_type(4)));
typedef unsigned u32x2 __attribute__((ext_vector_type(2)));
constexpr int BM = 256, BK = 64, HALF = 128, HTB = HALF * BK * 2, STAGE_BYTES = 8 * HTB, NXCD = 8, WGM = 8;

__host__ __device__ __forceinline__ int lds_byte(int r, int c) { const int st = (r >> 4) * 2 + (c >> 5), rr = r & 15, cc = c & 31, ob = rr * 64 + cc * 2; return st * 1024 + (ob ^ (((ob >> 9) & 1) << 5)); }
__host__ __device__ __forceinline__ void stage_rc(int b, int& R, int& C) { const int st = b / 1024, sb = b % 1024, swz = sb ^ (((sb >> 9) & 1) << 5); R = (st >> 1) * 16 + swz / 64; C = (st & 1) * 32 + (swz % 64) / 2; }
__host__ __device__ __forceinline__ int perm32(int rho) { const int n = rho >> 4, i = rho & 15; return 8 * (i >> 2) + 4 * n + (i & 3); }

struct Unit { int pm, pn, z; };
struct Gemm { const bf16_t* A; const bf16_t* Bt; int lda, ldb; size_t zA, zB; int K0, K1; unsigned* dummy; };

struct ZOrder {
    static constexpr bool CUSTOM_NT = false;
    int nM, nN, nZ, ntile, G, c, zinner;
    __device__ void init(int nM_, int nN_, int nZ_, int G_, int c_, int zinner_) { nM = nM_; nN = nN_; nZ = nZ_; ntile = nM_ * nN_; G = G_; c = c_; zinner = zinner_; }
    __device__ void map(int wgid, Unit& u) const {
        { const int q = ntile / NXCD, r = ntile % NXCD, xcd = wgid % NXCD, off = wgid / NXCD; wgid = (xcd < r ? xcd * (q + 1) : r * (q + 1) + (xcd - r) * q) + off; }
        const int nig = WGM * nN, gid = wgid / nig, fm = gid * WGM, gsz = (nM - fm) < WGM ? (nM - fm) : WGM;
        u.pm = fm + ((wgid % nig) % gsz); u.pn = (wgid % nig) / gsz;
    }
    __device__ bool next(int i, Unit& u) const {
        long L; int z;
        if (zinner) { const int ti = i / nZ; z = i - ti * nZ; L = (long)ti * G + c; if (L >= ntile) return false; }
        else { L = (long)i * G + c; if (L >= (long)ntile * nZ) return false; z = (int)(L / ntile); L -= (long)z * ntile; }
        int wgid = (int)L; { const int q = ntile / NXCD, r = ntile % NXCD, xcd = wgid % NXCD, off = wgid / NXCD; wgid = (xcd < r ? xcd * (q + 1) : r * (q + 1) + (xcd - r) * q) + off; }
        const int nig = WGM * nN, gid = wgid / nig, fm = gid * WGM, gsz = (nM - fm) < WGM ? (nM - fm) : WGM;
        u.pm = fm + ((wgid % nig) % gsz); u.pn = (wgid % nig) / gsz; u.z = z; return true;
    }
};

struct MergeOrder {
    static constexpr bool CUSTOM_NT = false;
    ZOrder Z; int G, c, n1;
    __device__ void init(int G_, int c_) { G = G_; c = c_; Z.init(48, 8, 3, G_, c_, 1); const int r = 384 - G_; n1 = (r > 0 && 2 * r <= G_) ? r : 0; }
    __device__ bool next(int i, Unit& u) const {
        bool ok;
        if (n1 == 0 || i < 3) ok = Z.next(i, u);
        else if (c < n1) { ok = i < 5; Z.map(G + c, u); u.z = i - 3; }
        else if (c < 2 * n1) { ok = i < 4; Z.map(G + c - n1, u); u.z = 2; }
        else ok = false;
        u.pm = __builtin_amdgcn_readfirstlane(u.pm); u.pn = __builtin_amdgcn_readfirstlane(u.pn); u.z = __builtin_amdgcn_readfirstlane(u.z);
        return ok;
    }
};

struct SplitKOrder {
    static constexpr bool CUSTOM_NT = true;
    ZOrder Z; int G, c, n1, pm2, pn2, ntf, nt0, nt1;
    __device__ void init(int G_, int c_, int Kfull, int K0h) { G = G_; c = c_; Z.init(48, 8, 1, G_, c_, 0); const int r = 384 - G_; n1 = (r > 0 && 2 * r <= G_) ? r : 0; ntf = Kfull / BK; nt0 = K0h / BK; nt1 = (Kfull - K0h) / BK;
        Unit u2; u2.pm = -1; u2.pn = -1; if (n1 > 0 && c_ < 2 * n1) Z.map(G_ + (c_ < n1 ? c_ : c_ - n1), u2); pm2 = __builtin_amdgcn_readfirstlane(u2.pm); pn2 = __builtin_amdgcn_readfirstlane(u2.pn); }
    __device__ bool next(int i, Unit& u) const {
        bool ok;
        if (n1 == 0) { const int L = i * G + c; ok = L < 384; if (ok) Z.map(L, u); u.z = 0; }
        else if (i == 0) { ok = c < 384; Z.map(c < 384 ? c : 0, u); u.z = 0; }
        else if (i == 1 && c < n1) { ok = true; Z.map(G + c, u); u.z = 0; }
        else if (i == 1 && c < 2 * n1) { ok = true; Z.map(G + c - n1, u); u.z = 1; }
        else ok = false;
        u.pm = __builtin_amdgcn_readfirstlane(u.pm); u.pn = __builtin_amdgcn_readfirstlane(u.pn); u.z = __builtin_amdgcn_readfirstlane(u.z);
        return ok;
    }
    __device__ int nt(const Unit& u) const { const int z1 = (u.z == 1) ? 1 : 0, sp = (u.pm == pm2 && u.pn == pn2) ? 1 : 0; return z1 * nt1 + (1 - z1) * (sp * nt0 + (1 - sp) * ntf); }
};

struct FfnOrder {
    static constexpr bool CUSTOM_NT = false;
    ZOrder Z; int G, c, pre;
    __device__ void init(int G_, int c_, int pre_) { G = G_; c = c_; pre = pre_; Z.init(48, 42, 1, G_, c_, 0); }
    __device__ bool next(int i, Unit& u) const {
        if (pre) { if (i > 0 || c >= 16) return false; u.pm = c; u.pn = 42; u.z = 0; return true; }
        const long L = (long)i * G + c;
        if (L < 2016) return Z.next(i, u);
        if (L >= 2048) return false;
        u.pm = 16 + (int)(L - 2016); u.pn = 42; u.z = 0; return true;
    }
};

struct FfnPreOrder {
    static constexpr bool CUSTOM_NT = true;
    int c, split, ntk;
    __device__ void init(int G_, int c_, int K) { c = c_; split = G_ >= 64 ? 1 : 0; ntk = K / BK; }
    __device__ int nblk() const { return split ? 32 : 16; }
    __device__ bool next(int i, Unit& u) const { if (i > 0 || c >= nblk()) return false; u.pm = c & 15; u.pn = 42; u.z = c >> 4; return true; }
    __device__ int nt(const Unit&) const { return split ? ntk / 2 : ntk; }
};

__device__ __forceinline__ unsigned cvt_pk_bf16(float lo, float hi) { unsigned r; asm volatile("v_cvt_pk_bf16_f32 %0, %1, %2" : "=v"(r) : "v"(lo), "v"(hi)); return r; }

template <class Epi, class Sched>
__device__ __forceinline__ void gemm_phase(PG8_LAS unsigned char* lds, const Gemm g, const Sched& S, const Epi& E, const int tid) {
    const int wid = __builtin_amdgcn_readfirstlane(tid >> 6), lane = tid & 63, wr = wid >> 2, wc = wid & 3, fr = lane & 15, fq = lane >> 4;
    unsigned voffA[2], voffB[2];
#pragma unroll
    for (int i = 0; i < 2; ++i) { int R, C; stage_rc(tid * 16 + i * 8192, R, C); const int Rb = Epi::PERM ? ((R & ~31) + perm32(R & 31)) : R;
        voffA[i] = (unsigned)(R * g.lda + C) * 2u; voffB[i] = (unsigned)(Rb * g.ldb + C) * 2u; }
    const size_t kstep = (size_t)(BK * 2);
    const size_t hA = (size_t)HALF * g.lda * 2, hB = (size_t)HALF * g.ldb * 2;
    const unsigned ldsw = (unsigned)wid * 1024u;
    const int aoff = lds_byte(wr * 64 + fr, fq * 8), boff = lds_byte(wc * 32 + fr, fq * 8);
#define PG8_SA(b, h) (((b) * 2 + (h)) * HTB)
#define PG8_SB(b, h) ((4 + (b) * 2 + (h)) * HTB)
#define PG8_STAGE(bufoff, gbase, voff) do { _Pragma("unroll") for (int _i = 0; _i < 2; ++_i) \
        __builtin_amdgcn_global_load_lds((const unsigned*)((const char*)(gbase) + (voff)[_i]), (PG8_LAS unsigned*)(lds + (bufoff) + ldsw + _i * 8192), 16, 0, 0); } while (0)
#define PG8_LDA(dst, b, h) do { _Pragma("unroll") for (int m = 0; m < 4; ++m) _Pragma("unroll") for (int k = 0; k < 2; ++k) dst[m][k] = *(const PG8_LAS bf16x8*)(lds + PG8_SA(b, h) + aoff + m * 2048 + k * 1024); } while (0)
#define PG8_LDB(dst, b, h) do { _Pragma("unroll") for (int n = 0; n < 2; ++n) _Pragma("unroll") for (int k = 0; k < 2; ++k) dst[n][k] = *(const PG8_LAS bf16x8*)(lds + PG8_SB(b, h) + boff + n * 2048 + k * 1024); } while (0)
#define PG8_MMA(ai, bj, At, Bt) do { __builtin_amdgcn_s_setprio(1); _Pragma("unroll") for (int m = 0; m < 4; ++m) _Pragma("unroll") for (int n = 0; n < 2; ++n) _Pragma("unroll") for (int k = 0; k < 2; ++k) \
        acc[ai][bj][m][n] = __builtin_amdgcn_mfma_f32_16x16x32_bf16(Bt[n][k], At[m][k], acc[ai][bj][m][n], 0, 0, 0); __builtin_amdgcn_s_setprio(0); } while (0)
#define PG8_WAIT_V(n) asm volatile("s_waitcnt vmcnt(" #n ")" ::: "memory")
#define PG8_WAIT_VN(n) asm volatile("s_waitcnt vmcnt(%0)" :: "n"(n) : "memory")
#define PG8_WAIT_L(n) asm volatile("s_waitcnt lgkmcnt(" #n ")" ::: "memory")
#define PG8_BAR __builtin_amdgcn_s_barrier()
#define PG8_SCHED __builtin_amdgcn_sched_barrier(0)
#define PG8_ABASE(u) ((const char*)g.A + ((size_t)(u).z * g.zA) * 2 + (size_t)(u).pm * 2 * hA)
#define PG8_BBASE(u) ((const char*)g.Bt + ((size_t)(u).z * g.zB) * 2 + (size_t)(u).pn * 2 * hB)
    Unit cur, nxt; int ui = 0;
    if (!S.next(0, cur)) return;
    f32x4 acc[2][2][4][2];
#pragma unroll
    for (int a = 0; a < 2; ++a)
#pragma unroll
        for (int b = 0; b < 2; ++b)
#pragma unroll
            for (int m = 0; m < 4; ++m)
#pragma unroll
                for (int n = 0; n < 2; ++n) acc[a][b][m][n] = (f32x4){0.f, 0.f, 0.f, 0.f};
    bf16x8 At[4][2], B0[2][2], B1[2][2];
    const char* cA = PG8_ABASE(cur); const char* cB = PG8_BBASE(cur);
    int nt; if constexpr (Sched::CUSTOM_NT) nt = S.nt(cur); else nt = (cur.z == 0 ? g.K0 : g.K1) / BK;
    PG8_STAGE(PG8_SB(0, 0), cB, voffB); PG8_STAGE(PG8_SB(0, 1), cB + hB, voffB); PG8_STAGE(PG8_SA(0, 0), cA, voffA); PG8_STAGE(PG8_SA(0, 1), cA + hA, voffA);
    if (wr == 1) PG8_BAR;
    PG8_WAIT_V(2); PG8_BAR;
    PG8_STAGE(PG8_SB(1, 0), cB + kstep, voffB); PG8_STAGE(PG8_SA(1, 0), cA + kstep, voffA); PG8_STAGE(PG8_SB(1, 1), cB + hB + kstep, voffB);
    PG8_WAIT_V(6); PG8_BAR;
    if (Epi::NSTORE > 0) { unsigned* dp = g.dummy + blockIdx.x * 512 + tid;
#pragma unroll
        for (int i = 0; i < Epi::NSTORE; ++i) asm volatile("global_store_dword %0, %1, off" :: "v"(dp), "v"(i) : "memory"); }
    for (;;) {
        const bool has_next = S.next(ui + 1, nxt);
        const char* nA = has_next ? PG8_ABASE(nxt) : cA; const char* nB = has_next ? PG8_BBASE(nxt) : cB;
#define PG8_KBODY(WV) do { \
              \
            PG8_LDB(B0, 0, 0); PG8_LDB(B1, 0, 1); PG8_SCHED; PG8_LDA(At, 0, 0); PG8_STAGE(PG8_SA(1, 1), a1 + hA, voffA); \
            PG8_WAIT_VN(WV); PG8_WAIT_L(0); PG8_BAR; PG8_MMA(0, 0, At, B0); PG8_MMA(0, 1, At, B1); PG8_BAR; PG8_SCHED; \
              \
            PG8_LDA(At, 0, 1); PG8_STAGE(PG8_SB(0, 0), b2, voffB); PG8_STAGE(PG8_SB(0, 1), b2 + hB, voffB); PG8_STAGE(PG8_SA(0, 0), a2, voffA); \
            PG8_WAIT_VN(WV); PG8_WAIT_L(0); PG8_BAR; PG8_MMA(1, 0, At, B0); PG8_MMA(1, 1, At, B1); PG8_BAR; PG8_SCHED; \
              \
            PG8_LDB(B0, 1, 0); PG8_LDB(B1, 1, 1); PG8_SCHED; PG8_LDA(At, 1, 0); PG8_STAGE(PG8_SA(0, 1), a2 + hA, voffA); \
            PG8_WAIT_VN(WV); PG8_WAIT_L(0); PG8_BAR; PG8_MMA(0, 0, At, B0); PG8_MMA(0, 1, At, B1); PG8_BAR; PG8_SCHED; \
              \
            PG8_LDA(At, 1, 1); PG8_STAGE(PG8_SB(1, 0), b3, voffB); PG8_STAGE(PG8_SB(1, 1), b3 + hB, voffB); PG8_STAGE(PG8_SA(1, 0), a3, voffA); \
            PG8_WAIT_VN(WV); PG8_WAIT_L(0); PG8_BAR; PG8_MMA(1, 0, At, B0); PG8_MMA(1, 1, At, B1); PG8_BAR; PG8_SCHED; } while (0)
        int t = 0;
        if (Epi::NSTORE > 0) {
            const char* a1 = cA + kstep; const char* a2 = cA + 2 * kstep; const char* b2 = cB + 2 * kstep; const char* a3 = a2 + kstep; const char* b3 = b2 + kstep;
            PG8_KBODY(8 + Epi::NSTORE); t = 2;
        }
        for (; t < nt; t += 2) {
            const bool last = (t == nt - 2);
            const char* a1 = cA + (size_t)(t + 1) * kstep;
            const char* a2 = last ? nA : cA + (size_t)(t + 2) * kstep; const char* b2 = last ? nB : cB + (size_t)(t + 2) * kstep;
            const char* a3 = a2 + kstep; const char* b3 = b2 + kstep;
            PG8_KBODY(8);
        }
#undef PG8_KBODY
        if (wr == 0) PG8_BAR;
        {
            unsigned zz_ = 0u; asm volatile("" : "+v"(zz_)); const int ln_ = (int)__builtin_amdgcn_mbcnt_hi(~0u, __builtin_amdgcn_mbcnt_lo(~0u, zz_));
            E(acc, cur, wr, wc, ln_ & 15, ln_ >> 4);
        }
        if (!has_next) break;
#pragma unroll
        for (int a = 0; a < 2; ++a)
#pragma unroll
            for (int b = 0; b < 2; ++b)
#pragma unroll
                for (int m = 0; m < 4; ++m)
#pragma unroll
                    for (int n = 0; n < 2; ++n) acc[a][b][m][n] = (f32x4){0.f, 0.f, 0.f, 0.f};
        cur = nxt; cA = nA; cB = nB; ++ui; if constexpr (Sched::CUSTOM_NT) nt = S.nt(cur); else nt = (cur.z == 0 ? g.K0 : g.K1) / BK;
        if (wr == 1) PG8_BAR;
    }
    PG8_WAIT_V(0);
    PG8_BAR;
#undef PG8_SA
#undef PG8_SB
#undef PG8_STAGE
#undef PG8_LDA
#undef PG8_LDB
#undef PG8_MMA
#undef PG8_WAIT_V
#undef PG8_WAIT_VN
#undef PG8_WAIT_L
#undef PG8_BAR
#undef PG8_SCHED
#undef PG8_ABASE
#undef PG8_BBASE
}
}

constexpr int DM = 2048, MCTX = 4096, MLAT = 8192, MTOK = 12288;
constexpr int FF = 5504, FF2 = 11008, INC = 13344, INP = 13568;
constexpr int NMOD = 9;
constexpr float EPS = 1e-6f;
constexpr int NWAVES = 8, NTHR = 512;

constexpr size_t MiB = 1u << 20;
constexpr size_t WS_CTL = 0, CTL_ZERO_BYTES = 65536;
constexpr size_t WS_MOD = 1 * MiB;
constexpr size_t WS_ROPE = 1 * MiB + 768 * 1024;
constexpr size_t WS_WFI = 2 * MiB;
constexpr size_t WS_WFO = 174 * MiB;
constexpr size_t WS_WIN = 260 * MiB;
constexpr size_t WS_WBR = 366 * MiB;
constexpr size_t WS_WOUT = 390 * MiB;
constexpr size_t WS_WPOOL = 406 * MiB;
constexpr size_t WS_H = 408 * MiB;
constexpr size_t WS_A = 456 * MiB;
constexpr size_t WS_B = 776 * MiB;
constexpr size_t WS_PL = 968 * MiB;
constexpr size_t WS_BR = 992 * MiB;
constexpr size_t WS_MG = 1064 * MiB;
constexpr size_t WS_CKB = 1112 * MiB;
constexpr size_t WS_CVT = 1120 * MiB;
constexpr size_t WS_QI = 1128 * MiB;
constexpr size_t WS_KI = 1152 * MiB;
constexpr size_t WS_KDT = 1176 * MiB;
constexpr size_t WS_DEC = 1200 * MiB;
constexpr size_t WS_PT = 1202 * MiB;
constexpr size_t WS_END = 1216 * MiB;
constexpr size_t PA_U = 0, PA_NQ = 24 * MiB, PA_NK = 48 * MiB, PA_NV = 72 * MiB, PA_GV = 96 * MiB, PA_GR = 120 * MiB, PA_GQ = 144 * MiB, PA_GK = 156 * MiB, PA_GL = 168 * MiB, PA_GZ = 312 * MiB;

constexpr int CW_MFLAG = 8192;
constexpr int CW_BAR = 4096;
constexpr int RING_BYTES = 131072;
constexpr int LDSCTL_OFF = RING_BYTES, MISC_OFF = LDSCTL_OFF + 320;
constexpr int LDS_BYTES = 155648, TS_OFF = RING_BYTES + 1024, TS_WAVE = 2688;

constexpr int NPH = 34;
#define REP_MIX1 1
#define REP_GEMM 1
#define REP_PRO 1
#define REP_SCAN 1
#define REP_ATT 1
#define REP_FFI 1
#define REP_INP 1
#define REP_FFO 1
#ifndef MK_PER_PHASE
#define MK_PER_PHASE 0
#endif

#define GAS __attribute__((address_space(1)))
#define LAS __attribute__((address_space(3)))
typedef unsigned short bf16;
typedef unsigned v4u __attribute__((ext_vector_type(4)));
typedef unsigned v2u __attribute__((ext_vector_type(2)));
typedef float f32x4 __attribute__((ext_vector_type(4)));
typedef float f32x2 __attribute__((ext_vector_type(2)));
typedef GAS unsigned gu32;
#define RLX_AGENT __ATOMIC_RELAXED, __HIP_MEMORY_SCOPE_AGENT
#define LDS_WAIT() asm volatile("s_waitcnt lgkmcnt(0)" ::: "memory")
__device__ __forceinline__ unsigned f2bf(float f) { unsigned u = __builtin_bit_cast(unsigned, f); return (u + 0x7fffu + ((u >> 16) & 1u)) >> 16; }
__device__ __forceinline__ unsigned pk2(float lo, float hi) { return f2bf(lo) | (f2bf(hi) << 16); }
__device__ __forceinline__ float bflo(unsigned w) { return __builtin_bit_cast(float, w << 16); }
__device__ __forceinline__ float bfhi(unsigned w) { return __builtin_bit_cast(float, w & 0xffff0000u); }
__device__ __forceinline__ float bf2f(bf16 b) { return __builtin_bit_cast(float, ((unsigned)b) << 16); }
__device__ __forceinline__ float sigmoid_f(float x) { return __builtin_amdgcn_rcpf(1.f + __builtin_amdgcn_exp2f(x * -1.4426950408889634f)); }
__device__ __forceinline__ float silu_f(float x) { return x * sigmoid_f(x); }
__device__ __forceinline__ f32x4 sigmoid4(f32x4 x) { const f32x4 t = x * -1.4426950408889634f; f32x4 e; e.x = __builtin_amdgcn_exp2f(t.x); e.y = __builtin_amdgcn_exp2f(t.y); e.z = __builtin_amdgcn_exp2f(t.z); e.w = __builtin_amdgcn_exp2f(t.w);
    const f32x4 d = e + 1.0f; f32x4 r; r.x = __builtin_amdgcn_rcpf(d.x); r.y = __builtin_amdgcn_rcpf(d.y); r.z = __builtin_amdgcn_rcpf(d.z); r.w = __builtin_amdgcn_rcpf(d.w); return r; }

#define XB_TMO      128
#define XB_XCNT(j)  (256  + 64 * (j))
#define XB_XSUB(j)  (1280 + 64 * (j))
#define XB_XGEN(j)  (2304 + 64 * (j))
#define XB_TOP      3328
#define XB_TOPGEN   3392
#define XCD_BAR_WORDS 3456
#define XB_SPIN_CAP (1u << 18)
__device__ __forceinline__ unsigned xb_ld(unsigned* p)              { return __hip_atomic_load(p, __ATOMIC_RELAXED, __HIP_MEMORY_SCOPE_AGENT); }
__device__ __forceinline__ unsigned xb_add(unsigned* p, unsigned v) { return __hip_atomic_fetch_add(p, v, __ATOMIC_RELAXED, __HIP_MEMORY_SCOPE_AGENT); }
__device__ __forceinline__ unsigned xb_xcc_id() { return (unsigned)__builtin_amdgcn_s_getreg((3 << 11) | 20) & 0xFu; }
#define XB_SPIN(cond, bar) do { unsigned _sp = 0; while (cond) { __builtin_amdgcn_s_sleep(1); \
    if ((++_sp & 255u) == 0u) { if (xb_ld(&(bar)[XB_TMO])) break; if (_sp > XB_SPIN_CAP) { atomicAdd(&(bar)[XB_TMO], 1u); break; } } } } while (0)
struct XcdBarrier { unsigned* bar; unsigned x; volatile LAS unsigned* st; };
__device__ __forceinline__ XcdBarrier xcd_barrier_post(unsigned* bar, volatile LAS unsigned* st) {
    XcdBarrier b; b.bar = bar; b.x = (unsigned)__builtin_amdgcn_readfirstlane((int)xb_xcc_id()); b.st = st;
    if (threadIdx.x == 0) (void)xb_add(&bar[XB_XCNT(b.x)], 1u);
    return b;
}
__device__ __forceinline__ void xcd_barrier_complete(unsigned* bar, unsigned x, unsigned& nloc, unsigned& nx) {
    const unsigned G = gridDim.x * gridDim.y * gridDim.z;
    unsigned sum, cnt, mine, sp = 0u;
    for (;;) {
        sum = 0u; cnt = 0u;
#pragma unroll 1
        for (unsigned j = 0; j < 16; ++j) { const unsigned c = xb_ld(&bar[XB_XCNT(j)]); sum += c; cnt += (c > 0u) ? 1u : 0u; }
        if (sum == G) break;
        __builtin_amdgcn_s_sleep(1);
        if ((++sp & 255u) == 0u) { if (xb_ld(&bar[XB_TMO])) break; if (sp > XB_SPIN_CAP) { atomicAdd(&bar[XB_TMO], 1u); break; } }
    }
    mine = xb_ld(&bar[XB_XCNT(x)]);
    nloc = mine > 0u ? mine : 1u; nx = cnt > 0u ? cnt : 1u;
}
static __device__ __forceinline__ void xcd_barrier_impl(unsigned* bar_, unsigned x_, volatile LAS unsigned* st_, int tid_) {
    XcdBarrier b; b.bar = bar_; b.x = x_; b.st = st_;
    asm volatile("s_waitcnt vmcnt(0)" ::: "memory");
    __syncthreads();
    if (tid_ == 0) {
        unsigned* bar = b.bar;
        __builtin_amdgcn_s_waitcnt(0);
        unsigned nloc = b.st[0], nx = b.st[1];
        if (nloc == 0u) { xcd_barrier_complete(bar, b.x, nloc, nx); b.st[0] = nloc; b.st[1] = nx; }
        const unsigned old = xb_add(&bar[XB_XSUB(b.x)], 1u);
        const unsigned gen = old / nloc;
        if (old + 1u == (gen + 1u) * nloc) {
            __builtin_amdgcn_fence(__ATOMIC_RELEASE, "agent");
            asm volatile("s_waitcnt vmcnt(0)" ::: "memory");
            const unsigned og = xb_add(&bar[XB_TOP], 1u);
            const unsigned tg = og / nx;
            if (og + 1u == (tg + 1u) * nx) xb_add(&bar[XB_TOPGEN], 1u);
            else XB_SPIN(xb_ld(&bar[XB_TOPGEN]) == tg, bar);
            __builtin_amdgcn_fence(__ATOMIC_ACQUIRE, "agent");
            xb_add(&bar[XB_XGEN(b.x)], 1u);
            asm volatile("s_waitcnt vmcnt(0)" ::: "memory");
        } else {
            XB_SPIN(xb_ld(&bar[XB_XGEN(b.x)]) == gen, bar);
            __builtin_amdgcn_fence(__ATOMIC_ACQUIRE, "agent");
            asm volatile("s_waitcnt vmcnt(0)" ::: "memory");
        }
    }
    __syncthreads();
}

using pg8::Unit; using pg8::cvt_pk_bf16;
struct EpiSwiGLU {
    static constexpr bool PERM = true; static constexpr int NSTORE = 8;
    bf16* ACT;
    __device__ __forceinline__ void operator()(const f32x4 (&acc)[2][2][4][2], const Unit& u, int wr, int wc, int fr, int fq) const {
        const int row0 = u.pm * 256 + wr * 64 + fr, col0 = u.pn * 128 + wc * 32 + 8 * fq;
#pragma unroll
        for (int ai = 0; ai < 2; ++ai)
#pragma unroll
            for (int m = 0; m < 4; ++m) {
                bf16* rowp = ACT + (size_t)(row0 + ai * 128 + m * 16) * FF + col0;
                const f32x4 v0 = (acc[ai][0][m][0] * acc[ai][1][m][0]) * sigmoid4(acc[ai][0][m][0]), v1 = (acc[ai][0][m][1] * acc[ai][1][m][1]) * sigmoid4(acc[ai][0][m][1]);
                v4u w; w.x = cvt_pk_bf16(v0[0], v0[1]); w.y = cvt_pk_bf16(v0[2], v0[3]); w.z = cvt_pk_bf16(v1[0], v1[1]); w.w = cvt_pk_bf16(v1[2], v1[3]);
                *(v4u*)rowp = w;
            }
    }
};
struct EpiSwiGLUPre {
    static constexpr bool PERM = true; static constexpr int NSTORE = 0;
    bf16* ACT; bf16* P; unsigned* flag; int role;
    __device__ __forceinline__ void operator()(const f32x4 (&acc)[2][2][4][2], const Unit& u, int wr, int wc, int fr, int fq) const {
        const int row0 = u.pm * 256 + wr * 64 + fr, col0 = u.pn * 128 + wc * 32 + 8 * fq;
        const int tidl = (wr * 4 + wc) * 64 + fq * 16 + fr;
        bf16* Pt = P + (size_t)tidl * 8;
        if (role == 2) {
#pragma unroll
            for (int ai = 0; ai < 2; ++ai)
#pragma unroll
                for (int m = 0; m < 4; ++m)
#pragma unroll
                    for (int bj = 0; bj < 2; ++bj) { const f32x4 v0 = acc[ai][bj][m][0], v1 = acc[ai][bj][m][1];
                        v4u w; w.x = cvt_pk_bf16(v0[0], v0[1]); w.y = cvt_pk_bf16(v0[2], v0[3]); w.z = cvt_pk_bf16(v1[0], v1[1]); w.w = cvt_pk_bf16(v1[2], v1[3]);
                        *(v4u*)(Pt + (size_t)(((ai * 4 + m) * 2 + bj) * 512) * 8) = w; }
            asm volatile("s_waitcnt vmcnt(0)" ::: "memory");
            __builtin_amdgcn_s_barrier();
            if (tidl == 0) { __builtin_amdgcn_fence(__ATOMIC_RELEASE, "agent"); asm volatile("s_waitcnt vmcnt(0)" ::: "memory"); __hip_atomic_store(flag, 1u, __ATOMIC_RELAXED, __HIP_MEMORY_SCOPE_AGENT); }
            return;
        }
        if (role == 1) {
            if (tidl == 0) { unsigned sp = 0u; while (__hip_atomic_load(flag, __ATOMIC_RELAXED, __HIP_MEMORY_SCOPE_AGENT) == 0u) { __builtin_amdgcn_s_sleep(2); if (++sp > (1u << 26)) break; }
                __builtin_amdgcn_fence(__ATOMIC_ACQUIRE, "agent"); }
            asm volatile("s_waitcnt vmcnt(0) lgkmcnt(0)" ::: "memory");
            __builtin_amdgcn_s_barrier();
        }
#pragma unroll
        for (int ai = 0; ai < 2; ++ai) {
            v4u hw[4][2];
#pragma unroll
            for (int m = 0; m < 4; ++m)
#pragma unroll
                for (int bj = 0; bj < 2; ++bj) hw[m][bj] = role == 1 ? *(const v4u*)(Pt + (size_t)(((ai * 4 + m) * 2 + bj) * 512) * 8) : (v4u){0u, 0u, 0u, 0u};
#pragma unroll
            for (int m = 0; m < 4; ++m) {
                bf16* rowp = ACT + (size_t)(row0 + ai * 128 + m * 16) * FF + col0;
                const v4u hg = hw[m][0], hu = hw[m][1];
                f32x4 g0 = acc[ai][0][m][0], g1 = acc[ai][0][m][1], u0 = acc[ai][1][m][0], u1 = acc[ai][1][m][1];
                g0[0] += bflo(hg.x); g0[1] += bfhi(hg.x); g0[2] += bflo(hg.y); g0[3] += bfhi(hg.y); g1[0] += bflo(hg.z); g1[1] += bfhi(hg.z); g1[2] += bflo(hg.w); g1[3] += bfhi(hg.w);
                u0[0] += bflo(hu.x); u0[1] += bfhi(hu.x); u0[2] += bflo(hu.y); u0[3] += bfhi(hu.y); u1[0] += bflo(hu.z); u1[1] += bfhi(hu.z); u1[2] += bflo(hu.w); u1[3] += bfhi(hu.w);
                const f32x4 v0 = (g0 * u0) * sigmoid4(g0), v1 = (g1 * u1) * sigmoid4(g1);
                v4u w; w.x = cvt_pk_bf16(v0[0], v0[1]); w.y = cvt_pk_bf16(v0[2], v0[3]); w.z = cvt_pk_bf16(v1[0], v1[1]); w.w = cvt_pk_bf16(v1[2], v1[3]);
                *(v4u*)rowp = w;
            }
            asm volatile("" ::: "memory");
        }
    }
};
struct EpiY {
    static constexpr bool PERM = true; static constexpr int NSTORE = 16;
    bf16* Y; int ldc; unsigned char* ws; int slot, jt, n1, role, pm2, pn2;
    __device__ __forceinline__ void operator()(const f32x4 (&acc)[2][2][4][2], const Unit& u, int wr, int wc, int fr, int fq) const {
        const int row0 = u.pm * 256 + wr * 64 + fr, col0 = u.pn * 256 + wc * 32 + 8 * fq;
        const int tidl = (wr * 4 + wc) * 64 + fq * 16 + fr;
        const bool split = role != 0 && u.pm == pm2 && u.pn == pn2; const int uf = !split ? 0 : role;
        bf16* P = (bf16*)(ws + WS_B + 64 * MiB) + (size_t)jt * 65536 + (size_t)tidl * 8;
        unsigned* cw = (unsigned*)(ws + WS_CTL) + CW_MFLAG;
        if (uf == 1) {
            if (tidl == 0) { const unsigned hx = __hip_atomic_load(cw + n1 + jt, __ATOMIC_RELAXED, __HIP_MEMORY_SCOPE_AGENT) & 15u; unsigned* xflag = cw + 528 + slot * 16 + hx;
                unsigned sp = 0u; while (__hip_atomic_load(xflag, __ATOMIC_RELAXED, __HIP_MEMORY_SCOPE_AGENT) == 0u) { __builtin_amdgcn_s_sleep(2); if (++sp > (1u << 26)) break; }
                __builtin_amdgcn_fence(__ATOMIC_ACQUIRE, "agent"); }
            asm volatile("s_waitcnt vmcnt(0) lgkmcnt(0)" ::: "memory");
            __builtin_amdgcn_s_barrier();
        }
#pragma unroll
        for (int ai = 0; ai < 2; ++ai) {
            v4u hw[4][2];
#pragma unroll
            for (int m = 0; m < 4; ++m)
#pragma unroll
                for (int bj = 0; bj < 2; ++bj) hw[m][bj] = uf == 1 ? *(const v4u*)(P + (size_t)(((ai * 4 + m) * 2 + bj) * 512) * 8) : (v4u){0u, 0u, 0u, 0u};
#pragma unroll
            for (int m = 0; m < 4; ++m) { bf16* rowp = Y + (size_t)(row0 + ai * 128 + m * 16) * ldc + col0;
#pragma unroll
                for (int bj = 0; bj < 2; ++bj) { f32x4 v0 = acc[ai][bj][m][0], v1 = acc[ai][bj][m][1]; const v4u h = hw[m][bj];
                    v0[0] += bflo(h.x); v0[1] += bfhi(h.x); v0[2] += bflo(h.y); v0[3] += bfhi(h.y); v1[0] += bflo(h.z); v1[1] += bfhi(h.z); v1[2] += bflo(h.w); v1[3] += bfhi(h.w);
                    v4u w; w.x = cvt_pk_bf16(v0[0], v0[1]); w.y = cvt_pk_bf16(v0[2], v0[3]); w.z = cvt_pk_bf16(v1[0], v1[1]); w.w = cvt_pk_bf16(v1[2], v1[3]);
                    if (uf == 2) *(v4u*)(P + (size_t)(((ai * 4 + m) * 2 + bj) * 512) * 8) = w;
                    else *(v4u*)(rowp + bj * 128) = w; } }
            asm volatile("" ::: "memory");
        }
        if (uf == 2) {
            asm volatile("s_waitcnt vmcnt(0)" ::: "memory");
            __builtin_amdgcn_s_barrier();
            if (tidl == 0) {
                const unsigned hx = __hip_atomic_load(cw + n1 + jt, __ATOMIC_RELAXED, __HIP_MEMORY_SCOPE_AGENT) & 15u, hcnt = __hip_atomic_load(cw + 384 + hx, __ATOMIC_RELAXED, __HIP_MEMORY_SCOPE_AGENT);
                const unsigned old = __hip_atomic_fetch_add(cw + 400 + slot * 16 + hx, 1u, __ATOMIC_RELAXED, __HIP_MEMORY_SCOPE_AGENT);
                if (old + 1u == hcnt) { __builtin_amdgcn_fence(__ATOMIC_RELEASE, "agent"); asm volatile("s_waitcnt vmcnt(0)" ::: "memory"); __hip_atomic_store(cw + 528 + slot * 16 + hx, 1u, __ATOMIC_RELAXED, __HIP_MEMORY_SCOPE_AGENT); }
            }
        }
    }
};
struct EpiPool {
    static constexpr bool PERM = true; static constexpr int NSTORE = 0;
    bf16* O; const float* scale;
    __device__ __forceinline__ void operator()(const f32x4 (&acc)[2][2][4][2], const Unit& u, int wr, int wc, int fr, int fq) const {
        const int row0 = u.pm * 256 + wr * 64 + fr, col0 = u.z * 256 + wc * 32 + 8 * fq;
        f32x4 sc[2][2];
#pragma unroll
        for (int bj = 0; bj < 2; ++bj)
#pragma unroll
            for (int n = 0; n < 2; ++n) sc[bj][n] = *(const f32x4*)(scale + col0 + bj * 128 + 4 * n);
#pragma unroll
        for (int ai = 0; ai < 2; ++ai)
#pragma unroll
            for (int m = 0; m < 4; ++m) { bf16* rowp = O + (size_t)(row0 + ai * 128 + m * 16) * 1024 + col0;
#pragma unroll
                for (int bj = 0; bj < 2; ++bj) { const f32x4 v0 = acc[ai][bj][m][0] * sc[bj][0], v1 = acc[ai][bj][m][1] * sc[bj][1];
                    v4u w; w.x = cvt_pk_bf16(v0[0], v0[1]); w.y = cvt_pk_bf16(v0[2], v0[3]); w.z = cvt_pk_bf16(v1[0], v1[1]); w.w = cvt_pk_bf16(v1[2], v1[3]);
                    *(v4u*)(rowp + bj * 128) = w; } }
    }
};
struct EpiMerge {
    static constexpr bool PERM = true; static constexpr int NSTORE = 0;
    const bf16* GL; bf16* MS; bf16* MG; unsigned char* ws; int l, jt, n1, role, pm2, pn2;
    __device__ __forceinline__ void operator()(const f32x4 (&acc)[2][2][4][2], const Unit& u, int wr, int wc, int fr, int fq) const {
        const int row0 = u.pm * 256 + wr * 64 + fr, col0 = u.pn * 256 + wc * 32 + 8 * fq;
        const int tidl = (wr * 4 + wc) * 64 + fq * 16 + fr;
        const bool split = role != 0 && u.pm == pm2 && u.pn == pn2; const int uf = !split ? 0 : (role == 1 ? (u.z == 1 ? 1 : 0) : 2);
        const bool first = (u.z == 0) || (uf == 2), fin = (u.z == 2) && (uf == 0);
        bf16* mst = MS + ((size_t)u.pm * 8 + u.pn) * 65536;
        bf16* MS2 = (bf16*)(ws + WS_B + 64 * MiB) + (size_t)jt * 65536;
        bf16* msd = uf == 2 ? MS2 : mst;
#pragma unroll
        for (int ai = 0; ai < 2; ++ai) {
            v4u gw[4][2], mw[4][2];
#pragma unroll
            for (int m = 0; m < 4; ++m)
#pragma unroll
                for (int bj = 0; bj < 2; ++bj) { const size_t cidx = (size_t)(((ai * 4 + m) * 2 + bj) * 512 + tidl) * 8;
                    gw[m][bj] = *(const v4u*)(GL + ((size_t)u.pm * 24 + u.z * 8 + u.pn) * 65536 + cidx);
                    mw[m][bj] = !first ? *(const v4u*)(mst + cidx) : (v4u){0u, 0u, 0u, 0u}; }
#pragma unroll
            for (int m = 0; m < 4; ++m)
#pragma unroll
                for (int bj = 0; bj < 2; ++bj) { const size_t row = (size_t)(row0 + ai * 128 + m * 16); const int col = col0 + bj * 128; const size_t cidx = (size_t)(((ai * 4 + m) * 2 + bj) * 512 + tidl) * 8;
                    const v4u g = gw[m][bj], q = mw[m][bj];
                    f32x4 v0 = acc[ai][bj][m][0], v1 = acc[ai][bj][m][1];
                    v0[0] = v0[0] * bflo(g.x) + bflo(q.x); v0[1] = v0[1] * bfhi(g.x) + bfhi(q.x); v0[2] = v0[2] * bflo(g.y) + bflo(q.y); v0[3] = v0[3] * bfhi(g.y) + bfhi(q.y);
                    v1[0] = v1[0] * bflo(g.z) + bflo(q.z); v1[1] = v1[1] * bfhi(g.z) + bfhi(q.z); v1[2] = v1[2] * bflo(g.w) + bflo(q.w); v1[3] = v1[3] * bfhi(g.w) + bfhi(q.w);
                    v4u w; w.x = cvt_pk_bf16(v0[0], v0[1]); w.y = cvt_pk_bf16(v0[2], v0[3]); w.z = cvt_pk_bf16(v1[0], v1[1]); w.w = cvt_pk_bf16(v1[2], v1[3]);
                    if (!fin) *(v4u*)(msd + cidx) = w;
                    else *(v4u*)(MG + row * DM + col) = w; }
            asm volatile("" ::: "memory");
        }
        if (uf == 2) {
            asm volatile("s_waitcnt vmcnt(0)" ::: "memory");
            __builtin_amdgcn_s_barrier();
            if (tidl == 0) {
                unsigned* cw = (unsigned*)(ws + WS_CTL) + CW_MFLAG;
                const unsigned hx = __hip_atomic_load(cw + n1 + jt, __ATOMIC_RELAXED, __HIP_MEMORY_SCOPE_AGENT) & 15u, hcnt = __hip_atomic_load(cw + 384 + hx, __ATOMIC_RELAXED, __HIP_MEMORY_SCOPE_AGENT);
                unsigned* done = cw + 400 + l * 16 + hx; unsigned* xflag = cw + 528 + l * 16 + hx;
                const unsigned old = __hip_atomic_fetch_add(done, 1u, __ATOMIC_RELAXED, __HIP_MEMORY_SCOPE_AGENT);
                if (old + 1u == hcnt) { __builtin_amdgcn_fence(__ATOMIC_RELEASE, "agent"); asm volatile("s_waitcnt vmcnt(0)" ::: "memory"); __hip_atomic_store(xflag, 1u, __ATOMIC_RELAXED, __HIP_MEMORY_SCOPE_AGENT); }
            }
        }
        if (uf == 1) {
            if (tidl == 0) { unsigned* cw = (unsigned*)(ws + WS_CTL) + CW_MFLAG; const unsigned hx = __hip_atomic_load(cw + n1 + jt, __ATOMIC_RELAXED, __HIP_MEMORY_SCOPE_AGENT) & 15u; unsigned* xflag = cw + 528 + l * 16 + hx;
                unsigned sp = 0u; while (__hip_atomic_load(xflag, __ATOMIC_RELAXED, __HIP_MEMORY_SCOPE_AGENT) == 0u) { __builtin_amdgcn_s_sleep(2); if (++sp > (1u << 26)) break; }
                __builtin_amdgcn_fence(__ATOMIC_ACQUIRE, "agent"); }
            asm volatile("s_waitcnt vmcnt(0) lgkmcnt(0)" ::: "memory");
            __builtin_amdgcn_s_barrier();
#pragma unroll
            for (int ai = 0; ai < 2; ++ai) {
                v4u mw[4][2], hw[4][2];
#pragma unroll
                for (int m = 0; m < 4; ++m)
#pragma unroll
                    for (int bj = 0; bj < 2; ++bj) { const size_t cidx = (size_t)(((ai * 4 + m) * 2 + bj) * 512 + tidl) * 8; mw[m][bj] = *(const v4u*)(mst + cidx); hw[m][bj] = *(const v4u*)(MS2 + cidx); }
#pragma unroll
                for (int m = 0; m < 4; ++m)
#pragma unroll
                    for (int bj = 0; bj < 2; ++bj) { const size_t row = (size_t)(row0 + ai * 128 + m * 16); const int col = col0 + bj * 128; const v4u q = mw[m][bj], h = hw[m][bj];
                        v4u w; w.x = cvt_pk_bf16(bflo(q.x) + bflo(h.x), bfhi(q.x) + bfhi(h.x)); w.y = cvt_pk_bf16(bflo(q.y) + bflo(h.y), bfhi(q.y) + bfhi(h.y));
                        w.z = cvt_pk_bf16(bflo(q.z) + bflo(h.z), bfhi(q.z) + bfhi(h.z)); w.w = cvt_pk_bf16(bflo(q.w) + bflo(h.w), bfhi(q.w) + bfhi(h.w));
                        *(v4u*)(MG + row * DM + col) = w; }
                asm volatile("" ::: "memory");
            }
        }
    }
};
struct EpiInProj {
    static constexpr bool PERM = true; static constexpr int NSTORE = 0;
    unsigned char* PA; float* outK; float* outV; const f32x2* rope; int l; LAS unsigned char* ts;
    __device__ __forceinline__ void operator()(const f32x4 (&acc)[2][2][4][2], const Unit& u, int wr, int wc, int fr, int fq) const {
        const int pn = u.pn;
        const int rl0 = wr * 64 + fr;
        const int cl = wc * 32 + 8 * fq;
        if (pn >= 16 && pn < 20) {
            const bool isq = pn < 18; const int hp = (pn - 16) & 1;
            bf16* G = (bf16*)(PA + (isq ? PA_GQ : PA_GK));
            const float qs = isq ? 0.08838834764831845f : 1.0f;
            const int head = 2 * hp + (wc >> 1), axis = wc & 1, j0 = 8 * fq;
            const bool lat = u.pm >= 16;
#pragma unroll
            for (int ai = 0; ai < 2; ++ai)
#pragma unroll
                for (int m = 0; m < 4; ++m) {
                    const int row = u.pm * 256 + rl0 + ai * 128 + m * 16;
                    float o1[8], o2[8];
                    int pos = 0;
                    if (lat) { const int t = (row - MCTX) & 2047; pos = axis ? (t & 63) : (t >> 6); }
#pragma unroll
                    for (int n = 0; n < 2; ++n)
#pragma unroll
                        for (int i = 0; i < 4; ++i) {
                            const float x1 = acc[ai][0][m][n][i], x2 = acc[ai][1][m][n][i];
                            float c = 1.f, s = 0.f;
                            if (lat) { const f32x2 cs = rope[pos * 32 + j0 + 4 * n + i]; c = cs.x; s = cs.y; }
                            o1[n * 4 + i] = (x1 * c - x2 * s) * qs; o2[n * 4 + i] = (x2 * c + x1 * s) * qs;
                        }
                    bf16* p1 = G + (size_t)row * 512 + head * 128 + axis * 64 + j0;
                    v4u w; w.x = cvt_pk_bf16(o1[0], o1[1]); w.y = cvt_pk_bf16(o1[2], o1[3]); w.z = cvt_pk_bf16(o1[4], o1[5]); w.w = cvt_pk_bf16(o1[6], o1[7]);
                    *(v4u*)p1 = w;
                    w.x = cvt_pk_bf16(o2[0], o2[1]); w.y = cvt_pk_bf16(o2[2], o2[3]); w.z = cvt_pk_bf16(o2[4], o2[5]); w.w = cvt_pk_bf16(o2[6], o2[7]);
                    *(v4u*)(p1 + 32) = w;
                    asm volatile("" ::: "memory");
                }
            return;
        }
        if (pn == 52) {
            if (wc == 0) {
                float* GZ = (float*)(PA + PA_GZ);
#pragma unroll
                for (int ai = 0; ai < 2; ++ai)
#pragma unroll
                    for (int m = 0; m < 4; ++m) { float* rowp = GZ + (size_t)(u.pm * 256 + rl0 + ai * 128 + m * 16) * 32 + 8 * fq;
                        *(f32x4*)rowp = acc[ai][0][m][0]; *(f32x4*)(rowp + 4) = acc[ai][0][m][1]; }
            }
            return;
        }
        const size_t rowb = (size_t)u.pm * 256 + rl0;
#define IP_LOOP(...) do { _Pragma("unroll") for (int ai = 0; ai < 2; ++ai) _Pragma("unroll") for (int m = 0; m < 4; ++m) { const int rl = rl0 + ai * 128 + m * 16; const size_t row = rowb + ai * 128 + m * 16; (void)rl; \
            _Pragma("unroll") for (int bj = 0; bj < 2; ++bj) { f32x4 v0 = acc[ai][bj][m][0], v1 = acc[ai][bj][m][1]; __VA_ARGS__ } asm volatile("" ::: "memory"); } } while (0)
#define IP_PACK_STORE(ptr) do { v4u w_; w_.x = cvt_pk_bf16(v0[0], v0[1]); w_.y = cvt_pk_bf16(v0[2], v0[3]); w_.z = cvt_pk_bf16(v1[0], v1[1]); w_.w = cvt_pk_bf16(v1[2], v1[3]); __builtin_nontemporal_store(w_, (v4u*)(ptr)); } while (0)
#define IP_F32_COPY(fout, tcol_) do { float* fp_ = (fout) + ((((size_t)u.pm * 2 + l) * 8 + ((tcol_) >> 7) + bj) * 256 + rl) * 128 + cl; __builtin_nontemporal_store(v0, (f32x4*)fp_); __builtin_nontemporal_store(v1, (f32x4*)(fp_ + 4)); } while (0)
#define IP_TRANS_STORE(O_, tcol_) do { bf16* tp_ = (O_) + (size_t)((tcol_) + bj * 128 + cl) * MTOK + row; const unsigned p0_ = cvt_pk_bf16(v0[0], v0[1]), p1_ = cvt_pk_bf16(v0[2], v0[3]), p2_ = cvt_pk_bf16(v1[0], v1[1]), p3_ = cvt_pk_bf16(v1[2], v1[3]); \
            tp_[0] = (bf16)p0_; tp_[(size_t)MTOK] = (bf16)(p0_ >> 16); tp_[(size_t)2 * MTOK] = (bf16)p1_; tp_[(size_t)3 * MTOK] = (bf16)(p1_ >> 16); \
            tp_[(size_t)4 * MTOK] = (bf16)p2_; tp_[(size_t)5 * MTOK] = (bf16)(p2_ >> 16); tp_[(size_t)6 * MTOK] = (bf16)p3_; tp_[(size_t)7 * MTOK] = (bf16)(p3_ >> 16); } while (0)
#define IP_TRANSPOSE(KIND, ...) do { LAS bf16* T_ = (LAS bf16*)(ts + (wr * 4 + wc) * TS_WAVE); const int ln_ = fq * 16 + fr; \
            _Pragma("unroll") for (int ai = 0; ai < 2; ++ai) _Pragma("unroll") for (int bj = 0; bj < 2; ++bj) _Pragma("unroll") for (int mp = 0; mp < 2; ++mp) { \
                _Pragma("unroll") for (int ml = 0; ml < 2; ++ml) { const f32x4 v0 = acc[ai][bj][2 * mp + ml][0], v1 = acc[ai][bj][2 * mp + ml][1]; \
                    const unsigned p0_ = cvt_pk_bf16(v0[0], v0[1]), p1_ = cvt_pk_bf16(v0[2], v0[3]), p2_ = cvt_pk_bf16(v1[0], v1[1]), p3_ = cvt_pk_bf16(v1[2], v1[3]); \
                    LAS bf16* d_ = T_ + (8 * fq) * 40 + fq * 16 + ((KIND) == 0 ? ml * 16 + fr : (fr >> 2) * 8 + ml * 4 + (fr & 3)); \
                    d_[0] = (bf16)p0_; d_[40] = (bf16)(p0_ >> 16); d_[80] = (bf16)p1_; d_[120] = (bf16)(p1_ >> 16); d_[160] = (bf16)p2_; d_[200] = (bf16)(p2_ >> 16); d_[240] = (bf16)p3_; d_[280] = (bf16)(p3_ >> 16); } \
                _Pragma("unroll") for (int h_ = 0; h_ < 2; ++h_) { const int q_ = ln_ + 64 * h_, c_ = q_ >> 2, k_ = q_ & 3; const v4u w_ = *(const LAS v4u*)(T_ + c_ * 40 + (c_ >> 3) * 16 + 8 * k_); __VA_ARGS__ } \
                asm volatile("" ::: "memory"); } } while (0)
        if (pn < 8) {
            bf16* O = (bf16*)(PA + (pn < 4 ? PA_U : PA_NQ)); const int tcol = (pn & 3) * 256; const float scl = pn < 4 ? 1.0f : 0.08838834764831845f * 1.4426950408889634f;
            IP_LOOP({ v0 *= scl; v1 *= scl; IP_PACK_STORE(O + row * 1024 + tcol + bj * 128 + cl); });
        } else if (pn < 12) {
            bf16* O = (bf16*)(PA + PA_NK); const int tcol = (pn - 8) * 256;
            if (u.pm < 16) IP_LOOP({ IP_F32_COPY(outK, tcol); IP_PACK_STORE(O + row * 1024 + tcol + bj * 128 + cl); });
            else IP_LOOP({ IP_PACK_STORE(O + row * 1024 + tcol + bj * 128 + cl); });
        } else if (pn < 16) {
            bf16* O = (bf16*)(PA + PA_NV); const int tcol = (pn - 12) * 256;
            if (u.pm < 16) IP_LOOP({ IP_F32_COPY(outV, tcol); });
            IP_TRANSPOSE(0, { *(v4u*)(O + (size_t)(tcol + bj * 128 + wc * 32 + c_) * MTOK + ((size_t)u.pm * 256 + ai * 128 + wr * 64 + 32 * mp + 8 * k_)) = w_; });
        } else if (pn < 24) {
            bf16* O = (bf16*)(PA + PA_GV); const int tcol = (pn - 20) * 256;
            IP_TRANSPOSE(1, { const int e_ = tcol + bj * 128 + wc * 32 + c_, chunk_ = u.pm * 4 + ai * 2 + wr;
                *(v4u*)((unsigned char*)O + ((size_t)chunk_ * 64 + (e_ >> 4)) * 2048 + (size_t)((k_ * 16 + (e_ & 15)) * 32) + mp * 16) = w_; });
        } else if (pn < 28) {
            bf16* O = (bf16*)(PA + PA_GR); const int tcol = (pn - 24) * 256;
            IP_LOOP({ v0 = v0 * sigmoid4(v0); v1 = v1 * sigmoid4(v1); IP_PACK_STORE(O + row * 1024 + tcol + bj * 128 + cl); });
        } else {
            bf16* O = (bf16*)(PA + PA_GL) + ((size_t)u.pm * 24 + (pn - 28)) * 65536 + (size_t)((wr * 4 + wc) * 64 + fq * 16 + fr) * 8;
            IP_LOOP({ v0 = sigmoid4(v0); v1 = sigmoid4(v1); IP_PACK_STORE(O + (size_t)(((ai * 4 + m) * 2 + bj) * 512) * 8); });
        }
#undef IP_TRANSPOSE
#undef IP_LOOP
#undef IP_PACK_STORE
#undef IP_F32_COPY
#undef IP_TRANS_STORE
    }
};

template <int CTRL> __device__ __forceinline__ float dpp_mov(float v) { return __builtin_bit_cast(float, __builtin_amdgcn_update_dpp(0, __builtin_bit_cast(int, v), CTRL, 0xf, 0xf, false)); }
__device__ __forceinline__ float rdlane(float v, int l) { return __builtin_bit_cast(float, __builtin_amdgcn_readlane(__builtin_bit_cast(int, v), l)); }
__device__ __forceinline__ float row16_sum(float v) {
    v += dpp_mov<0xB1>(v); v += dpp_mov<0x4E>(v); v += dpp_mov<0x141>(v); v += dpp_mov<0x140>(v); return v; }
__device__ __forceinline__ float row16_max(float v) {
    v = fmaxf(v, dpp_mov<0xB1>(v)); v = fmaxf(v, dpp_mov<0x4E>(v)); v = fmaxf(v, dpp_mov<0x141>(v)); v = fmaxf(v, dpp_mov<0x140>(v)); return v; }
__device__ __forceinline__ float wave_sum(float v) { v = row16_sum(v); return (rdlane(v, 0) + rdlane(v, 16)) + (rdlane(v, 32) + rdlane(v, 48)); }
__device__ __forceinline__ float wave_max(float v) { v = row16_max(v); return fmaxf(fmaxf(rdlane(v, 0), rdlane(v, 16)), fmaxf(rdlane(v, 32), rdlane(v, 48))); }
__device__ __forceinline__ void p0_transpose_item(const float* W, int K, int N, bf16* WT, int dst_row0, LAS float* scr, int kb, int nb, int lane) {
    const int k0 = 64 * kb, n0 = 32 * nb;
#pragma unroll 8
    for (int i = 0; i < 32; ++i) { const int kk = 2 * i + (lane >> 5); scr[kk * 33 + (lane & 31)] = W[(size_t)(k0 + kk) * N + n0 + (lane & 31)]; }
    LDS_WAIT(); asm volatile("" ::: "memory");
    const int c = lane & 7;
#pragma unroll
    for (int j = 0; j < 4; ++j) { const int n = (lane >> 3) + 8 * j; const LAS float* s = scr + (8 * c) * 33 + n;
        v4u o; o.x = pk2(s[0 * 33], s[1 * 33]); o.y = pk2(s[2 * 33], s[3 * 33]); o.z = pk2(s[4 * 33], s[5 * 33]); o.w = pk2(s[6 * 33], s[7 * 33]);
        *(GAS v4u*)(WT + (size_t)(dst_row0 + n) * K + k0 + 8 * c) = o; }
    LDS_WAIT(); asm volatile("" ::: "memory");
}
__device__ __forceinline__ int win_dst(int n0) {
    if (n0 < 4096) return n0;
    if (n0 < 5120) { const int base = n0 < 4608 ? 4096 : 4608, dd = n0 - base, hh = dd >> 7, w = dd & 127, axis = w >> 6, half = (w >> 5) & 1;
        return base + 256 * (hh >> 1) + 128 * half + (hh & 1) * 64 + axis * 32; }
    if (n0 < 6144) return n0;
    if (n0 < 6176) return 13312;
    return n0 - 32;
}

struct Args { const float* in[22]; float* out; unsigned char* ws; int ph_lo, ph_hi, li, pad; };
#define AS4 __attribute__((address_space(4)))
typedef const AS4 unsigned char* kargp;
#define KARG ((kargp)__builtin_amdgcn_kernarg_segment_ptr())
__device__ __forceinline__ const float* arg_in(kargp ka, int i) { return *(const float* const AS4*)(ka + 8 * i); }
__device__ __forceinline__ float* arg_out(kargp ka) { return *(float* const AS4*)(ka + 176); }
__device__ __forceinline__ unsigned char* arg_ws(kargp ka) { return *(unsigned char* const AS4*)(ka + 184); }
__device__ __forceinline__ int arg_i(kargp ka, int off) { return *(const int AS4*)(ka + off); }

template <bool FIRST, bool LAST>
__device__ __forceinline__ void norm_rows(kargp ka, int gw, int NGW, int lane, const bf16* Y, const float* post, int li, int gi, float resw, const float* pre, int ln, int gn, int row_lo, int row_hi) {
    const float* MOD = (const float*)(arg_ws(ka) + WS_MOD);
    bf16* H = (bf16*)(arg_ws(ka) + WS_H);
    const int R = (row_hi - row_lo + NGW - 1) / NGW, r0 = row_lo + gw * R, r1 = r0 + R < row_hi ? r0 + R : row_hi;
    int vcur = -1;
    f32x4 cg[8], cb[8], cs[8];
#pragma unroll
    for (int j = 0; j < 8; ++j) { cg[j] = (f32x4){0.f, 0.f, 0.f, 0.f}; cb[j] = cg[j]; cs[j] = cg[j]; }
    for (int row = r0; row < r1; ++row) {
        const int v = row < MCTX ? 0 : 1 + ((row - MCTX) >> 11);
        const float* xin = FIRST ? (row < MCTX ? arg_in(ka, 0) + (size_t)row * DM : arg_in(ka, 1) + (size_t)(row - MCTX) * DM) : arg_out(ka) + (size_t)row * DM;
        const f32x4* xr = (const f32x4*)xin + lane;
        f32x4 x[8]; v2u yw[8];
#pragma unroll
        for (int j = 0; j < 8; ++j) x[j] = xr[64 * j];
        if (!FIRST) { const v2u* y0 = (const v2u*)(Y + (size_t)row * DM) + lane;
#pragma unroll
            for (int j = 0; j < 8; ++j) yw[j] = y0[64 * j]; }
        if (v != vcur) {
            vcur = v;
            if (!FIRST) { const f32x4* pg = (const f32x4*)post + lane; const f32x4* gt = (const f32x4*)(MOD + (size_t)((v * 2 + li) * NMOD + 3 * gi + 2) * DM) + lane;
#pragma unroll
                for (int j = 0; j < 8; ++j) cg[j] = (gt[64 * j] * resw) * pg[64 * j]; }
            if (!LAST) { const f32x4* pg = (const f32x4*)pre + lane;
                const f32x4* sh = (const f32x4*)(MOD + (size_t)((v * 2 + ln) * NMOD + 3 * gn + 0) * DM) + lane;
                const f32x4* sc = (const f32x4*)(MOD + (size_t)((v * 2 + ln) * NMOD + 3 * gn + 1) * DM) + lane;
#pragma unroll
                for (int j = 0; j < 8; ++j) { cb[j] = pg[64 * j] * (sc[64 * j] + 1.0f); cs[j] = sh[64 * j]; } }
        }
        if (!FIRST) {
            float ss = 0.f;
#pragma unroll
            for (int j = 0; j < 8; ++j) { const v2u a = yw[j]; const float y0f = bflo(a.x), y1f = bfhi(a.x), y2f = bflo(a.y), y3f = bfhi(a.y);
                ss += (y0f * y0f + y1f * y1f) + (y2f * y2f + y3f * y3f); }
            const float rstd = 1.0f / sqrtf(wave_sum(ss) * (1.f / DM) + EPS);
#pragma unroll
            for (int j = 0; j < 8; ++j) { const v2u a = yw[j]; f32x4 yj; yj.x = bflo(a.x); yj.y = bfhi(a.x); yj.z = bflo(a.y); yj.w = bfhi(a.y);
                x[j] = x[j] + cg[j] * (yj * rstd); }
        }
        f32x4* xo = (f32x4*)(arg_out(ka) + (size_t)row * DM) + lane;
#pragma unroll
        for (int j = 0; j < 8; ++j) xo[64 * j] = x[j];
        if (!LAST) {
            float ss = 0.f;
#pragma unroll
            for (int j = 0; j < 8; ++j) ss += (x[j].x * x[j].x + x[j].y * x[j].y) + (x[j].z * x[j].z + x[j].w * x[j].w);
            const float rstd = 1.0f / sqrtf(wave_sum(ss) * (1.f / DM) + EPS);
            v2u* ho = (v2u*)(H + (size_t)row * DM) + lane;
#pragma unroll
            for (int j = 0; j < 8; ++j) { const f32x4 h = (x[j] * rstd) * cb[j] + cs[j];
                v2u w; w.x = cvt_pk_bf16(h.x, h.y); w.y = cvt_pk_bf16(h.z, h.w); ho[64 * j] = w; }
        }
    }
}

typedef short bf16x8v __attribute__((ext_vector_type(8)));
__device__ __forceinline__ float swz16(float v) { return __builtin_bit_cast(float, __builtin_amdgcn_ds_swizzle(__builtin_bit_cast(int, v), 0x401F)); }
__device__ __forceinline__ void pl32swap(unsigned& a, unsigned& b) { asm volatile("s_nop 1\n\tv_permlane32_swap_b32 %0, %1" : "+v"(a), "+v"(b)); }
__device__ __forceinline__ float xmax32(float v) { unsigned a = __builtin_bit_cast(unsigned, v), b = a; pl32swap(a, b); return fmaxf(__builtin_bit_cast(float, a), __builtin_bit_cast(float, b)); }
__device__ __forceinline__ float xsum32(float v) { unsigned a = __builtin_bit_cast(unsigned, v), b = a; pl32swap(a, b); return __builtin_bit_cast(float, a) + __builtin_bit_cast(float, b); }
template <int NQT, bool LATENT>
__device__ __forceinline__ void attn_block(LAS unsigned char* lds, int wave, int lane, const bf16* NQ, const float* rpbh, bf16* BR1,
                                           int q0, int h, int rs, int r, int ct0, int qc0, int Rlo, int nloc,
                                           const char* lksrc, const char* lvsrc  ,
                                           const char* ksrc, unsigned krs, const char* vsrc, unsigned vrs, int nshared) {
    asm volatile("" : "+v"(lane));
    const int fr = lane & 15, g = lane >> 4;
    const int nstage = nloc + nshared;
#define AT_DMA(bufi, st_) do { int ln_ = lane; asm volatile("" : "+v"(ln_));   \
        const bool lc_ = (st_) < nloc; const int si_ = lc_ ? (st_) : (st_) - nloc; const bool kw_ = wave < 4; \
        const unsigned strd_ = kw_ ? (lc_ ? 2048u : krs) : (lc_ ? (unsigned)(MTOK * 2) : vrs); \
        const char* sb_ = kw_ ? (lc_ ? lksrc + (size_t)si_ * 128u * 2048u : ksrc + (size_t)si_ * 128u * krs) : (lc_ ? lvsrc : vsrc) + (size_t)si_ * 256u; \
        const char* lb_ = sb_ + (size_t)(32 * (wave & 3) + (ln_ >> 4)) * strd_; \
        _Pragma("unroll") for (int j_ = 0; j_ < 8; ++j_) { const int c_ = (ln_ & 15) ^ ((4 * j_ + (ln_ >> 4)) & 15); \
        __builtin_amdgcn_global_load_lds((const unsigned*)(lb_ + (size_t)(4 * j_) * strd_ + c_ * 16), (LAS unsigned*)(lds + (bufi) * 65536 + (wave * 8 + j_) * 1024), 16, 0, 0); } } while (0)
    AT_DMA(0, 0);
    if (nstage > 1) AT_DMA(1, 1);
    LAS float* rpbl = (LAS float*)(lds + TS_OFF);
    if (LATENT) { for (int e = wave * 64 + lane; e < 465; e += NTHR) rpbl[e] = rpbh[e] * 1.4426950408889634f; asm volatile("s_waitcnt lgkmcnt(0)" ::: "memory"); }
    bf16x8v Qf[NQT][4];
#pragma unroll
    for (int qt = 0; qt < NQT; ++qt)
#pragma unroll
        for (int kk = 0; kk < 4; ++kk) Qf[qt][kk] = *(const bf16x8v*)(NQ + (size_t)(q0 + qt * 16 + fr) * 1024 + h * 128 + kk * 32 + g * 8);
    f32x4 O[NQT][8]; float m[NQT], lsum[NQT];
#pragma unroll
    for (int qt = 0; qt < NQT; ++qt) { m[qt] = -1e30f; lsum[qt] = 0.f;
#pragma unroll
        for (int d = 0; d < 8; ++d) O[qt][d] = (f32x4){0.f, 0.f, 0.f, 0.f}; }
#define AT_STEP(MASKED, ka0_, kb0_, ria, cta, rib, ctb, bok_) do { \
        f32x4 sa[NQT], sb[NQT]; \
        _Pragma("unroll") for (int qt = 0; qt < NQT; ++qt) { sa[qt] = (f32x4){0.f, 0.f, 0.f, 0.f}; sb[qt] = (f32x4){0.f, 0.f, 0.f, 0.f}; } \
        _Pragma("unroll") for (int kk = 0; kk < 4; ++kk) { const int ra = (ka0_) + fr, rb = (kb0_) + fr; \
            const bf16x8v Ka = *(const LAS bf16x8v*)(Kimg + ra * 256 + (((kk * 4 + g) ^ (ra & 15)) * 16)), Kb = *(const LAS bf16x8v*)(Kimg + rb * 256 + (((kk * 4 + g) ^ (rb & 15)) * 16)); \
            __builtin_amdgcn_s_setprio(1); _Pragma("unroll") for (int qt = 0; qt < NQT; ++qt) { sa[qt] = __builtin_amdgcn_mfma_f32_16x16x32_bf16(Ka, Qf[qt][kk], sa[qt], 0, 0, 0); sb[qt] = __builtin_amdgcn_mfma_f32_16x16x32_bf16(Kb, Qf[qt][kk], sb[qt], 0, 0, 0); } __builtin_amdgcn_s_setprio(0); } \
        bf16x8v P[NQT]; \
        _Pragma("unroll") for (int qt = 0; qt < NQT; ++qt) { \
            bool va[4] = {true, true, true, true}, vb[4] = {true, true, true, true}; \
            if (MASKED) { \
                const int c = qc0 + qt * 16 + fr; int cs = c - 8; cs = cs < 0 ? 0 : (cs > 48 ? 48 : cs); \
                _Pragma("unroll") for (int i = 0; i < 4; ++i) { \
                    const int kca = (cta) * 16 + 4 * g + i, kcb = (ctb) * 16 + 4 * g + i; \
                    va[i] = (kca >= cs) && (kca < cs + 16); vb[i] = (bok_) && (kcb >= cs) && (kcb < cs + 16); \
                    const float ba = va[i] ? rpbl[((ria) - r + 7) * 31 + (kca - c + 15)] : 0.f; \
                    const float bb = vb[i] ? rpbl[((rib) - r + 7) * 31 + (kcb - c + 15)] : 0.f; \
                    sa[qt][i] = va[i] ? sa[qt][i] + ba : -1e30f; sb[qt][i] = vb[i] ? sb[qt][i] + bb : -1e30f; } } \
            float mx = fmaxf(fmaxf(fmaxf(sa[qt][0], sa[qt][1]), fmaxf(sa[qt][2], sa[qt][3])), fmaxf(fmaxf(sb[qt][0], sb[qt][1]), fmaxf(sb[qt][2], sb[qt][3]))); \
            mx = fmaxf(mx, swz16(mx)); mx = xmax32(mx); \
            const float mn = fmaxf(m[qt], mx), alpha = __builtin_amdgcn_exp2f(fmaxf(m[qt] - mn, -200.f)); m[qt] = mn; \
            float pa[4], pb[4], ps = 0.f;     \
            _Pragma("unroll") for (int i = 0; i < 4; ++i) { pa[i] = va[i] ? __builtin_amdgcn_exp2f(fmaxf(sa[qt][i] - mn, -200.f)) : 0.f; pb[i] = vb[i] ? __builtin_amdgcn_exp2f(fmaxf(sb[qt][i] - mn, -200.f)) : 0.f; ps += pa[i] + pb[i]; } \
            lsum[qt] = lsum[qt] * alpha + ps; \
            _Pragma("unroll") for (int d = 0; d < 8; ++d) O[qt][d] *= alpha; \
            v4u pw; pw.x = cvt_pk_bf16(pa[0], pa[1]); pw.y = cvt_pk_bf16(pa[2], pa[3]); pw.z = cvt_pk_bf16(pb[0], pb[1]); pw.w = cvt_pk_bf16(pb[2], pb[3]); \
            P[qt] = __builtin_bit_cast(bf16x8v, pw); } \
        _Pragma("unroll") for (int d = 0; d < 8; ++d) { const int rv = 16 * d + fr; \
            const v2u Va = *(const LAS v2u*)(Vimg + rv * 256 + (((((ka0_) >> 3) + (g >> 1)) ^ (rv & 15)) * 16) + 8 * (g & 1)); \
            const v2u Vb = *(const LAS v2u*)(Vimg + rv * 256 + (((((kb0_) >> 3) + (g >> 1)) ^ (rv & 15)) * 16) + 8 * (g & 1)); \
            v4u vw; vw.x = Va.x; vw.y = Va.y; vw.z = Vb.x; vw.w = Vb.y; const bf16x8v Vf = __builtin_bit_cast(bf16x8v, vw); \
            __builtin_amdgcn_s_setprio(1); _Pragma("unroll") for (int qt = 0; qt < NQT; ++qt) O[qt][d] = __builtin_amdgcn_mfma_f32_16x16x32_bf16(Vf, P[qt], O[qt][d], 0, 0, 0); __builtin_amdgcn_s_setprio(0); } } while (0)
    for (int sg = 0; sg < nstage; ++sg) {
        asm volatile("s_waitcnt vmcnt(0)" ::: "memory");
        __builtin_amdgcn_s_barrier();
        const LAS unsigned char* Kimg = lds + (sg & 1) * 65536; const LAS unsigned char* Vimg = Kimg + 32768;
        if (LATENT && sg < nloc) {
            const int R0 = Rlo + 2 * sg; const bool act0 = (R0 >= rs) && (R0 <= rs + 7), act1 = (R0 + 1 >= rs) && (R0 + 1 <= rs + 7);
            const int nt = 3 * ((act0 ? 1 : 0) + (act1 ? 1 : 0)), rsel1 = act0 ? 0 : 1;
#pragma unroll 1
            for (int k = 0; k < nt; k += 2) {
                const int ka = k, kb = (k + 1 < nt) ? k + 1 : k;
                const int rowa = (act0 && act1) ? ka / 3 : rsel1, cta = ct0 + ((act0 && act1) ? ka % 3 : ka);
                const int rowb = (act0 && act1) ? kb / 3 : rsel1, ctb = ct0 + ((act0 && act1) ? kb % 3 : kb);
                const bool bok = k + 1 < nt;
                AT_STEP(true, rowa * 64 + cta * 16, rowb * 64 + ctb * 16, R0 + rowa, cta, R0 + rowb, ctb, bok);
            }
        } else {
#pragma unroll 1
            for (int j = 0; j < 4; ++j) AT_STEP(false, 32 * j, 32 * j + 16, 0, 0, 0, 0, true);
        }
        asm volatile("s_waitcnt lgkmcnt(0)" ::: "memory");
        __builtin_amdgcn_s_barrier();
        if (sg + 2 < nstage) AT_DMA(sg & 1, sg + 2);
    }
#undef AT_STEP
#undef AT_DMA
#pragma unroll
    for (int qt = 0; qt < NQT; ++qt) {
        float lt = lsum[qt]; lt += swz16(lt); lt = xsum32(lt);
        const float iv = 1.0f / lt;
        bf16* op = BR1 + (size_t)(q0 + qt * 16 + fr) * 1024 + h * 128 + 4 * g;
#pragma unroll
        for (int d = 0; d < 8; ++d) { v2u w; w.x = cvt_pk_bf16(O[qt][d][0] * iv, O[qt][d][1] * iv); w.y = cvt_pk_bf16(O[qt][d][2] * iv, O[qt][d][3] * iv); *(v2u*)(op + d * 16) = w; }
    }
}

template <int DIR>
__device__ __forceinline__ void gla_g1_item(LAS float* zs, LAS float* xch, int tid, int blk, const float* wg, const float* bg, const bf16* GQ, const bf16* GK, bf16* QI, bf16* KI, bf16* KDT, float* DEC) {
    const int tok0 = blk * 64, half = tid >> 8, c0 = 2 * (tid & 255);
    f32x2 wv[16];
#pragma unroll
    for (int r = 0; r < 16; ++r) wv[r] = *(const f32x2*)(wg + r * 512 + c0);
    const f32x2 bgv = *(const f32x2*)(bg + c0);
    f32x2 b[32];
#pragma unroll
    for (int p = 0; p < 32; ++p) {
        const LAS f32x4* zp = (const LAS f32x4*)(zs + (half * 32 + p) * 16);
        f32x2 lg = bgv;
#pragma unroll
        for (int r4 = 0; r4 < 4; ++r4) { const f32x4 z = zp[r4]; lg += z.x * wv[4 * r4]; lg += z.y * wv[4 * r4 + 1]; lg += z.z * wv[4 * r4 + 2]; lg += z.w * wv[4 * r4 + 3]; }
        b[p].x = (fminf(lg.x, 0.f) - __builtin_amdgcn_logf(1.f + __expf(-fabsf(lg.x))) * 0.6931471805599453f) * (1.0f / 16.0f);
        b[p].y = (fminf(lg.y, 0.f) - __builtin_amdgcn_logf(1.f + __expf(-fabsf(lg.y))) * 0.6931471805599453f) * (1.0f / 16.0f);
    }
    if (DIR == 0) {
#pragma unroll
        for (int p = 1; p < 32; ++p) b[p] += b[p - 1];
    } else {
#pragma unroll
        for (int p = 30; p >= 0; --p) b[p] += b[p + 1];
    }
    const f32x2 T = DIR == 0 ? b[31] : b[0];
    *(LAS f32x2*)(xch + half * 512 + c0) = T;
    __syncthreads();
    const f32x2 To = *(const LAS f32x2*)(xch + (half ^ 1) * 512 + c0);
    const bool addo = DIR == 0 ? (half == 1) : (half == 0);
    const f32x2 off = addo ? To : (f32x2){0.f, 0.f};
    const f32x2 bend = T + To;
    f32x2 ebend; ebend.x = __expf(bend.x); ebend.y = __expf(bend.y);
    if (half == 0) *(f32x2*)(DEC + (size_t)blk * 512 + c0) = ebend;
    int c2 = c0; asm volatile("" : "+v"(c2));
    const size_t rb = (size_t)(tok0 + half * 32) * 512 + c2;
    const bf16* gq = GQ + rb; const bf16* gk = GK + rb; bf16* qi = QI + rb; bf16* ki = KI + rb;
    unsigned char* kdrec = (unsigned char*)KDT + ((size_t)(blk * 4 + (c2 >> 7)) * 8 + ((c2 & 127) >> 4)) * 2048 + (size_t)(c2 & 15) * 32 + half * 16;
    unsigned qw[32], kw[32];
#pragma unroll
    for (int p = 0; p < 32; ++p) { qw[p] = *(const unsigned*)(gq + (size_t)p * 512); kw[p] = *(const unsigned*)(gk + (size_t)p * 512); }
#pragma unroll
    for (int g = 0; g < 4; ++g) {
        unsigned r0[4], r1[4];
#pragma unroll
        for (int jj = 0; jj < 2; ++jj)
#pragma unroll
            for (int i2 = 0; i2 < 2; ++i2) {
                const int p = 16 * jj + 4 * g + 2 * i2;
                const unsigned qa = qw[p], qb = qw[p + 1];
                const unsigned ka_ = kw[p], kb_ = kw[p + 1];
                const f32x2 ba = b[p] + off, bb = b[p + 1] + off;
                f32x2 ea, eb; ea.x = __expf(ba.x); ea.y = __expf(ba.y); eb.x = __expf(bb.x); eb.y = __expf(bb.y);
                f32x2 ra, rbv; ra.x = __builtin_amdgcn_rcpf(ea.x); ra.y = __builtin_amdgcn_rcpf(ea.y); rbv.x = __builtin_amdgcn_rcpf(eb.x); rbv.y = __builtin_amdgcn_rcpf(eb.y);
                f32x2 qfa, qfb, kfa, kfb; qfa.x = bflo(qa); qfa.y = bfhi(qa); qfb.x = bflo(qb); qfb.y = bfhi(qb); kfa.x = bflo(ka_); kfa.y = bfhi(ka_); kfb.x = bflo(kb_); kfb.y = bfhi(kb_);
                qfa *= ea; qfb *= eb; kfa *= ra; kfb *= rbv;
                *(unsigned*)(qi + (size_t)p * 512) = cvt_pk_bf16(qfa.x, qfa.y); *(unsigned*)(qi + (size_t)(p + 1) * 512) = cvt_pk_bf16(qfb.x, qfb.y);
                *(unsigned*)(ki + (size_t)p * 512) = cvt_pk_bf16(kfa.x, kfa.y); *(unsigned*)(ki + (size_t)(p + 1) * 512) = cvt_pk_bf16(kfb.x, kfb.y);
                kfa *= ebend; kfb *= ebend;
                r0[jj * 2 + i2] = cvt_pk_bf16(kfa.x, kfb.x); r1[jj * 2 + i2] = cvt_pk_bf16(kfa.y, kfb.y);
            }
        v4u w0, w1; w0.x = r0[0]; w0.y = r0[1]; w0.z = r0[2]; w0.w = r0[3]; w1.x = r1[0]; w1.y = r1[1]; w1.z = r1[2]; w1.w = r1[3];
        *(v4u*)(kdrec + g * 512) = w0; *(v4u*)(kdrec + g * 512 + 32) = w1;
    }
}
__device__ __forceinline__ void gld16(bf16x8v& d, const void* p) { asm volatile("global_load_dwordx4 %0, %1, off" : "=&v"(d) : "v"(p) : "memory"); }
__device__ __forceinline__ void gld8(v2u& d, const void* p) { asm volatile("global_load_dwordx2 %0, %1, off" : "=&v"(d) : "v"(p) : "memory"); }
__device__ __forceinline__ void gld4(float& d, const void* p) { asm volatile("global_load_dword %0, %1, off" : "=&v"(d) : "v"(p) : "memory"); }
template <int OFF> __device__ __forceinline__ void gld16s(bf16x8v& d, unsigned vo, const void* sb) { asm volatile("global_load_dwordx4 %0, %1, %2 offset:%3" : "=&v"(d) : "v"(vo), "s"(sb), "n"(OFF) : "memory"); }
template <int OFF> __device__ __forceinline__ void gld8s(v2u& d, unsigned vo, const void* sb) { asm volatile("global_load_dwordx2 %0, %1, %2 offset:%3" : "=&v"(d) : "v"(vo), "s"(sb), "n"(OFF) : "memory"); }
template <int OFF> __device__ __forceinline__ void gld4s(float& d, unsigned vo, const void* sb) { asm volatile("global_load_dword %0, %1, %2 offset:%3" : "=&v"(d) : "v"(vo), "s"(sb), "n"(OFF) : "memory"); }
struct G2Regs { bf16x8v Vf[2][2]; bf16x8v Kf[2][2]; float dec[2]; bf16x8v Pf[2]; };
__device__ __forceinline__ int gla_g2_unit4(kargp ka, LAS unsigned char* ldsg, int tt, int lane, int l, int u) {
    asm volatile("" : "+v"(lane));
    unsigned char* ws = arg_ws(ka);
    const bool latent = u < 256; const int uu = latent ? u : u - 256;
    const int slice = uu & 7, cj = uu >> 3, b = cj >> 3, h = (cj >> 1) & 3, dir = cj & 1;
    const int nchunk = latent ? 32 : 4, base = latent ? MCTX + b * 2048 : b * 256;
    const bf16* QI = (const bf16*)(ws + WS_QI) + (size_t)dir * MTOK * 512; const unsigned char* PT = ws + WS_PT + (size_t)dir * 192 * 32768;
    const bf16* KDT = (const bf16*)(ws + WS_KDT) + (size_t)dir * 512 * MTOK; const float* DEC = (const float*)(ws + WS_DEC) + (size_t)dir * 192 * 512;
    const bf16* GVT = (const bf16*)(ws + WS_A + PA_GV);
    float* OUT = (float*)(ws + WS_B) + (size_t)dir * MTOK * 1024;
    const int fr = lane & 15, g = lane >> 4;
    const int e0 = h * 256 + slice * 32;
    LAS unsigned char* S16 = ldsg;
    LAS unsigned char* QR = ldsg + 16384;
    f32x4 ST[2][2];
    const size_t sidx = ((((size_t)b * 2 + l) * 2 + dir) * 4 + h) * 128 * 256;
    unsigned dsrc[4];
#pragma unroll
    for (int j = 0; j < 4; ++j) { const int pcs = 4 * tt + j, r = 4 * pcs + (lane >> 4), c = (lane & 15) ^ (r & 15); dsrc[j] = (unsigned)(r * 1024 + h * 256 + c * 16); }
#define G2_DMA(bufi, tok) do { const char* qb_ = (const char*)(QI + (size_t)(tok) * 512); \
        _Pragma("unroll") for (int j_ = 0; j_ < 4; ++j_) \
            __builtin_amdgcn_global_load_lds((const unsigned*)(qb_ + dsrc[j_]), (LAS unsigned*)(QR + (bufi) * 16384 + (4 * tt + j_) * 1024), 16, 0, 0); } while (0)
    unsigned offd[2];
#pragma unroll
    for (int j = 0; j < 2; ++j) offd[j] = (unsigned)((h * 128 + (2 * tt + j) * 16 + fr) * 4);
    const unsigned offp = (unsigned)(tt * 2048 + lane * 16), offr = (unsigned)(lane * 32);
#define G2_LOADR(R, tok) do { const int ck_ = __builtin_amdgcn_readfirstlane((tok) >> 6); \
        const char* vb_ = (const char*)GVT + ((size_t)ck_ * 64 + (e0 >> 4)) * 2048; const char* kb_ = (const char*)KDT + (((size_t)ck_ * 4 + h) * 8 + 2 * tt) * 2048; \
        const char* db_ = (const char*)(DEC + (size_t)ck_ * 512); const char* pb_ = (const char*)(PT + ((size_t)ck_ * 4 + h) * 8192); \
        gld16s<0>(R.Vf[0][0], offr, vb_); gld16s<16>(R.Vf[0][1], offr, vb_); gld16s<2048>(R.Vf[1][0], offr, vb_); gld16s<2064>(R.Vf[1][1], offr, vb_); \
        gld16s<0>(R.Kf[0][0], offr, kb_); gld16s<16>(R.Kf[0][1], offr, kb_); gld16s<2048>(R.Kf[1][0], offr, kb_); gld16s<2064>(R.Kf[1][1], offr, kb_); \
        gld4s<0>(R.dec[0], offd[0], db_); gld4s<0>(R.dec[1], offd[1], db_); \
        gld16s<0>(R.Pf[0], offp, pb_); gld16s<1024>(R.Pf[1], offp, pb_); } while (0)
#define G2_TOK(c) (base + 64 * (dir ? nchunk - 1 - ((c) < nchunk ? (c) : nchunk - 1) : ((c) < nchunk ? (c) : nchunk - 1)))
#define G2_S16OFF(e_, d_) ((e_) * 256 + ((((d_) >> 3) ^ ((e_) & 15)) * 16) + ((d_) & 7) * 2)
    G2_DMA(0, G2_TOK(0));
    G2Regs R0; G2_LOADR(R0, G2_TOK(0));
    G2_DMA(1, G2_TOK(1));
    G2Regs R1; G2_LOADR(R1, G2_TOK(1));
#pragma unroll
    for (int et = 0; et < 2; ++et)
#pragma unroll
        for (int dt = 0; dt < 2; ++dt) {
            const int d = (2 * tt + dt) * 16 + fr;
            if (latent) ST[et][dt] = *(const f32x4*)(arg_in(ka, 5) + sidx + (size_t)d * 256 + slice * 32 + et * 16 + 4 * g); else ST[et][dt] = (f32x4){0.f, 0.f, 0.f, 0.f};
#pragma unroll
            for (int i = 0; i < 4; ++i) *(LAS bf16*)(S16 + G2_S16OFF(et * 16 + 4 * g + i, d)) = (bf16)f2bf(ST[et][dt][i]);
        }
    asm volatile("s_waitcnt vmcnt(0) lgkmcnt(0)" ::: "memory");
    __builtin_amdgcn_s_barrier();
#define G2_STEP(RC, RF, BC, BF, cn_) do { \
        const int tok0 = G2_TOK(cn_); \
        const LAS unsigned char* Sr = S16 + ((cn_) & 1) * 8192; LAS unsigned char* Sw = S16 + (((cn_) + 1) & 1) * 8192; \
        const LAS unsigned char* Qs = QR + (BC) * 16384; \
        G2_DMA(BF, G2_TOK((cn_) + 2)); \
        G2_LOADR(RF, G2_TOK((cn_) + 2)); \
        bf16x8v Qf[4]; \
        _Pragma("unroll") for (int kk = 0; kk < 4; ++kk) { const int r = 16 * tt + fr; Qf[kk] = *(const LAS bf16x8v*)(Qs + r * 256 + (((kk * 4 + g) ^ (r & 15)) * 16)); } \
        _Pragma("unroll") for (int et = 0; et < 2; ++et) { \
            f32x4 o = (f32x4){0.f, 0.f, 0.f, 0.f}; \
            _Pragma("unroll") for (int pr = 0; pr < 2; ++pr) o = __builtin_amdgcn_mfma_f32_16x16x32_bf16(RC.Vf[et][pr], RC.Pf[pr], o, 0, 0, 0); \
            _Pragma("unroll") for (int kk = 0; kk < 4; ++kk) { const int er = et * 16 + fr; const bf16x8v Sf = *(const LAS bf16x8v*)(Sr + er * 256 + (((kk * 4 + g) ^ (er & 15)) * 16)); \
                o = __builtin_amdgcn_mfma_f32_16x16x32_bf16(Sf, Qf[kk], o, 0, 0, 0); } \
            *(f32x4*)(OUT + (size_t)(tok0 + 16 * tt + fr) * 1024 + e0 + et * 16 + 4 * g) = o; } \
        _Pragma("unroll") for (int dt = 0; dt < 2; ++dt) { \
            const int d = (2 * tt + dt) * 16 + fr; \
            _Pragma("unroll") for (int et = 0; et < 2; ++et) { \
                ST[et][dt] *= RC.dec[dt]; \
                _Pragma("unroll") for (int hf = 0; hf < 2; ++hf) ST[et][dt] = __builtin_amdgcn_mfma_f32_16x16x32_bf16(RC.Vf[et][hf], RC.Kf[dt][hf], ST[et][dt], 0, 0, 0); \
                _Pragma("unroll") for (int i = 0; i < 4; ++i) *(LAS bf16*)(Sw + G2_S16OFF(et * 16 + 4 * g + i, d)) = (bf16)f2bf(ST[et][dt][i]); } } \
          \
        asm volatile("s_waitcnt vmcnt(18) lgkmcnt(0)" ::: "memory"); \
        __builtin_amdgcn_s_barrier(); } while (0)
    G2Regs R2;
    for (int cn = 0; cn < nchunk; cn += 3) {
        G2_STEP(R0, R2, 0, 2, cn);
        if (cn + 1 < nchunk) G2_STEP(R1, R0, 1, 0, cn + 1);
        if (cn + 2 < nchunk) G2_STEP(R2, R1, 2, 1, cn + 2);
    }
#undef G2_STEP
#undef G2_TOK
#undef G2_DMA
#undef G2_LOADR
    if (!latent) {
#pragma unroll
        for (int et = 0; et < 2; ++et)
#pragma unroll
            for (int dt = 0; dt < 2; ++dt) { const int d = (2 * tt + dt) * 16 + fr;
                *(f32x4*)(arg_out(ka) + (size_t)41943040 + sidx + (size_t)d * 256 + slice * 32 + et * 16 + 4 * g) = ST[et][dt]; }
    }
#undef G2_S16OFF
    asm volatile("s_waitcnt vmcnt(0)" ::: "memory");
    return 1 + nchunk;
}

#define PHASE_FN static __device__ __forceinline__ void
#define PH_BEGIN \
    LAS unsigned char* lds = lds_; \
    int wave = wave_, G = gridDim.x, bx = blockIdx.x; kargp ka = KARG; asm volatile("" : "+s"(wave), "+s"(G), "+s"(bx), "+s"(ka)); \
    unsigned zz_ = 0u; asm volatile("" : "+v"(zz_)); const int lane = (int)__builtin_amdgcn_mbcnt_hi(~0u, __builtin_amdgcn_mbcnt_lo(~0u, zz_)); \
    const int tid = wave * 64 + lane; const int vcu = (G % 8 == 0) ? (bx % 8) * (G / 8) + bx / 8 : bx; \
    const int gw = vcu * NWAVES + wave, NGW = G * NWAVES; unsigned char* ws = arg_ws(ka); \
    (void)lane; (void)gw; (void)NGW; (void)ws; (void)tid; (void)lds;
#define WSP(T, name, off) T* name = (T*)(ws + (off))

template<int FI0, int FI1, int FO0, int FO1, int IN0, int IN1, int BR0, int BR1, int OUT0, int OUT1, int SMALL>
__device__ __forceinline__ void cvt_run(kargp ka, unsigned char* ws, LAS float* scr, int lane, int w, int NW, int rep) {
    WSP(bf16, WFI, WS_WFI); WSP(bf16, WFO, WS_WFO); WSP(bf16, WIN, WS_WIN); WSP(bf16, WBR, WS_WBR); WSP(bf16, WOUT, WS_WOUT); WSP(bf16, WPOOL, WS_WPOOL);
    constexpr int I_FI = FI1 - FI0, I_FO = FO1 - FO0, I_IN = IN1 - IN0, I_BR = BR1 - BR0, I_OUT = OUT1 - OUT0, I_PW = SMALL ? 256 : 0, I_CV = SMALL ? 2048 : 0, NITEMS = I_FI + I_FO + I_IN + I_BR + I_OUT + I_PW + I_CV;
    for (int it = w, k_ = 0; it < NITEMS; (++k_ < rep) ? ++it : (k_ = 0, it += NW - rep + 1)) {
        int r = it;
        if (r < I_FI) { r += FI0; const int mat = r / 11008, rr = r % 11008, kb = rr / 344, nb = rr % 344, n0 = nb * 32, half = n0 / FF, j0 = n0 % FF;
            p0_transpose_item(arg_in(ka, 11) + (size_t)mat * 2048 * FF2, 2048, FF2, WFI + (size_t)mat * FF2 * 2048, 256 * (j0 >> 7) + 128 * half + (j0 & 127), scr, kb, nb, lane); continue; }
        r -= I_FI;
        if (r < I_FO) { r += FO0; const int mat = r / 5504, rr = r % 5504, kb = rr / 64, nb = rr % 64;
            p0_transpose_item(arg_in(ka, 12) + (size_t)mat * FF * 2048, FF, 2048, WFO + (size_t)mat * 2048 * FF, nb * 32, scr, kb, nb, lane); continue; }
        r -= I_FO;
        if (r < I_IN) { r += IN0; const int l = r / 13344, rr = r % 13344, kb = rr / 417, nb = rr % 417;
            p0_transpose_item(arg_in(ka, 13) + (size_t)l * 2048 * INC, 2048, INC, WIN + (size_t)l * INP * 2048, win_dst(nb * 32), scr, kb, nb, lane); continue; }
        r -= I_IN;
        if (r < I_BR) { r += BR0; const int mat = r / 1024, rr = r % 1024, kb = rr / 64, nb = rr % 64;
            p0_transpose_item(arg_in(ka, 20) + (size_t)mat * 1024 * 2048, 1024, 2048, WBR + (size_t)mat * 2048 * 1024, nb * 32, scr, kb, nb, lane); continue; }
        r -= I_BR;
        if (r < I_OUT) { r += OUT0; const int l = r / 2048, rr = r % 2048, kb = rr / 64, nb = rr % 64;
            p0_transpose_item(arg_in(ka, 21) + (size_t)l * 2048 * 2048, 2048, 2048, WOUT + (size_t)l * 2048 * 2048, nb * 32, scr, kb, nb, lane); continue; }
        if (SMALL) {
            r -= I_OUT;
            if (r < I_PW) { const int mat = r / 32, rr = r % 32, kb = rr / 8, nb = rr % 8;
                p0_transpose_item(arg_in(ka, 14) + (size_t)mat * 65536, 256, 256, WPOOL + (size_t)mat * 65536, nb * 32, scr, kb, nb, lane); continue; }
            r -= I_PW;
            { const int mat = r / 32, rr = r % 32, kb = rr / 4, nb = rr % 4;
                p0_transpose_item(arg_in(ka, 4) + (size_t)mat * 65536, 512, 128, (bf16*)(ws + WS_CVT) + (size_t)mat * 65536, nb * 32, scr, kb, nb, lane); }
        }
    }
}

__device__ __forceinline__ void mod_gemv(kargp ka, LAS unsigned char* lds, int tid, float* MOD, int it_end, int start, int stride) {
    LAS float* sc = (LAS float*)lds; LAS float* red = sc + 5 * 2048;
    for (int e = tid; e < 5 * 2048; e += NTHR) { const int v = e >> 11, k = e & 2047; const float c = v == 0 ? arg_in(ka, 6)[k] : arg_in(ka, 2)[(v - 1) * 2048 + k]; sc[e] = c / (1.f + expf(-c)); }
    __syncthreads();
    for (int it = start; it < it_end; it += stride) {
        const int l = it / 288, j0 = (it % 288) * 64, cg = tid & 15, kg = tid >> 4;
        const float* w = arg_in(ka, 7) + ((size_t)l * 2048 + kg * 64) * 18432 + j0 + cg * 4;
        f32x4 a0 = (f32x4){0.f, 0.f, 0.f, 0.f}, a1 = a0, a2 = a0, a3 = a0, a4 = a0;
#pragma unroll 16
        for (int k = 0; k < 64; ++k) { const f32x4 wv = *(const f32x4*)(w + (size_t)k * 18432); const int kk = kg * 64 + k;
            a0 += sc[kk] * wv; a1 += sc[2048 + kk] * wv; a2 += sc[4096 + kk] * wv; a3 += sc[6144 + kk] * wv; a4 += sc[8192 + kk] * wv; }
        *(LAS f32x4*)(red + (kg * 5 + 0) * 64 + cg * 4) = a0; *(LAS f32x4*)(red + (kg * 5 + 1) * 64 + cg * 4) = a1; *(LAS f32x4*)(red + (kg * 5 + 2) * 64 + cg * 4) = a2;
        *(LAS f32x4*)(red + (kg * 5 + 3) * 64 + cg * 4) = a3; *(LAS f32x4*)(red + (kg * 5 + 4) * 64 + cg * 4) = a4;
        __syncthreads();
        if (tid < 320) { const int v = tid >> 6, c2 = tid & 63; float s = 0.f;
#pragma unroll
            for (int k8 = 0; k8 < 32; ++k8) s += red[(k8 * 5 + v) * 64 + c2];
            const int j = j0 + c2; MOD[(size_t)(v * 2 + l) * 18432 + j] = s + arg_in(ka, 8)[(size_t)l * 18432 + j]; }
        __syncthreads();
    }
}

PHASE_FN ph_prologue(LAS unsigned char* lds_, int wave_) {
    PH_BEGIN
    WSP(float, MOD, WS_MOD); WSP(f32x2, ROPE, WS_ROPE); WSP(bf16, WFI, WS_WFI); WSP(bf16, WFO, WS_WFO); WSP(bf16, WIN, WS_WIN); WSP(bf16, WBR, WS_WBR); WSP(bf16, WOUT, WS_WOUT); WSP(bf16, WPOOL, WS_WPOOL);
    if (tid == 0) {
        const int r0 = 384 - G, n1_ = (r0 > 0 && 2 * r0 <= G) ? r0 : 0; const unsigned myx = xb_xcc_id() & 15u; unsigned* cw = (unsigned*)(ws + WS_CTL) + CW_MFLAG;
        if (bx < 384) __hip_atomic_store(cw + bx, myx, __ATOMIC_RELAXED, __HIP_MEMORY_SCOPE_AGENT);
        if (bx >= n1_ && bx < 2 * n1_) (void)__hip_atomic_fetch_add(cw + 384 + myx, 1u, __ATOMIC_RELAXED, __HIP_MEMORY_SCOPE_AGENT);
    }
    mod_gemv(ka, lds, tid, MOD, 576, bx, G);
    if (bx == G - 1) {
        for (int e = tid; e < 2048; e += NTHR) { const int pos = e >> 5, j = e & 31; const float invf = exp2f(-(float)j * (13.287712379549449f / 32.f)); const float ang = (float)pos * invf;
            f32x2 cs; cs.x = cosf(ang); cs.y = sinf(ang); ROPE[e] = cs; }
    }
    {
        const int gt = vcu * NTHR + tid, NGT = G * NTHR;
        for (int i = gt; i < 2 * 57344; i += NGT) { const int l = i / 57344, r = i % 57344; ((v4u*)(WIN + ((size_t)l * INP + INC) * 2048))[r] = (v4u){0u, 0u, 0u, 0u}; }
    }
    cvt_run<0, 22016, 0, 11008, 0, 13344, 0, 3072, 0, 2048, 1>(ka, ws, (LAS float*)(lds + wave * 16384), lane, gw, NGW, 1);
    {
        const int gt = vcu * NTHR + tid, NGT = G * NTHR; const float* ck = arg_in(ka, 3); bf16* CKB = (bf16*)(ws + WS_CKB);
        for (int i = gt; i < 4194304 / 8; i += NGT) { const f32x4 a = ((const f32x4*)ck)[2 * i], b2 = ((const f32x4*)ck)[2 * i + 1];
            v4u w; w.x = pk2(a.x, a.y); w.y = pk2(a.z, a.w); w.z = pk2(b2.x, b2.y); w.w = pk2(b2.z, b2.w); ((v4u*)CKB)[i] = w; }
    }
}
PHASE_FN ph_norm(LAS unsigned char* lds_, int wave_, int mode_, int l_, int i_, int part_, int lfp_) {
    PH_BEGIN
    const int mode = mode_, l = l_, i = i_, part = part_;
    pg8::FfnPreOrder SP; SP.init(G, bx, 2048);
    const int npre = part == 2 ? SP.nblk() : 0;
    if (part == 2 && bx < npre) {
        WSP(bf16, H, WS_H); WSP(bf16, WFI, WS_WFI); WSP(bf16, ACT, WS_A);
        pg8::Gemm g{H, WFI + (size_t)lfp_ * FF2 * 2048, 2048, 2048, 1024, 1024, 2048, 2048, (unsigned*)(ws + WS_CTL + 524288)};
        EpiSwiGLUPre E{ACT, (bf16*)(ws + WS_B + 64 * MiB) + (size_t)(bx & 15) * 65536, (unsigned*)(ws + WS_CTL) + CW_MFLAG + 656 + lfp_ * 16 + (bx & 15), SP.split ? (bx < 16 ? 1 : 2) : 0};
        pg8::gemm_phase<EpiSwiGLUPre, pg8::FfnPreOrder>(lds, g, SP, E, tid);
        return;
    }
    WSP(bf16, YB, WS_B);
    const int ln = (i == 2) ? l + 1 : l, gn = (i == 2) ? 0 : i + 1;
    const float resw = (i == 1) ? 1.0f : 0.5f;
    const int row_lo = part == 2 ? MCTX : 0, row_hi = part == 1 ? MCTX : MTOK;
    const int gwe = part == 2 ? (bx - npre) * NWAVES + wave : gw, NGWe = part == 2 ? (G - npre) * NWAVES : NGW;
    if (mode == 0) norm_rows<true, false>(ka, gwe, NGWe, lane, nullptr, nullptr, 0, 0, 0.f, arg_in(ka, 9), 0, 0, row_lo, row_hi);
    else if (mode == 1) norm_rows<false, false>(ka, gwe, NGWe, lane, YB, arg_in(ka, 10) + (size_t)(l * 3 + i) * DM, l, i, resw, arg_in(ka, 9) + (size_t)(ln * 3 + gn) * DM, ln, gn, row_lo, row_hi);
    else norm_rows<false, true>(ka, gwe, NGWe, lane, YB, arg_in(ka, 10) + (size_t)(l * 3 + i) * DM, l, i, resw, nullptr, 0, 0, row_lo, row_hi);
}
PHASE_FN ph_ffn_in(LAS unsigned char* lds_, int wave_, int lf_) {
    PH_BEGIN
    const int lf = lf_;
    WSP(bf16, H, WS_H); WSP(bf16, WFI, WS_WFI); WSP(bf16, ACT, WS_A);
    pg8::Gemm g{H, WFI + (size_t)lf * FF2 * 2048, 2048, 2048, 0, 0, 2048, 2048, (unsigned*)(ws + WS_CTL + 524288)}; pg8::FfnOrder S; S.init(G, bx, 0);
    EpiSwiGLU E{ACT}; pg8::gemm_phase<EpiSwiGLU, pg8::FfnOrder>(lds, g, S, E, tid);
}
PHASE_FN ph_ffn_out(LAS unsigned char* lds_, int wave_, int lf_) {
    PH_BEGIN
    const int lf = lf_;
    WSP(bf16, ACT, WS_A); WSP(bf16, WFO, WS_WFO); WSP(bf16, YB, WS_B);
    pg8::Gemm g{ACT, WFO + (size_t)lf * 2048 * FF, FF, FF, 2944, 2944, 2944, 2560, (unsigned*)(ws + WS_CTL + 524288)}; pg8::SplitKOrder S; S.init(G, bx, FF, 2944);
    const int n1 = S.n1, jt = (bx < n1 ? bx : bx - n1) & 127;
    EpiY E{YB, DM, ws, 2 + lf, jt, n1, (n1 > 0 && bx < 2 * n1) ? (bx < n1 ? 1 : 2) : 0, S.pm2, S.pn2}; pg8::gemm_phase<EpiY, pg8::SplitKOrder>(lds, g, S, E, tid);
}
PHASE_FN ph_inproj(LAS unsigned char* lds_, int wave_, int l_) {
    PH_BEGIN
    const int l = l_;
    WSP(bf16, H, WS_H); WSP(bf16, WIN, WS_WIN); WSP(f32x2, ROPE, WS_ROPE);
    pg8::Gemm g{H, WIN + (size_t)l * INP * 2048, 2048, 2048, 0, 0, 2048, 2048, (unsigned*)(ws + WS_CTL + 524288)}; pg8::ZOrder S; S.init(48, 53, 1, G, bx, 0);
    EpiInProj E{ws + WS_A, arg_out(ka) + 25165824, arg_out(ka) + 33554432, ROPE, l, lds + TS_OFF};
    pg8::gemm_phase<EpiInProj, pg8::ZOrder>(lds, g, S, E, tid);
}
PHASE_FN ph_mix1(LAS unsigned char* lds_, int wave_, int l_) {
    PH_BEGIN
    const int l = l_;
    unsigned char* PA = ws + WS_A; WSP(bf16, PL, WS_PL); WSP(bf16, BR, WS_BR);
    const bf16* U = (const bf16*)(PA + PA_U);
    {
        const int gt = vcu * NTHR + tid, NGT = G * NTHR;
#define PL_ACC(w_, f_) { s[0] += f_ * bflo(w_.x); s[1] += f_ * bfhi(w_.x); s[2] += f_ * bflo(w_.y); s[3] += f_ * bfhi(w_.y); s[4] += f_ * bflo(w_.z); s[5] += f_ * bfhi(w_.z); s[6] += f_ * bflo(w_.w); s[7] += f_ * bfhi(w_.w); }
        for (int idx = gt; idx < (MTOK / 16) * 128; idx += NGT) {
            const int run = idx >> 7, cc = idx & 127, col0 = cc * 8, g4 = col0 >> 8, win = 2 << g4, lo = win / 2, hi = win - 1 - lo;
            const int row0 = run * 16;
            const int base = row0 < MCTX ? (row0 & ~255) : MCTX + ((row0 - MCTX) & ~2047), L = row0 < MCTX ? 256 : 2048, t0 = row0 - base;
            const bf16* Ub = U + (size_t)base * 1024 + col0; bf16* Pb = PL + (size_t)base * 1024 + col0;
            float s[8] = {0.f, 0.f, 0.f, 0.f, 0.f, 0.f, 0.f, 0.f};
            {
                v4u wq[16];
#pragma unroll
                for (int k = 0; k < 16; ++k) { int r = t0 - lo + k; r = r < 0 ? 0 : (r > L - 1 ? L - 1 : r); wq[k] = *(const v4u*)(Ub + (size_t)r * 1024); }
#pragma unroll
                for (int k = 0; k < 16; ++k) { const int r = t0 - lo + k; const float f = (k < win && r >= 0 && r <= L - 1) ? 1.f : 0.f; PL_ACC(wq[k], f) }
            }
#pragma unroll
            for (int jg = 0; jg < 4; ++jg) {
                v4u wn[4], wo[4], wc[4];
#pragma unroll
                for (int jj = 0; jj < 4; ++jj) { const int t = t0 + 4 * jg + jj; int tn = t + hi, to = t - lo - 1; tn = tn > L - 1 ? L - 1 : tn; to = to < 0 ? 0 : to;
                    wn[jj] = *(const v4u*)(Ub + (size_t)tn * 1024); wo[jj] = *(const v4u*)(Ub + (size_t)to * 1024); wc[jj] = *(const v4u*)(Ub + (size_t)t * 1024); }
#pragma unroll
                for (int jj = 0; jj < 4; ++jj) { const int j = 4 * jg + jj, t = t0 + j;
                    if (j > 0) { const float fn = (t + hi <= L - 1) ? 1.f : 0.f, fo = (t - lo - 1 >= 0) ? -1.f : 0.f; PL_ACC(wn[jj], fn) PL_ACC(wo[jj], fo) }
                    const int tlo = t - lo < 0 ? 0 : t - lo, thi = t + hi > L - 1 ? L - 1 : t + hi;
                    const float ic = 1.0f / (float)(thi - tlo + 1);
                    const v4u w = wc[jj];
                    v4u o; o.x = cvt_pk_bf16(s[0] * ic - bflo(w.x), s[1] * ic - bfhi(w.x)); o.y = cvt_pk_bf16(s[2] * ic - bflo(w.y), s[3] * ic - bfhi(w.y));
                    o.z = cvt_pk_bf16(s[4] * ic - bflo(w.z), s[5] * ic - bfhi(w.z)); o.w = cvt_pk_bf16(s[6] * ic - bflo(w.w), s[7] * ic - bfhi(w.w));
                    *(v4u*)(Pb + (size_t)t * 1024) = o; }
            }
        }
#undef PL_ACC
    }
    {
        LAS float* zs = (LAS float*)lds;
        const bf16* GQ = (const bf16*)(PA + PA_GQ); const bf16* GK = (const bf16*)(PA + PA_GK); const float* GZ = (const float*)(PA + PA_GZ);
        for (int it = bx; it < 384; it += G) {
            const int dir = it & 1, blk = it >> 1;
            __syncthreads();
            for (int e = tid; e < 1024; e += NTHR) zs[e] = GZ[(size_t)(blk * 64 + (e >> 4)) * 32 + dir * 16 + (e & 15)];
            __syncthreads();
            const float* wg = arg_in(ka, 17) + (size_t)(l * 2 + dir) * 16 * 512; const float* bg = arg_in(ka, 18) + (size_t)(l * 2 + dir) * 512;
            bf16* QI = (bf16*)(ws + WS_QI) + (size_t)dir * MTOK * 512; bf16* KI = (bf16*)(ws + WS_KI) + (size_t)dir * MTOK * 512;
            bf16* KDT = (bf16*)(ws + WS_KDT) + (size_t)dir * 512 * MTOK; float* DEC = (float*)(ws + WS_DEC) + (size_t)dir * 192 * 512;
            if (dir == 0) gla_g1_item<0>(zs, zs + 1024, tid, blk, wg, bg, GQ, GK, QI, KI, KDT, DEC); else gla_g1_item<1>(zs, zs + 1024, tid, blk, wg, bg, GQ, GK, QI, KI, KDT, DEC);
            asm volatile("s_waitcnt vmcnt(0)" ::: "memory");
            __syncthreads();
            {
                const int hh = wave >> 1, pr = wave & 1, fr = lane & 15, g = lane >> 4, tok0 = blk * 64;
                bf16x8v Kf[2][4];
#pragma unroll
                for (int sl = 0; sl < 2; ++sl)
#pragma unroll
                    for (int kk = 0; kk < 4; ++kk) Kf[sl][kk] = *(const bf16x8v*)(KI + (size_t)(tok0 + 16 * (2 * pr + sl) + fr) * 512 + hh * 128 + kk * 32 + g * 8);
                unsigned char* pt = ws + WS_PT + ((size_t)(dir * 192 + blk) * 4 + hh) * 8192 + pr * 1024 + lane * 16;
                bf16x8v Qa[4][4];
#pragma unroll
                for (int t4 = 0; t4 < 4; ++t4)
#pragma unroll
                    for (int kk = 0; kk < 4; ++kk) Qa[t4][kk] = *(const bf16x8v*)(QI + (size_t)(tok0 + 16 * t4 + fr) * 512 + hh * 128 + kk * 32 + g * 8);
#pragma unroll
                for (int t4 = 0; t4 < 4; ++t4) {
                    f32x4 a0 = (f32x4){0.f, 0.f, 0.f, 0.f}, a1 = (f32x4){0.f, 0.f, 0.f, 0.f};
#pragma unroll
                    for (int kk = 0; kk < 4; ++kk) { const bf16x8v Qf = Qa[t4][kk];
                        a0 = __builtin_amdgcn_mfma_f32_16x16x32_bf16(Kf[0][kk], Qf, a0, 0, 0, 0); a1 = __builtin_amdgcn_mfma_f32_16x16x32_bf16(Kf[1][kk], Qf, a1, 0, 0, 0); }
#pragma unroll
                    for (int i = 0; i < 4; ++i) { const int tp = 16 * t4 + fr, s0 = 32 * pr + 4 * g + i, s1 = s0 + 16;
                        a0[i] = (dir ? (s0 >= tp) : (s0 <= tp)) ? a0[i] : 0.f; a1[i] = (dir ? (s1 >= tp) : (s1 <= tp)) ? a1[i] : 0.f; }
                    v4u pw; pw.x = cvt_pk_bf16(a0[0], a0[1]); pw.y = cvt_pk_bf16(a0[2], a0[3]); pw.z = cvt_pk_bf16(a1[0], a1[1]); pw.w = cvt_pk_bf16(a1[2], a1[3]);
                    *(v4u*)(pt + t4 * 2048) = pw;
                }
            }
        }
    }
    {
        const bf16* NQ = (const bf16*)(PA + PA_NQ); const bf16* NK = (const bf16*)(PA + PA_NK); const bf16* NVT = (const bf16*)(PA + PA_NV);
        bf16* BR1 = BR + (size_t)MTOK * 1024;
        const float* rpb = arg_in(ka, 16) + (size_t)l * 8 * 15 * 31;
        const bf16* CKB = (const bf16*)(ws + WS_CKB); const bf16* CVT = (const bf16*)(ws + WS_CVT);
        __syncthreads();
        for (int rep_ = 0; rep_ < REP_ATT; ++rep_) {
        for (int ub = vcu; ub < 256; ub += G) {
            const int u = ub * 8 + wave, half = u & 1, r = (u >> 1) & 31, h = (u >> 6) & 7, b = u >> 9;
            int rs = r - 4; rs = rs < 0 ? 0 : (rs > 24 ? 24 : rs);
            const int r0 = r & ~3; int Rlo = r0 - 4; Rlo = Rlo < 0 ? 0 : (Rlo > 24 ? 24 : Rlo); int rs3 = r0 + 3 - 4; rs3 = rs3 < 0 ? 0 : (rs3 > 24 ? 24 : rs3);
            const int nR = rs3 + 7 - Rlo + 1, nloc = (nR + 1) >> 1;
            const int base = MCTX + b * 2048; const size_t co = (((size_t)b * 2 + l) * 8 + h) * 512 * 128;
            attn_block<2, true>(lds, wave, lane, NQ, rpb + h * 465, BR1, base + r * 64 + half * 32, h, rs, r, half, half * 32, Rlo, nloc,
                                (const char*)(NK + (size_t)(base + Rlo * 64) * 1024 + h * 128), (const char*)(NVT + (size_t)(h * 128) * MTOK + base + Rlo * 64),
                                (const char*)(CKB + co), 256u, (const char*)(CVT + co), 1024u, 4);
        }
        for (int ub = bx; ub < 256; ub += G) {
            const int qh = ub & 1, h = (ub >> 1) & 7, b = ub >> 4;
            attn_block<1, false>(lds, wave, lane, NQ, nullptr, BR1, b * 256 + qh * 128 + wave * 16, h, 0, 0, 0, 0, 0, 0, nullptr, nullptr,
                                 (const char*)(NK + (size_t)(b * 256) * 1024 + h * 128), 2048u, (const char*)(NVT + (size_t)(h * 128) * MTOK + b * 256), (unsigned)(MTOK * 2), 2);
        }
        }
    }
}
PHASE_FN ph_mix1b(LAS unsigned char* lds_, int wave_, int l_) {
    PH_BEGIN
    const int l = l_;
    int nb0 = 0, nb1 = 0;
    for (int u = vcu; u < 256; u += G) nb0 += 33;
    for (int u = 256 + vcu; u < 1280; u += G) nb1 += 5;
    const int nbmax = nb0 > nb1 ? nb0 : nb1;
    int done = 0;
    if (wave < 4) { for (int u = vcu; u < 256; u += G) done += gla_g2_unit4(ka, lds, wave, lane, l, u); }
    else { for (int u = 256 + vcu; u < 1280; u += G) done += gla_g2_unit4(ka, lds + 65536, wave - 4, lane, l, u); }
    for (; done < nbmax; ++done) __builtin_amdgcn_s_barrier();
}
PHASE_FN ph_mix2(LAS unsigned char* lds_, int wave_, int l_) {
    PH_BEGIN
    const int l = l_;
    unsigned char* PA = ws + WS_A; WSP(bf16, PL, WS_PL); WSP(bf16, BR, WS_BR); WSP(float, YB, WS_B); WSP(bf16, WPOOL, WS_WPOOL);
    {
        const float* OF = YB; const float* OB = YB + (size_t)MTOK * 1024; const bf16* GR = (const bf16*)(PA + PA_GR); bf16* BR2 = BR + (size_t)2 * MTOK * 1024;
        const float* gn = arg_in(ka, 19) + (size_t)l * 1024;
        const int hh = lane >> 4, sub = lane & 15;
        for (int row = gw; row < MTOK; row += NGW) {
            f32x4 o[4], gv[4]; v2u rv[4]; float ss = 0.f;
#pragma unroll
            for (int j = 0; j < 4; ++j) { const int c = hh * 256 + (sub + 16 * j) * 4; const size_t off = (size_t)row * 1024 + c; o[j] = *(const f32x4*)(OF + off) + *(const f32x4*)(OB + off);
                gv[j] = *(const f32x4*)(gn + c); rv[j] = *(const v2u*)(GR + off); }
#pragma unroll
            for (int j = 0; j < 4; ++j) ss += (o[j].x * o[j].x + o[j].y * o[j].y) + (o[j].z * o[j].z + o[j].w * o[j].w);
            ss = row16_sum(ss);
            const float rstd = 1.0f / sqrtf(ss * (1.f / 256.f) + EPS);
#pragma unroll
            for (int j = 0; j < 4; ++j) { const int c = hh * 256 + (sub + 16 * j) * 4; const f32x4 g4 = gv[j]; const v2u rw = rv[j];
                v2u w; w.x = cvt_pk_bf16(o[j].x * rstd * g4.x * bflo(rw.x), o[j].y * rstd * g4.y * bfhi(rw.x)); w.y = cvt_pk_bf16(o[j].z * rstd * g4.z * bflo(rw.y), o[j].w * rstd * g4.w * bfhi(rw.y));
                *(v2u*)(BR2 + (size_t)row * 1024 + c) = w; }
        }
    }
    {
        pg8::Gemm g{PL, WPOOL + (size_t)l * 4 * 65536, 1024, 256, 256, 65536, 256, 256, (unsigned*)(ws + WS_CTL + 524288)}; pg8::ZOrder S; S.init(48, 1, 4, G, bx, 0);
        EpiPool E{BR, arg_in(ka, 15) + (size_t)l * 1024};
        pg8::gemm_phase<EpiPool, pg8::ZOrder>(lds, g, S, E, tid);
    }
}
PHASE_FN ph_merge(LAS unsigned char* lds_, int wave_, int l_) {
    PH_BEGIN
    const int l = l_;
    WSP(bf16, BR, WS_BR); WSP(bf16, WBR, WS_WBR); WSP(bf16, YB, WS_B); WSP(bf16, MG, WS_MG);
    pg8::Gemm g{BR, WBR + (size_t)l * 3 * 2048 * 1024, 1024, 1024, (size_t)MTOK * 1024, (size_t)2048 * 1024, 1024, 1024, (unsigned*)(ws + WS_CTL + 524288)}; pg8::MergeOrder S; S.init(G, bx); if (l == 0) S.n1 = 0;
    const int n1 = S.n1, jt = bx < n1 ? bx : bx - n1;
    pg8::Unit u2; u2.pm = -1; u2.pn = -1; if (n1 > 0 && bx < 2 * n1) S.Z.map(G + jt, u2);
    EpiMerge E{(const bf16*)(ws + WS_A + PA_GL), YB, MG, ws, l, jt & 127, n1, (n1 > 0 && bx < 2 * n1) ? (bx < n1 ? 1 : 2) : 0, u2.pm, u2.pn};
    pg8::gemm_phase<EpiMerge, pg8::MergeOrder>(lds, g, S, E, tid);
    {
        int w0, rep = 1, NV; bool act;
        if (n1 > 0) {
            if (l == 0) { NV = n1 * NWAVES * 4; act = bx < 2 * n1; if (bx < n1) w0 = bx * NWAVES + wave; else { w0 = n1 * NWAVES + ((bx - n1) * NWAVES + wave) * 3; rep = 3; } }
            else { NV = n1 * NWAVES; act = bx >= n1 && bx < 2 * n1; w0 = (bx - n1) * NWAVES + wave; }
        } else { const int first = 384 % G; act = bx >= first; w0 = (bx - first) * NWAVES + wave; NV = (G - first) * NWAVES; }
        if (act) {
            __syncthreads();
            if (l == 0) cvt_run<22016, 33024, 11008, 16512, 13344, 26688, 3072, 6144, 2048, 4096, 0>(ka, ws, (LAS float*)(lds + wave * 16384), lane, w0, NV, rep);
            else        cvt_run<33024, 44032, 16512, 22016, 0, 0, 0, 0, 0, 0, 0>(ka, ws, (LAS float*)(lds + wave * 16384), lane, w0, NV, rep);
        }
    }
}
PHASE_FN ph_out(LAS unsigned char* lds_, int wave_, int l_) {
    PH_BEGIN
    const int l = l_;
    WSP(bf16, MG, WS_MG); WSP(bf16, WOUT, WS_WOUT); WSP(bf16, YB, WS_B);
    pg8::Gemm g{MG, WOUT + (size_t)l * 2048 * 2048, 2048, 2048, 1152, 1152, 1152, 896, (unsigned*)(ws + WS_CTL + 524288)}; pg8::SplitKOrder S; S.init(G, bx, 2048, 1152);
    const int n1 = S.n1, jt = (bx < n1 ? bx : bx - n1) & 127;
    EpiY E{YB, DM, ws, 6 + l, jt, n1, (n1 > 0 && bx < 2 * n1) ? (bx < n1 ? 1 : 2) : 0, S.pm2, S.pn2};
    pg8::gemm_phase<EpiY, pg8::SplitKOrder>(lds, g, S, E, tid);
}

__global__ void __launch_bounds__(NTHR, 2) mk_fwd(Args args) {
    extern __shared__ __attribute__((aligned(16))) unsigned char lds_raw[];
    LAS unsigned char* lds = (LAS unsigned char*)lds_raw;
    volatile LAS unsigned* MISC = (volatile LAS unsigned*)(lds + MISC_OFF);
    const int wave0 = __builtin_amdgcn_readfirstlane((int)(threadIdx.x >> 6));
    unsigned char* ws0 = arg_ws(KARG);
    gu32* ctl = (gu32*)(ws0 + WS_CTL);
    for (int u = threadIdx.x; u < (LDS_BYTES - LDSCTL_OFF) / 4; u += NTHR) ((LAS unsigned*)(lds + LDSCTL_OFF))[u] = 0u;
    __syncthreads();
    XcdBarrier bar = xcd_barrier_post((unsigned*)(ctl + CW_BAR) + arg_i(KARG, 200) * XCD_BAR_WORDS, MISC + 8);
#if MK_PER_PHASE
    const int lo = arg_i(KARG, 192), hi = arg_i(KARG, 196);
#define IN(k) (lo <= (k) && (k) < hi)
#else
#define IN(k) ((k) < NPH)
#endif
#define SEAM(k) do { if (IN(k) && IN((k) + 1)) { unsigned* bb_ = bar.bar; unsigned bx_ = bar.x; int w_ = wave0; asm volatile("" : "+s"(bb_), "+s"(bx_), "+s"(w_)); \
        unsigned zz_ = 0u; asm volatile("" : "+v"(zz_)); const int ln_ = (int)__builtin_amdgcn_mbcnt_hi(~0u, __builtin_amdgcn_mbcnt_lo(~0u, zz_)); xcd_barrier_impl(bb_, bx_, bar.st, w_ * 64 + ln_); } } while (0)
    if (IN(0)) { ph_prologue(lds, wave0); if (REP_PRO > 1) { __syncthreads(); ph_prologue(lds, wave0); } }
    SEAM(0);
    if (IN(1)) ph_norm(lds, wave0, 0, 0, 0, 1, 0);
    SEAM(1);
    if (IN(2)) ph_norm(lds, wave0, 0, 0, 0, 2, 0);
    SEAM(2);
#define LAYER(l) { constexpr int k0 = 3 + 16 * (l); \
        if (IN(k0 + 0)) { ph_ffn_in(lds, wave0, l * 2 + 0); if (REP_GEMM > 1 || REP_FFI > 1) { __syncthreads(); ph_ffn_in(lds, wave0, l * 2 + 0); } } \
        SEAM(k0 + 0); \
        if (IN(k0 + 1)) { ph_ffn_out(lds, wave0, l * 2 + 0); if (REP_GEMM > 1 || REP_FFO > 1) { __syncthreads(); ph_ffn_out(lds, wave0, l * 2 + 0); } } \
        SEAM(k0 + 1); \
        if (IN(k0 + 2)) ph_norm(lds, wave0, 1, l, 0, 0, 0); \
        SEAM(k0 + 2); \
        if (IN(k0 + 3)) { ph_inproj(lds, wave0, l); if (REP_GEMM > 1 || REP_INP > 1) { __syncthreads(); ph_inproj(lds, wave0, l); } } \
        SEAM(k0 + 3); \
        if (IN(k0 + 4)) { ph_mix1(lds, wave0, l); if (REP_MIX1 > 1) { __syncthreads(); ph_mix1(lds, wave0, l); } } \
        SEAM(k0 + 4); \
        if (IN(k0 + 5)) { ph_mix1b(lds, wave0, l); if (REP_SCAN > 1) { __syncthreads(); ph_mix1b(lds, wave0, l); } } \
        SEAM(k0 + 5); \
        if (IN(k0 + 6)) { ph_mix2(lds, wave0, l); if (REP_GEMM > 1) { __syncthreads(); ph_mix2(lds, wave0, l); } } \
        SEAM(k0 + 6); \
        if (IN(k0 + 7)) { ph_merge(lds, wave0, l); if (REP_GEMM > 1) { __syncthreads(); ph_merge(lds, wave0, l); } } \
        SEAM(k0 + 7); \
        if (IN(k0 + 8)) { ph_out(lds, wave0, l); if (REP_GEMM > 1) { __syncthreads(); ph_out(lds, wave0, l); } } \
        SEAM(k0 + 8); \
        if (IN(k0 + 9)) ph_norm(lds, wave0, 1, l, 1, 1, 0); \
        SEAM(k0 + 9); \
        if (IN(k0 + 10)) ph_norm(lds, wave0, 1, l, 1, 2, l * 2 + 1); \
        SEAM(k0 + 10); \
        if (IN(k0 + 11)) { ph_ffn_in(lds, wave0, l * 2 + 1); if (REP_GEMM > 1 || REP_FFI > 1) { __syncthreads(); ph_ffn_in(lds, wave0, l * 2 + 1); } } \
        SEAM(k0 + 11); \
        if (IN(k0 + 12)) { ph_ffn_out(lds, wave0, l * 2 + 1); if (REP_GEMM > 1 || REP_FFO > 1) { __syncthreads(); ph_ffn_out(lds, wave0, l * 2 + 1); } } \
        SEAM(k0 + 12); \
        if (l == 0) { \
            if (IN(k0 + 13)) ph_norm(lds, wave0, 1, l, 2, 1, 0); \
            SEAM(k0 + 13); \
            if (IN(k0 + 14)) ph_norm(lds, wave0, 1, l, 2, 2, 2); \
            SEAM(k0 + 14); \
        } else { \
            if (IN(k0 + 13)) ph_norm(lds, wave0, 2, l, 2, 0, 0); \
        } \
    }
    LAYER(0)
    LAYER(1)
#undef LAYER
#undef IN
#undef SEAM
}

extern "C" void kernel_launch(void* const* d_in, const int* in_sizes, int n_in, void* d_out, int out_size, void* d_ws, size_t ws_size, hipStream_t stream) {
    static int grid = 0;
    if (grid == 0) {
        if (n_in != 22 || out_size != 50331648 || ws_size < WS_END) { fprintf(stderr, "kernel_launch: unexpected shapes (n_in %d, out %d, ws %zu); nothing launched\n", n_in, out_size, ws_size); grid = -1; return; }
        int dev = 0, cus = 0, per_cu = 0;
        if (hipGetDevice(&dev) != hipSuccess || hipDeviceGetAttribute(&cus, hipDeviceAttributeMultiprocessorCount, dev) != hipSuccess) { grid = -1; return; }
        if (hipFuncSetAttribute((const void*)mk_fwd, hipFuncAttributeMaxDynamicSharedMemorySize, LDS_BYTES) != hipSuccess) { fprintf(stderr, "kernel_launch: hipFuncSetAttribute failed\n"); grid = -1; return; }
        if (hipOccupancyMaxActiveBlocksPerMultiprocessor(&per_cu, (const void*)mk_fwd, NTHR, LDS_BYTES) != hipSuccess || per_cu < 1)
            fprintf(stderr, "kernel_launch: note: occupancy query reports %d workgroups per CU\n", per_cu);
        (void)hipGetLastError();
        grid = cus;
    }
    if (grid < 0) return;
    if (hipMemsetAsync((char*)d_ws + WS_CTL, 0, CTL_ZERO_BYTES, stream) != hipSuccess) { fprintf(stderr, "kernel_launch: memset failed\n"); return; }
    Args a{};
    for (int i = 0; i < 22; ++i) a.in[i] = (const float*)d_in[i];
    a.out = (float*)d_out; a.ws = (unsigned char*)d_ws;
#if MK_PER_PHASE
    for (int k = 0; k < NPH; ++k) { a.ph_lo = k; a.ph_hi = k + 1; a.li = k;
        hipLaunchKernelGGL(mk_fwd, dim3(grid), dim3(NTHR), LDS_BYTES, stream, a); }
#else
    a.ph_lo = 0; a.ph_hi = NPH; a.li = 0;
    hipLaunchKernelGGL(mk_fwd, dim3(grid), dim3(NTHR), LDS_BYTES, stream, a);
#endif
    const hipError_t le = hipPeekAtLastError();
    if (le != hipSuccess) fprintf(stderr, "kernel_launch: launch failed: %s\n", hipGetErrorName(le));
}
```

```cpp
#include <hip/hip_runtime.h>
#include <cstdio>
#include <cstdint>

namespace pg8 {
#define PG8_LAS __attribute__((address_space(3)))
typedef unsigned short bf16_t;
typedef short bf16x8 __attribute__((ext_vector_type(8)));
typedef float f32x4 __attribute__((ext_vector_type(4)));
typedef unsigned u32x4 __attribute__((ext_vector_type(4)));
typedef unsigned u32x2 __attribute__((ext_vector_type(2)));
constexpr int BM = 256, BK = 64, HALF = 128, HTB = HALF * BK * 2, STAGE_BYTES = 8 * HTB, NXCD = 8, WGM = 8;

__host__ __device__ __forceinline__ int lds_byte(int r, int c) { const int st = (r >> 4) * 2 + (c >> 5), rr = r & 15, cc = c & 31, ob = rr * 64 + cc * 2; return st * 1024 + (ob ^ (((ob >> 9) & 1) << 5)); }
__host__ __device__ __forceinline__ void stage_rc(int b, int& R, int& C) { const int st = b / 1024, sb = b % 1024, swz = sb ^ (((sb >> 9) & 1) << 5); R = (st >> 1) * 16 + swz / 64; C = (st & 1) * 32 + (swz % 64) / 2; }
__host__ __device__ __forceinline__ int perm32(int rho) { const int n = rho >> 4, i = rho & 15; return 8 * (i >> 2) + 4 * n + (i & 3); }

struct Unit { int pm, pn, z; };
struct Gemm { const bf16_t* A; const bf16_t* Bt; int lda, ldb; size_t zA, zB; int K0, K1; unsigned* dummy; };

struct ZOrder {
    static constexpr bool CUSTOM_NT = false;
    int nM, nN, nZ, ntile, G, c, zinner;
    __device__ void init(int nM_, int nN_, int nZ_, int G_, int c_, int zinner_) { nM = nM_; nN = nN_; nZ = nZ_; ntile = nM_ * nN_; G = G_; c = c_; zinner = zinner_; }
    __device__ void map(int wgid, Unit& u) const {
        { const int q = ntile / NXCD, r = ntile % NXCD, xcd = wgid % NXCD, off = wgid / NXCD; wgid = (xcd < r ? xcd * (q + 1) : r * (q + 1) + (xcd - r) * q) + off; }
        const int nig = WGM * nN, gid = wgid / nig, fm = gid * WGM, gsz = (nM - fm) < WGM ? (nM - fm) : WGM;
        u.pm = fm + ((wgid % nig) % gsz); u.pn = (wgid % nig) / gsz;
    }
    __device__ bool next(int i, Unit& u) const {
        long L; int z;
        if (zinner) { const int ti = i / nZ; z = i - ti * nZ; L = (long)ti * G + c; if (L >= ntile) return false; }
        else { L = (long)i * G + c; if (L >= (long)ntile * nZ) return false; z = (int)(L / ntile); L -= (long)z * ntile; }
        int wgid = (int)L; { const int q = ntile / NXCD, r = ntile % NXCD, xcd = wgid % NXCD, off = wgid / NXCD; wgid = (xcd < r ? xcd * (q + 1) : r * (q + 1) + (xcd - r) * q) + off; }
        const int nig = WGM * nN, gid = wgid / nig, fm = gid * WGM, gsz = (nM - fm) < WGM ? (nM - fm) : WGM;
        u.pm = fm + ((wgid % nig) % gsz); u.pn = (wgid % nig) / gsz; u.z = z; return true;
    }
};

struct MergeOrder {
    static constexpr bool CUSTOM_NT = false;
    ZOrder Z; int G, c, n1;
    __device__ void init(int G_, int c_) { G = G_; c = c_; Z.init(48, 8, 3, G_, c_, 1); const int r = 384 - G_; n1 = (r > 0 && 2 * r <= G_) ? r : 0; }
    __device__ bool next(int i, Unit& u) const {
        bool ok;
        if (n1 == 0 || i < 3) ok = Z.next(i, u);
        else if (c < n1) { ok = i < 5; Z.map(G + c, u); u.z = i - 3; }
        else if (c < 2 * n1) { ok = i < 4; Z.map(G + c - n1, u); u.z = 2; }
        else ok = false;
        u.pm = __builtin_amdgcn_readfirstlane(u.pm); u.pn = __builtin_amdgcn_readfirstlane(u.pn); u.z = __builtin_amdgcn_readfirstlane(u.z);
        return ok;
    }
};

struct SplitKOrder {
    static constexpr bool CUSTOM_NT = true;
    ZOrder Z; int G, c, n1, pm2, pn2, ntf, nt0, nt1;
    __device__ void init(int G_, int c_, int Kfull, int K0h) { G = G_; c = c_; Z.init(48, 8, 1, G_, c_, 0); const int r = 384 - G_; n1 = (r > 0 && 2 * r <= G_) ? r : 0; ntf = Kfull / BK; nt0 = K0h / BK; nt1 = (Kfull - K0h) / BK;
        Unit u2; u2.pm = -1; u2.pn = -1; if (n1 > 0 && c_ < 2 * n1) Z.map(G_ + (c_ < n1 ? c_ : c_ - n1), u2); pm2 = __builtin_amdgcn_readfirstlane(u2.pm); pn2 = __builtin_amdgcn_readfirstlane(u2.pn); }
    __device__ bool next(int i, Unit& u) const {
        bool ok;
        if (n1 == 0) { const int L = i * G + c; ok = L < 384; if (ok) Z.map(L, u); u.z = 0; }
        else if (i == 0) { ok = c < 384; Z.map(c < 384 ? c : 0, u); u.z = 0; }
        else if (i == 1 && c < n1) { ok = true; Z.map(G + c, u); u.z = 0; }
        else if (i == 1 && c < 2 * n1) { ok = true; Z.map(G + c - n1, u); u.z = 1; }
        else ok = false;
        u.pm = __builtin_amdgcn_readfirstlane(u.pm); u.pn = __builtin_amdgcn_readfirstlane(u.pn); u.z = __builtin_amdgcn_readfirstlane(u.z);
        return ok;
    }
    __device__ int nt(const Unit& u) const { const int z1 = (u.z == 1) ? 1 : 0, sp = (u.pm == pm2 && u.pn == pn2) ? 1 : 0; return z1 * nt1 + (1 - z1) * (sp * nt0 + (1 - sp) * ntf); }
};

struct FfnOrder {
    static constexpr bool CUSTOM_NT = false;
    ZOrder Z; int G, c, pre;
    __device__ void init(int G_, int c_, int pre_) { G = G_; c = c_; pre = pre_; Z.init(48, 42, 1, G_, c_, 0); }
    __device__ bool next(int i, Unit& u) const {
        if (pre) { if (i > 0 || c >= 16) return false; u.pm = c; u.pn = 42; u.z = 0; return true; }
        const long L = (long)i * G + c;
        if (L < 2016) return Z.next(i, u);
        if (L >= 2048) return false;
        u.pm = 16 + (int)(L - 2016); u.pn = 42; u.z = 0; return true;
    }
};

struct FfnPreOrder {
    static constexpr bool CUSTOM_NT = true;
    int c, split, ntk;
    __device__ void init(int G_, int c_, int K) { c = c_; split = G_ >= 64 ? 1 : 0; ntk = K / BK; }
    __device__ int nblk() const { return split ? 32 : 16; }
    __device__ bool next(int i, Unit& u) const { if (i > 0 || c >= nblk()) return false; u.pm = c & 15; u.pn = 42; u.z = c >> 4; return true; }
    __device__ int nt(const Unit&) const { return split ? ntk / 2 : ntk; }
};

__device__ __forceinline__ unsigned cvt_pk_bf16(float lo, float hi) { unsigned r; asm volatile("v_cvt_pk_bf16_f32 %0, %1, %2" : "=v"(r) : "v"(lo), "v"(hi)); return r; }

template <class Epi, class Sched>
__device__ __forceinline__ void gemm_phase(PG8_LAS unsigned char* lds, const Gemm g, const Sched& S, const Epi& E, const int tid) {
    const int wid = __builtin_amdgcn_readfirstlane(tid >> 6), lane = tid & 63, wr = wid >> 2, wc = wid & 3, fr = lane & 15, fq = lane >> 4;
    unsigned voffA[2], voffB[2];
#pragma unroll
    for (int i = 0; i < 2; ++i) { int R, C; stage_rc(tid * 16 + i * 8192, R, C); const int Rb = Epi::PERM ? ((R & ~31) + perm32(R & 31)) : R;
        voffA[i] = (unsigned)(R * g.lda + C) * 2u; voffB[i] = (unsigned)(Rb * g.ldb + C) * 2u; }
    const size_t kstep = (size_t)(BK * 2);
    const size_t hA = (size_t)HALF * g.lda * 2, hB = (size_t)HALF * g.ldb * 2;
    const unsigned ldsw = (unsigned)wid * 1024u;
    const int aoff = lds_byte(wr * 64 + fr, fq * 8), boff = lds_byte(wc * 32 + fr, fq * 8);
#define PG8_SA(b, h) (((b) * 2 + (h)) * HTB)
#define PG8_SB(b, h) ((4 + (b) * 2 + (h)) * HTB)
#define PG8_STAGE(bufoff, gbase, voff) do { _Pragma("unroll") for (int _i = 0; _i < 2; ++_i) \
        __builtin_amdgcn_global_load_lds((const unsigned*)((const char*)(gbase) + (voff)[_i]), (PG8_LAS unsigned*)(lds + (bufoff) + ldsw + _i * 8192), 16, 0, 0); } while (0)
#define PG8_LDA(dst, b, h) do { _Pragma("unroll") for (int m = 0; m < 4; ++m) _Pragma("unroll") for (int k = 0; k < 2; ++k) dst[m][k] = *(const PG8_LAS bf16x8*)(lds + PG8_SA(b, h) + aoff + m * 2048 + k * 1024); } while (0)
#define PG8_LDB(dst, b, h) do { _Pragma("unroll") for (int n = 0; n < 2; ++n) _Pragma("unroll") for (int k = 0; k < 2; ++k) dst[n][k] = *(const PG8_LAS bf16x8*)(lds + PG8_SB(b, h) + boff + n * 2048 + k * 1024); } while (0)
#define PG8_MMA(ai, bj, At, Bt) do { __builtin_amdgcn_s_setprio(1); _Pragma("unroll") for (int m = 0; m < 4; ++m) _Pragma("unroll") for (int n = 0; n < 2; ++n) _Pragma("unroll") for (int k = 0; k < 2; ++k) \
        acc[ai][bj][m][n] = __builtin_amdgcn_mfma_f32_16x16x32_bf16(Bt[n][k], At[m][k], acc[ai][bj][m][n], 0, 0, 0); __builtin_amdgcn_s_setprio(0); } while (0)
#define PG8_WAIT_V(n) asm volatile("s_waitcnt vmcnt(" #n ")" ::: "memory")
#define PG8_WAIT_VN(n) asm volatile("s_waitcnt vmcnt(%0)" :: "n"(n) : "memory")
#define PG8_WAIT_L(n) asm volatile("s_waitcnt lgkmcnt(" #n ")" ::: "memory")
#define PG8_BAR __builtin_amdgcn_s_barrier()
#define PG8_SCHED __builtin_amdgcn_sched_barrier(0)
#define PG8_ABASE(u) ((const char*)g.A + ((size_t)(u).z * g.zA) * 2 + (size_t)(u).pm * 2 * hA)
#define PG8_BBASE(u) ((const char*)g.Bt + ((size_t)(u).z * g.zB) * 2 + (size_t)(u).pn * 2 * hB)
    Unit cur, nxt; int ui = 0;
    if (!S.next(0, cur)) return;
    f32x4 acc[2][2][4][2];
#pragma unroll
    for (int a = 0; a < 2; ++a)
#pragma unroll
        for (int b = 0; b < 2; ++b)
#pragma unroll
            for (int m = 0; m < 4; ++m)
#pragma unroll
                for (int n = 0; n < 2; ++n) acc[a][b][m][n] = (f32x4){0.f, 0.f, 0.f, 0.f};
    bf16x8 At[4][2], B0[2][2], B1[2][2];
    const char* cA = PG8_ABASE(cur); const char* cB = PG8_BBASE(cur);
    int nt; if constexpr (Sched::CUSTOM_NT) nt = S.nt(cur); else nt = (cur.z == 0 ? g.K0 : g.K1) / BK;
    PG8_STAGE(PG8_SB(0, 0), cB, voffB); PG8_STAGE(PG8_SB(0, 1), cB + hB, voffB); PG8_STAGE(PG8_SA(0, 0), cA, voffA); PG8_STAGE(PG8_SA(0, 1), cA + hA, voffA);
    if (wr == 1) PG8_BAR;
    PG8_WAIT_V(2); PG8_BAR;
    PG8_STAGE(PG8_SB(1, 0), cB + kstep, voffB); PG8_STAGE(PG8_SA(1, 0), cA + kstep, voffA); PG8_STAGE(PG8_SB(1, 1), cB + hB + kstep, voffB);
    PG8_WAIT_V(6); PG8_BAR;
    if (Epi::NSTORE > 0) { unsigned* dp = g.dummy + blockIdx.x * 512 + tid;
#pragma unroll
        for (int i = 0; i < Epi::NSTORE; ++i) asm volatile("global_store_dword %0, %1, off" :: "v"(dp), "v"(i) : "memory"); }
    for (;;) {
        const bool has_next = S.next(ui + 1, nxt);
        const char* nA = has_next ? PG8_ABASE(nxt) : cA; const char* nB = has_next ? PG8_BBASE(nxt) : cB;
#define PG8_KBODY(WV) do { \
              \
            PG8_LDB(B0, 0, 0); PG8_LDB(B1, 0, 1); PG8_SCHED; PG8_LDA(At, 0, 0); PG8_STAGE(PG8_SA(1, 1), a1 + hA, voffA); \
            PG8_WAIT_VN(WV); PG8_WAIT_L(0); PG8_BAR; PG8_MMA(0, 0, At, B0); PG8_MMA(0, 1, At, B1); PG8_BAR; PG8_SCHED; \
              \
            PG8_LDA(At, 0, 1); PG8_STAGE(PG8_SB(0, 0), b2, voffB); PG8_STAGE(PG8_SB(0, 1), b2 + hB, voffB); PG8_STAGE(PG8_SA(0, 0), a2, voffA); \
            PG8_WAIT_VN(WV); PG8_WAIT_L(0); PG8_BAR; PG8_MMA(1, 0, At, B0); PG8_MMA(1, 1, At, B1); PG8_BAR; PG8_SCHED; \
              \
            PG8_LDB(B0, 1, 0); PG8_LDB(B1, 1, 1); PG8_SCHED; PG8_LDA(At, 1, 0); PG8_STAGE(PG8_SA(0, 1), a2 + hA, voffA); \
            PG8_WAIT_VN(WV); PG8_WAIT_L(0); PG8_BAR; PG8_MMA(0, 0, At, B0); PG8_MMA(0, 1, At, B1); PG8_BAR; PG8_SCHED; \
              \
            PG8_LDA(At, 1, 1); PG8_STAGE(PG8_SB(1, 0), b3, voffB); PG8_STAGE(PG8_SB(1, 1), b3 + hB, voffB); PG8_STAGE(PG8_SA(1, 0), a3, voffA); \
            PG8_WAIT_VN(WV); PG8_WAIT_L(0); PG8_BAR; PG8_MMA(1, 0, At, B0); PG8_MMA(1, 1, At, B1); PG8_BAR; PG8_SCHED; } while (0)
        int t = 0;
        if (Epi::NSTORE > 0) {
            const char* a1 = cA + kstep; const char* a2 = cA + 2 * kstep; const char* b2 = cB + 2 * kstep; const char* a3 = a2 + kstep; const char* b3 = b2 + kstep;
            PG8_KBODY(8 + Epi::NSTORE); t = 2;
        }
        for (; t < nt; t += 2) {
            const bool last = (t == nt - 2);
            const char* a1 = cA + (size_t)(t + 1) * kstep;
            const char* a2 = last ? nA : cA + (size_t)(t + 2) * kstep; const char* b2 = last ? nB : cB + (size_t)(t + 2) * kstep;
            const char* a3 = a2 + kstep; const char* b3 = b2 + kstep;
            PG8_KBODY(8);
        }
#undef PG8_KBODY
        if (wr == 0) PG8_BAR;
        {
            unsigned zz_ = 0u; asm volatile("" : "+v"(zz_)); const int ln_ = (int)__builtin_amdgcn_mbcnt_hi(~0u, __builtin_amdgcn_mbcnt_lo(~0u, zz_));
            E(acc, cur, wr, wc, ln_ & 15, ln_ >> 4);
        }
        if (!has_next) break;
#pragma unroll
        for (int a = 0; a < 2; ++a)
#pragma unroll
            for (int b = 0; b < 2; ++b)
#pragma unroll
                for (int m = 0; m < 4; ++m)
#pragma unroll
                    for (int n = 0; n < 2; ++n) acc[a][b][m][n] = (f32x4){0.f, 0.f, 0.f, 0.f};
        cur = nxt; cA = nA; cB = nB; ++ui; if constexpr (Sched::CUSTOM_NT) nt = S.nt(cur); else nt = (cur.z == 0 ? g.K0 : g.K1) / BK;
        if (wr == 1) PG8_BAR;
    }
    PG8_WAIT_V(0);
    PG8_BAR;
#undef PG8_SA
#undef PG8_SB
#undef PG8_STAGE
#undef PG8_LDA
#undef PG8_LDB
#undef PG8_MMA
#undef PG8_WAIT_V
#undef PG8_WAIT_VN
#undef PG8_WAIT_L
#undef PG8_BAR
#undef PG8_SCHED
#undef PG8_ABASE
#undef PG8_BBASE
}
}

constexpr int DM = 2048, MCTX = 4096, MLAT = 8192, MTOK = 12288;
constexpr int FF = 5504, FF2 = 11008, INC = 13344, INP = 13568;
constexpr int NMOD = 9;
constexpr float EPS = 1e-6f;
constexpr int NWAVES = 8, NTHR = 512;

constexpr size_t MiB = 1u << 20;
constexpr size_t WS_CTL = 0, CTL_ZERO_BYTES = 65536;
constexpr size_t WS_MOD = 1 * MiB;
constexpr size_t WS_ROPE = 1 * MiB + 768 * 1024;
constexpr size_t WS_WFI = 2 * MiB;
constexpr size_t WS_WFO = 174 * MiB;
constexpr size_t WS_WIN = 260 * MiB;
constexpr size_t WS_WBR = 366 * MiB;
constexpr size_t WS_WOUT = 390 * MiB;
constexpr size_t WS_WPOOL = 406 * MiB;
constexpr size_t WS_H = 408 * MiB;
constexpr size_t WS_A = 456 * MiB;
constexpr size_t WS_B = 776 * MiB;
constexpr size_t WS_PL = 968 * MiB;
constexpr size_t WS_BR = 992 * MiB;
constexpr size_t WS_MG = 1064 * MiB;
constexpr size_t WS_CKB = 1112 * MiB;
constexpr size_t WS_CVT = 1120 * MiB;
constexpr size_t WS_QI = 1128 * MiB;
constexpr size_t WS_KI = 1152 * MiB;
constexpr size_t WS_KDT = 1176 * MiB;
constexpr size_t WS_DEC = 1200 * MiB;
constexpr size_t WS_PT = 1202 * MiB;
constexpr size_t WS_END = 1216 * MiB;
constexpr size_t PA_U = 0, PA_NQ = 24 * MiB, PA_NK = 48 * MiB, PA_NV = 72 * MiB, PA_GV = 96 * MiB, PA_GR = 120 * MiB, PA_GQ = 144 * MiB, PA_GK = 156 * MiB, PA_GL = 168 * MiB, PA_GZ = 312 * MiB;

constexpr int CW_MFLAG = 8192;
constexpr int CW_BAR = 4096;
constexpr int RING_BYTES = 131072;
constexpr int LDSCTL_OFF = RING_BYTES, MISC_OFF = LDSCTL_OFF + 320;
constexpr int LDS_BYTES = 155648, TS_OFF = RING_BYTES + 1024, TS_WAVE = 2688;

constexpr int NPH = 34;
#define REP_MIX1 1
#define REP_GEMM 1
#define REP_PRO 1
#define REP_SCAN 1
#define REP_ATT 1
#define REP_FFI 1
#define REP_INP 1
#define REP_FFO 1
#ifndef MK_PER_PHASE
#define MK_PER_PHASE 0
#endif

#define GAS __attribute__((address_space(1)))
#define LAS __attribute__((address_space(3)))
typedef unsigned short bf16;
typedef unsigned v4u __attribute__((ext_vector_type(4)));
typedef unsigned v2u __attribute__((ext_vector_type(2)));
typedef float f32x4 __attribute__((ext_vector_type(4)));
typedef float f32x2 __attribute__((ext_vector_type(2)));
typedef GAS unsigned gu32;
#define RLX_AGENT __ATOMIC_RELAXED, __HIP_MEMORY_SCOPE_AGENT
#define LDS_WAIT() asm volatile("s_waitcnt lgkmcnt(0)" ::: "memory")
__device__ __forceinline__ unsigned f2bf(float f) { unsigned u = __builtin_bit_cast(unsigned, f); return (u + 0x7fffu + ((u >> 16) & 1u)) >> 16; }
__device__ __forceinline__ unsigned pk2(float lo, float hi) { return f2bf(lo) | (f2bf(hi) << 16); }
__device__ __forceinline__ float bflo(unsigned w) { return __builtin_bit_cast(float, w << 16); }
__device__ __forceinline__ float bfhi(unsigned w) { return __builtin_bit_cast(float, w & 0xffff0000u); }
__device__ __forceinline__ float bf2f(bf16 b) { return __builtin_bit_cast(float, ((unsigned)b) << 16); }
__device__ __forceinline__ float sigmoid_f(float x) { return __builtin_amdgcn_rcpf(1.f + __builtin_amdgcn_exp2f(x * -1.4426950408889634f)); }
__device__ __forceinline__ float silu_f(float x) { return x * sigmoid_f(x); }
__device__ __forceinline__ f32x4 sigmoid4(f32x4 x) { const f32x4 t = x * -1.4426950408889634f; f32x4 e; e.x = __builtin_amdgcn_exp2f(t.x); e.y = __builtin_amdgcn_exp2f(t.y); e.z = __builtin_amdgcn_exp2f(t.z); e.w = __builtin_amdgcn_exp2f(t.w);
    const f32x4 d = e + 1.0f; f32x4 r; r.x = __builtin_amdgcn_rcpf(d.x); r.y = __builtin_amdgcn_rcpf(d.y); r.z = __builtin_amdgcn_rcpf(d.z); r.w = __builtin_amdgcn_rcpf(d.w); return r; }

#define XB_TMO      128
#define XB_XCNT(j)  (256  + 64 * (j))
#define XB_XSUB(j)  (1280 + 64 * (j))
#define XB_XGEN(j)  (2304 + 64 * (j))
#define XB_TOP      3328
#define XB_TOPGEN   3392
#define XCD_BAR_WORDS 3456
#define XB_SPIN_CAP (1u << 18)
__device__ __forceinline__ unsigned xb_ld(unsigned* p)              { return __hip_atomic_load(p, __ATOMIC_RELAXED, __HIP_MEMORY_SCOPE_AGENT); }
__device__ __forceinline__ unsigned xb_add(unsigned* p, unsigned v) { return __hip_atomic_fetch_add(p, v, __ATOMIC_RELAXED, __HIP_MEMORY_SCOPE_AGENT); }
__device__ __forceinline__ unsigned xb_xcc_id() { return (unsigned)__builtin_amdgcn_s_getreg((3 << 11) | 20) & 0xFu; }
#define XB_SPIN(cond, bar) do { unsigned _sp = 0; while (cond) { __builtin_amdgcn_s_sleep(1); \
    if ((++_sp & 255u) == 0u) { if (xb_ld(&(bar)[XB_TMO])) break; if (_sp > XB_SPIN_CAP) { atomicAdd(&(bar)[XB_TMO], 1u); break; } } } } while (0)
struct XcdBarrier { unsigned* bar; unsigned x; volatile LAS unsigned* st; };
__device__ __forceinline__ XcdBarrier xcd_barrier_post(unsigned* bar, volatile LAS unsigned* st) {
    XcdBarrier b; b.bar = bar; b.x = (unsigned)__builtin_amdgcn_readfirstlane((int)xb_xcc_id()); b.st = st;
    if (threadIdx.x == 0) (void)xb_add(&bar[XB_XCNT(b.x)], 1u);
    return b;
}
__device__ __forceinline__ void xcd_barrier_complete(unsigned* bar, unsigned x, unsigned& nloc, unsigned& nx) {
    const unsigned G = gridDim.x * gridDim.y * gridDim.z;
    unsigned sum, cnt, mine, sp = 0u;
    for (;;) {
        sum = 0u; cnt = 0u;
#pragma unroll 1
        for (unsigned j = 0; j < 16; ++j) { const unsigned c = xb_ld(&bar[XB_XCNT(j)]); sum += c; cnt += (c > 0u) ? 1u : 0u; }
        if (sum == G) break;
        __builtin_amdgcn_s_sleep(1);
        if ((++sp & 255u) == 0u) { if (xb_ld(&bar[XB_TMO])) break; if (sp > XB_SPIN_CAP) { atomicAdd(&bar[XB_TMO], 1u); break; } }
    }
    mine = xb_ld(&bar[XB_XCNT(x)]);
    nloc = mine > 0u ? mine : 1u; nx = cnt > 0u ? cnt : 1u;
}
static __device__ __forceinline__ void xcd_barrier_impl(unsigned* bar_, unsigned x_, volatile LAS unsigned* st_, int tid_) {
    XcdBarrier b; b.bar = bar_; b.x = x_; b.st = st_;
    asm volatile("s_waitcnt vmcnt(0)" ::: "memory");
    __syncthreads();
    if (tid_ == 0) {
        unsigned* bar = b.bar;
        __builtin_amdgcn_s_waitcnt(0);
        unsigned nloc = b.st[0], nx = b.st[1];
        if (nloc == 0u) { xcd_barrier_complete(bar, b.x, nloc, nx); b.st[0] = nloc; b.st[1] = nx; }
        const unsigned old = xb_add(&bar[XB_XSUB(b.x)], 1u);
        const unsigned gen = old / nloc;
        if (old + 1u == (gen + 1u) * nloc) {
            __builtin_amdgcn_fence(__ATOMIC_RELEASE, "agent");
            asm volatile("s_waitcnt vmcnt(0)" ::: "memory");
            const unsigned og = xb_add(&bar[XB_TOP], 1u);
            const unsigned tg = og / nx;
            if (og + 1u == (tg + 1u) * nx) xb_add(&bar[XB_TOPGEN], 1u);
            else XB_SPIN(xb_ld(&bar[XB_TOPGEN]) == tg, bar);
            __builtin_amdgcn_fence(__ATOMIC_ACQUIRE, "agent");
            xb_add(&bar[XB_XGEN(b.x)], 1u);
            asm volatile("s_waitcnt vmcnt(0)" ::: "memory");
        } else {
            XB_SPIN(xb_ld(&bar[XB_XGEN(b.x)]) == gen, bar);
            __builtin_amdgcn_fence(__ATOMIC_ACQUIRE, "agent");
            asm volatile("s_waitcnt vmcnt(0)" ::: "memory");
        }
    }
    __syncthreads();
}

using pg8::Unit; using pg8::cvt_pk_bf16;
struct EpiSwiGLU {
    static constexpr bool PERM = true; static constexpr int NSTORE = 8;
    bf16* ACT;
    __device__ __forceinline__ void operator()(const f32x4 (&acc)[2][2][4][2], const Unit& u, int wr, int wc, int fr, int fq) const {
        const int row0 = u.pm * 256 + wr * 64 + fr, col0 = u.pn * 128 + wc * 32 + 8 * fq;
#pragma unroll
        for (int ai = 0; ai < 2; ++ai)
#pragma unroll
            for (int m = 0; m < 4; ++m) {
                bf16* rowp = ACT + (size_t)(row0 + ai * 128 + m * 16) * FF + col0;
                const f32x4 v0 = (acc[ai][0][m][0] * acc[ai][1][m][0]) * sigmoid4(acc[ai][0][m][0]), v1 = (acc[ai][0][m][1] * acc[ai][1][m][1]) * sigmoid4(acc[ai][0][m][1]);
                v4u w; w.x = cvt_pk_bf16(v0[0], v0[1]); w.y = cvt_pk_bf16(v0[2], v0[3]); w.z = cvt_pk_bf16(v1[0], v1[1]); w.w = cvt_pk_bf16(v1[2], v1[3]);
                *(v4u*)rowp = w;
            }
    }
};
struct EpiSwiGLUPre {
    static constexpr bool PERM = true; static constexpr int NSTORE = 0;
    bf16* ACT; bf16* P; unsigned* flag; int role;
    __device__ __forceinline__ void operator()(const f32x4 (&acc)[2][2][4][2], const Unit& u, int wr, int wc, int fr, int fq) const {
        const int row0 = u.pm * 256 + wr * 64 + fr, col0 = u.pn * 128 + wc * 32 + 8 * fq;
        const int tidl = (wr * 4 + wc) * 64 + fq * 16 + fr;
        bf16* Pt = P + (size_t)tidl * 8;
        if (role == 2) {
#pragma unroll
            for (int ai = 0; ai < 2; ++ai)
#pragma unroll
                for (int m = 0; m < 4; ++m)
#pragma unroll
                    for (int bj = 0; bj < 2; ++bj) { const f32x4 v0 = acc[ai][bj][m][0], v1 = acc[ai][bj][m][1];
                        v4u w; w.x = cvt_pk_bf16(v0[0], v0[1]); w.y = cvt_pk_bf16(v0[2], v0[3]); w.z = cvt_pk_bf16(v1[0], v1[1]); w.w = cvt_pk_bf16(v1[2], v1[3]);
                        *(v4u*)(Pt + (size_t)(((ai * 4 + m) * 2 + bj) * 512) * 8) = w; }
            asm volatile("s_waitcnt vmcnt(0)" ::: "memory");
            __builtin_amdgcn_s_barrier();
            if (tidl == 0) { __builtin_amdgcn_fence(__ATOMIC_RELEASE, "agent"); asm volatile("s_waitcnt vmcnt(0)" ::: "memory"); __hip_atomic_store(flag, 1u, __ATOMIC_RELAXED, __HIP_MEMORY_SCOPE_AGENT); }
            return;
        }
        if (role == 1) {
            if (tidl == 0) { unsigned sp = 0u; while (__hip_atomic_load(flag, __ATOMIC_RELAXED, __HIP_MEMORY_SCOPE_AGENT) == 0u) { __builtin_amdgcn_s_sleep(2); if (++sp > (1u << 26)) break; }
                __builtin_amdgcn_fence(__ATOMIC_ACQUIRE, "agent"); }
            asm volatile("s_waitcnt vmcnt(0) lgkmcnt(0)" ::: "memory");
            __builtin_amdgcn_s_barrier();
        }
#pragma unroll
        for (int ai = 0; ai < 2; ++ai) {
            v4u hw[4][2];
#pragma unroll
            for (int m = 0; m < 4; ++m)
#pragma unroll
                for (int bj = 0; bj < 2; ++bj) hw[m][bj] = role == 1 ? *(const v4u*)(Pt + (size_t)(((ai * 4 + m) * 2 + bj) * 512) * 8) : (v4u){0u, 0u, 0u, 0u};
#pragma unroll
            for (int m = 0; m < 4; ++m) {
                bf16* rowp = ACT + (size_t)(row0 + ai * 128 + m * 16) * FF + col0;
                const v4u hg = hw[m][0], hu = hw[m][1];
                f32x4 g0 = acc[ai][0][m][0], g1 = acc[ai][0][m][1], u0 = acc[ai][1][m][0], u1 = acc[ai][1][m][1];
                g0[0] += bflo(hg.x); g0[1] += bfhi(hg.x); g0[2] += bflo(hg.y); g0[3] += bfhi(hg.y); g1[0] += bflo(hg.z); g1[1] += bfhi(hg.z); g1[2] += bflo(hg.w); g1[3] += bfhi(hg.w);
                u0[0] += bflo(hu.x); u0[1] += bfhi(hu.x); u0[2] += bflo(hu.y); u0[3] += bfhi(hu.y); u1[0] += bflo(hu.z); u1[1] += bfhi(hu.z); u1[2] += bflo(hu.w); u1[3] += bfhi(hu.w);
                const f32x4 v0 = (g0 * u0) * sigmoid4(g0), v1 = (g1 * u1) * sigmoid4(g1);
                v4u w; w.x = cvt_pk_bf16(v0[0], v0[1]); w.y = cvt_pk_bf16(v0[2], v0[3]); w.z = cvt_pk_bf16(v1[0], v1[1]); w.w = cvt_pk_bf16(v1[2], v1[3]);
                *(v4u*)rowp = w;
            }
            asm volatile("" ::: "memory");
        }
    }
};
struct EpiY {
    static constexpr bool PERM = true; static constexpr int NSTORE = 16;
    bf16* Y; int ldc; unsigned char* ws; int slot, jt, n1, role, pm2, pn2;
    __device__ __forceinline__ void operator()(const f32x4 (&acc)[2][2][4][2], const Unit& u, int wr, int wc, int fr, int fq) const {
        const int row0 = u.pm * 256 + wr * 64 + fr, col0 = u.pn * 256 + wc * 32 + 8 * fq;
        const int tidl = (wr * 4 + wc) * 64 + fq * 16 + fr;
        const bool split = role != 0 && u.pm == pm2 && u.pn == pn2; const int uf = !split ? 0 : role;
        bf16* P = (bf16*)(ws + WS_B + 64 * MiB) + (size_t)jt * 65536 + (size_t)tidl * 8;
        unsigned* cw = (unsigned*)(ws + WS_CTL) + CW_MFLAG;
        if (uf == 1) {
            if (tidl == 0) { const unsigned hx = __hip_atomic_load(cw + n1 + jt, __ATOMIC_RELAXED, __HIP_MEMORY_SCOPE_AGENT) & 15u; unsigned* xflag = cw + 528 + slot * 16 + hx;
                unsigned sp = 0u; while (__hip_atomic_load(xflag, __ATOMIC_RELAXED, __HIP_MEMORY_SCOPE_AGENT) == 0u) { __builtin_amdgcn_s_sleep(2); if (++sp > (1u << 26)) break; }
                __builtin_amdgcn_fence(__ATOMIC_ACQUIRE, "agent"); }
            asm volatile("s_waitcnt vmcnt(0) lgkmcnt(0)" ::: "memory");
            __builtin_amdgcn_s_barrier();
        }
#pragma unroll
        for (int ai = 0; ai < 2; ++ai) {
            v4u hw[4][2];
#pragma unroll
            for (int m = 0; m < 4; ++m)
#pragma unroll
                for (int bj = 0; bj < 2; ++bj) hw[m][bj] = uf == 1 ? *(const v4u*)(P + (size_t)(((ai * 4 + m) * 2 + bj) * 512) * 8) : (v4u){0u, 0u, 0u, 0u};
#pragma unroll
            for (int m = 0; m < 4; ++m) { bf16* rowp = Y + (size_t)(row0 + ai * 128 + m * 16) * ldc + col0;
#pragma unroll
                for (int bj = 0; bj < 2; ++bj) { f32x4 v0 = acc[ai][bj][m][0], v1 = acc[ai][bj][m][1]; const v4u h = hw[m][bj];
                    v0[0] += bflo(h.x); v0[1] += bfhi(h.x); v0[2] += bflo(h.y); v0[3] += bfhi(h.y); v1[0] += bflo(h.z); v1[1] += bfhi(h.z); v1[2] += bflo(h.w); v1[3] += bfhi(h.w);
                    v4u w; w.x = cvt_pk_bf16(v0[0], v0[1]); w.y = cvt_pk_bf16(v0[2], v0[3]); w.z = cvt_pk_bf16(v1[0], v1[1]); w.w = cvt_pk_bf16(v1[2], v1[3]);
                    if (uf == 2) *(v4u*)(P + (size_t)(((ai * 4 + m) * 2 + bj) * 512) * 8) = w;
                    else *(v4u*)(rowp + bj * 128) = w; } }
            asm volatile("" ::: "memory");
        }
        if (uf == 2) {
            asm volatile("s_waitcnt vmcnt(0)" ::: "memory");
            __builtin_amdgcn_s_barrier();
            if (tidl == 0) {
                const unsigned hx = __hip_atomic_load(cw + n1 + jt, __ATOMIC_RELAXED, __HIP_MEMORY_SCOPE_AGENT) & 15u, hcnt = __hip_atomic_load(cw + 384 + hx, __ATOMIC_RELAXED, __HIP_MEMORY_SCOPE_AGENT);
                const unsigned old = __hip_atomic_fetch_add(cw + 400 + slot * 16 + hx, 1u, __ATOMIC_RELAXED, __HIP_MEMORY_SCOPE_AGENT);
                if (old + 1u == hcnt) { __builtin_amdgcn_fence(__ATOMIC_RELEASE, "agent"); asm volatile("s_waitcnt vmcnt(0)" ::: "memory"); __hip_atomic_store(cw + 528 + slot * 16 + hx, 1u, __ATOMIC_RELAXED, __HIP_MEMORY_SCOPE_AGENT); }
            }
        }
    }
};
struct EpiPool {
    static constexpr bool PERM = true; static constexpr int NSTORE = 0;
    bf16* O; const float* scale;
    __device__ __forceinline__ void operator()(const f32x4 (&acc)[2][2][4][2], const Unit& u, int wr, int wc, int fr, int fq) const {
        const int row0 = u.pm * 256 + wr * 64 + fr, col0 = u.z * 256 + wc * 32 + 8 * fq;
        f32x4 sc[2][2];
#pragma unroll
        for (int bj = 0; bj < 2; ++bj)
#pragma unroll
            for (int n = 0; n < 2; ++n) sc[bj][n] = *(const f32x4*)(scale + col0 + bj * 128 + 4 * n);
#pragma unroll
        for (int ai = 0; ai < 2; ++ai)
#pragma unroll
            for (int m = 0; m < 4; ++m) { bf16* rowp = O + (size_t)(row0 + ai * 128 + m * 16) * 1024 + col0;
#pragma unroll
                for (int bj = 0; bj < 2; ++bj) { const f32x4 v0 = acc[ai][bj][m][0] * sc[bj][0], v1 = acc[ai][bj][m][1] * sc[bj][1];
                    v4u w; w.x = cvt_pk_bf16(v0[0], v0[1]); w.y = cvt_pk_bf16(v0[2], v0[3]); w.z = cvt_pk_bf16(v1[0], v1[1]); w.w = cvt_pk_bf16(v1[2], v1[3]);
                    *(v4u*)(rowp + bj * 128) = w; } }
    }
};
struct EpiMerge {
    static constexpr bool PERM = true; static constexpr int NSTORE = 0;
    const bf16* GL; bf16* MS; bf16* MG; unsigned char* ws; int l, jt, n1, role, pm2, pn2;
    __device__ __forceinline__ void operator()(const f32x4 (&acc)[2][2][4][2], const Unit& u, int wr, int wc, int fr, int fq) const {
        const int row0 = u.pm * 256 + wr * 64 + fr, col0 = u.pn * 256 + wc * 32 + 8 * fq;
        const int tidl = (wr * 4 + wc) * 64 + fq * 16 + fr;
        const bool split = role != 0 && u.pm == pm2 && u.pn == pn2; const int uf = !split ? 0 : (role == 1 ? (u.z == 1 ? 1 : 0) : 2);
        const bool first = (u.z == 0) || (uf == 2), fin = (u.z == 2) && (uf == 0);
        bf16* mst = MS + ((size_t)u.pm * 8 + u.pn) * 65536;
        bf16* MS2 = (bf16*)(ws + WS_B + 64 * MiB) + (size_t)jt * 65536;
        bf16* msd = uf == 2 ? MS2 : mst;
#pragma unroll
        for (int ai = 0; ai < 2; ++ai) {
            v4u gw[4][2], mw[4][2];
#pragma unroll
            for (int m = 0; m < 4; ++m)
#pragma unroll
                for (int bj = 0; bj < 2; ++bj) { const size_t cidx = (size_t)(((ai * 4 + m) * 2 + bj) * 512 + tidl) * 8;
                    gw[m][bj] = *(const v4u*)(GL + ((size_t)u.pm * 24 + u.z * 8 + u.pn) * 65536 + cidx);
                    mw[m][bj] = !first ? *(const v4u*)(mst + cidx) : (v4u){0u, 0u, 0u, 0u}; }
#pragma unroll
            for (int m = 0; m < 4; ++m)
#pragma unroll
                for (int bj = 0; bj < 2; ++bj) { const size_t row = (size_t)(row0 + ai * 128 + m * 16); const int col = col0 + bj * 128; const size_t cidx = (size_t)(((ai * 4 + m) * 2 + bj) * 512 + tidl) * 8;
                    const v4u g = gw[m][bj], q = mw[m][bj];
                    f32x4 v0 = acc[ai][bj][m][0], v1 = acc[ai][bj][m][1];
                    v0[0] = v0[0] * bflo(g.x) + bflo(q.x); v0[1] = v0[1] * bfhi(g.x) + bfhi(q.x); v0[2] = v0[2] * bflo(g.y) + bflo(q.y); v0[3] = v0[3] * bfhi(g.y) + bfhi(q.y);
                    v1[0] = v1[0] * bflo(g.z) + bflo(q.z); v1[1] = v1[1] * bfhi(g.z) + bfhi(q.z); v1[2] = v1[2] * bflo(g.w) + bflo(q.w); v1[3] = v1[3] * bfhi(g.w) + bfhi(q.w);
                    v4u w; w.x = cvt_pk_bf16(v0[0], v0[1]); w.y = cvt_pk_bf16(v0[2], v0[3]); w.z = cvt_pk_bf16(v1[0], v1[1]); w.w = cvt_pk_bf16(v1[2], v1[3]);
                    if (!fin) *(v4u*)(msd + cidx) = w;
                    else *(v4u*)(MG + row * DM + col) = w; }
            asm volatile("" ::: "memory");
        }
        if (uf == 2) {
            asm volatile("s_waitcnt vmcnt(0)" ::: "memory");
            __builtin_amdgcn_s_barrier();
            if (tidl == 0) {
                unsigned* cw = (unsigned*)(ws + WS_CTL) + CW_MFLAG;
                const unsigned hx = __hip_atomic_load(cw + n1 + jt, __ATOMIC_RELAXED, __HIP_MEMORY_SCOPE_AGENT) & 15u, hcnt = __hip_atomic_load(cw + 384 + hx, __ATOMIC_RELAXED, __HIP_MEMORY_SCOPE_AGENT);
                unsigned* done = cw + 400 + l * 16 + hx; unsigned* xflag = cw + 528 + l * 16 + hx;
                const unsigned old = __hip_atomic_fetch_add(done, 1u, __ATOMIC_RELAXED, __HIP_MEMORY_SCOPE_AGENT);
                if (old + 1u == hcnt) { __builtin_amdgcn_fence(__ATOMIC_RELEASE, "agent"); asm volatile("s_waitcnt vmcnt(0)" ::: "memory"); __hip_atomic_store(xflag, 1u, __ATOMIC_RELAXED, __HIP_MEMORY_SCOPE_AGENT); }
            }
        }
        if (uf == 1) {
            if (tidl == 0) { unsigned* cw = (unsigned*)(ws + WS_CTL) + CW_MFLAG; const unsigned hx = __hip_atomic_load(cw + n1 + jt, __ATOMIC_RELAXED, __HIP_MEMORY_SCOPE_AGENT) & 15u; unsigned* xflag = cw + 528 + l * 16 + hx;
                unsigned sp = 0u; while (__hip_atomic_load(xflag, __ATOMIC_RELAXED, __HIP_MEMORY_SCOPE_AGENT) == 0u) { __builtin_amdgcn_s_sleep(2); if (++sp > (1u << 26)) break; }
                __builtin_amdgcn_fence(__ATOMIC_ACQUIRE, "agent"); }
            asm volatile("s_waitcnt vmcnt(0) lgkmcnt(0)" ::: "memory");
            __builtin_amdgcn_s_barrier();
#pragma unroll
            for (int ai = 0; ai < 2; ++ai) {
                v4u mw[4][2], hw[4][2];
#pragma unroll
                for (int m = 0; m < 4; ++m)
#pragma unroll
                    for (int bj = 0; bj < 2; ++bj) { const size_t cidx = (size_t)(((ai * 4 + m) * 2 + bj) * 512 + tidl) * 8; mw[m][bj] = *(const v4u*)(mst + cidx); hw[m][bj] = *(const v4u*)(MS2 + cidx); }
#pragma unroll
                for (int m = 0; m < 4; ++m)
#pragma unroll
                    for (int bj = 0; bj < 2; ++bj) { const size_t row = (size_t)(row0 + ai * 128 + m * 16); const int col = col0 + bj * 128; const v4u q = mw[m][bj], h = hw[m][bj];
                        v4u w; w.x = cvt_pk_bf16(bflo(q.x) + bflo(h.x), bfhi(q.x) + bfhi(h.x)); w.y = cvt_pk_bf16(bflo(q.y) + bflo(h.y), bfhi(q.y) + bfhi(h.y));
                        w.z = cvt_pk_bf16(bflo(q.z) + bflo(h.z), bfhi(q.z) + bfhi(h.z)); w.w = cvt_pk_bf16(bflo(q.w) + bflo(h.w), bfhi(q.w) + bfhi(h.w));
                        *(v4u*)(MG + row * DM + col) = w; }
                asm volatile("" ::: "memory");
            }
        }
    }
};
struct EpiInProj {
    static constexpr bool PERM = true; static constexpr int NSTORE = 0;
    unsigned char* PA; float* outK; float* outV; const f32x2* rope; int l; LAS unsigned char* ts;
    __device__ __forceinline__ void operator()(const f32x4 (&acc)[2][2][4][2], const Unit& u, int wr, int wc, int fr, int fq) const {
        const int pn = u.pn;
        const int rl0 = wr * 64 + fr;
        const int cl = wc * 32 + 8 * fq;
        if (pn >= 16 && pn < 20) {
            const bool isq = pn < 18; const int hp = (pn - 16) & 1;
            bf16* G = (bf16*)(PA + (isq ? PA_GQ : PA_GK));
            const float qs = isq ? 0.08838834764831845f : 1.0f;
            const int head = 2 * hp + (wc >> 1), axis = wc & 1, j0 = 8 * fq;
            const bool lat = u.pm >= 16;
#pragma unroll
            for (int ai = 0; ai < 2; ++ai)
#pragma unroll
                for (int m = 0; m < 4; ++m) {
                    const int row = u.pm * 256 + rl0 + ai * 128 + m * 16;
                    float o1[8], o2[8];
                    int pos = 0;
                    if (lat) { const int t = (row - MCTX) & 2047; pos = axis ? (t & 63) : (t >> 6); }
#pragma unroll
                    for (int n = 0; n < 2; ++n)
#pragma unroll
                        for (int i = 0; i < 4; ++i) {
                            const float x1 = acc[ai][0][m][n][i], x2 = acc[ai][1][m][n][i];
                            float c = 1.f, s = 0.f;
                            if (lat) { const f32x2 cs = rope[pos * 32 + j0 + 4 * n + i]; c = cs.x; s = cs.y; }
                            o1[n * 4 + i] = (x1 * c - x2 * s) * qs; o2[n * 4 + i] = (x2 * c + x1 * s) * qs;
                        }
                    bf16* p1 = G + (size_t)row * 512 + head * 128 + axis * 64 + j0;
                    v4u w; w.x = cvt_pk_bf16(o1[0], o1[1]); w.y = cvt_pk_bf16(o1[2], o1[3]); w.z = cvt_pk_bf16(o1[4], o1[5]); w.w = cvt_pk_bf16(o1[6], o1[7]);
                    *(v4u*)p1 = w;
                    w.x = cvt_pk_bf16(o2[0], o2[1]); w.y = cvt_pk_bf16(o2[2], o2[3]); w.z = cvt_pk_bf16(o2[4], o2[5]); w.w = cvt_pk_bf16(o2[6], o2[7]);
                    *(v4u*)(p1 + 32) = w;
                    asm volatile("" ::: "memory");
                }
            return;
        }
        if (pn == 52) {
            if (wc == 0) {
                float* GZ = (float*)(PA + PA_GZ);
#pragma unroll
                for (int ai = 0; ai < 2; ++ai)
#pragma unroll
                    for (int m = 0; m < 4; ++m) { float* rowp = GZ + (size_t)(u.pm * 256 + rl0 + ai * 128 + m * 16) * 32 + 8 * fq;
                        *(f32x4*)rowp = acc[ai][0][m][0]; *(f32x4*)(rowp + 4) = acc[ai][0][m][1]; }
            }
            return;
        }
        const size_t rowb = (size_t)u.pm * 256 + rl0;
#define IP_LOOP(...) do { _Pragma("unroll") for (int ai = 0; ai < 2; ++ai) _Pragma("unroll") for (int m = 0; m < 4; ++m) { const int rl = rl0 + ai * 128 + m * 16; const size_t row = rowb + ai * 128 + m * 16; (void)rl; \
            _Pragma("unroll") for (int bj = 0; bj < 2; ++bj) { f32x4 v0 = acc[ai][bj][m][0], v1 = acc[ai][bj][m][1]; __VA_ARGS__ } asm volatile("" ::: "memory"); } } while (0)
#define IP_PACK_STORE(ptr) do { v4u w_; w_.x = cvt_pk_bf16(v0[0], v0[1]); w_.y = cvt_pk_bf16(v0[2], v0[3]); w_.z = cvt_pk_bf16(v1[0], v1[1]); w_.w = cvt_pk_bf16(v1[2], v1[3]); __builtin_nontemporal_store(w_, (v4u*)(ptr)); } while (0)
#define IP_F32_COPY(fout, tcol_) do { float* fp_ = (fout) + ((((size_t)u.pm * 2 + l) * 8 + ((tcol_) >> 7) + bj) * 256 + rl) * 128 + cl; __builtin_nontemporal_store(v0, (f32x4*)fp_); __builtin_nontemporal_store(v1, (f32x4*)(fp_ + 4)); } while (0)
#define IP_TRANS_STORE(O_, tcol_) do { bf16* tp_ = (O_) + (size_t)((tcol_) + bj * 128 + cl) * MTOK + row; const unsigned p0_ = cvt_pk_bf16(v0[0], v0[1]), p1_ = cvt_pk_bf16(v0[2], v0[3]), p2_ = cvt_pk_bf16(v1[0], v1[1]), p3_ = cvt_pk_bf16(v1[2], v1[3]); \
            tp_[0] = (bf16)p0_; tp_[(size_t)MTOK] = (bf16)(p0_ >> 16); tp_[(size_t)2 * MTOK] = (bf16)p1_; tp_[(size_t)3 * MTOK] = (bf16)(p1_ >> 16); \
            tp_[(size_t)4 * MTOK] = (bf16)p2_; tp_[(size_t)5 * MTOK] = (bf16)(p2_ >> 16); tp_[(size_t)6 * MTOK] = (bf16)p3_; tp_[(size_t)7 * MTOK] = (bf16)(p3_ >> 16); } while (0)
#define IP_TRANSPOSE(KIND, ...) do { LAS bf16* T_ = (LAS bf16*)(ts + (wr * 4 + wc) * TS_WAVE); const int ln_ = fq * 16 + fr; \
            _Pragma("unroll") for (int ai = 0; ai < 2; ++ai) _Pragma("unroll") for (int bj = 0; bj < 2; ++bj) _Pragma("unroll") for (int mp = 0; mp < 2; ++mp) { \
                _Pragma("unroll") for (int ml = 0; ml < 2; ++ml) { const f32x4 v0 = acc[ai][bj][2 * mp + ml][0], v1 = acc[ai][bj][2 * mp + ml][1]; \
                    const unsigned p0_ = cvt_pk_bf16(v0[0], v0[1]), p1_ = cvt_pk_bf16(v0[2], v0[3]), p2_ = cvt_pk_bf16(v1[0], v1[1]), p3_ = cvt_pk_bf16(v1[2], v1[3]); \
                    LAS bf16* d_ = T_ + (8 * fq) * 40 + fq * 16 + ((KIND) == 0 ? ml * 16 + fr : (fr >> 2) * 8 + ml * 4 + (fr & 3)); \
                    d_[0] = (bf16)p0_; d_[40] = (bf16)(p0_ >> 16); d_[80] = (bf16)p1_; d_[120] = (bf16)(p1_ >> 16); d_[160] = (bf16)p2_; d_[200] = (bf16)(p2_ >> 16); d_[240] = (bf16)p3_; d_[280] = (bf16)(p3_ >> 16); } \
                _Pragma("unroll") for (int h_ = 0; h_ < 2; ++h_) { const int q_ = ln_ + 64 * h_, c_ = q_ >> 2, k_ = q_ & 3; const v4u w_ = *(const LAS v4u*)(T_ + c_ * 40 + (c_ >> 3) * 16 + 8 * k_); __VA_ARGS__ } \
                asm volatile("" ::: "memory"); } } while (0)
        if (pn < 8) {
            bf16* O = (bf16*)(PA + (pn < 4 ? PA_U : PA_NQ)); const int tcol = (pn & 3) * 256; const float scl = pn < 4 ? 1.0f : 0.08838834764831845f * 1.4426950408889634f;
            IP_LOOP({ v0 *= scl; v1 *= scl; IP_PACK_STORE(O + row * 1024 + tcol + bj * 128 + cl); });
        } else if (pn < 12) {
            bf16* O = (bf16*)(PA + PA_NK); const int tcol = (pn - 8) * 256;
            if (u.pm < 16) IP_LOOP({ IP_F32_COPY(outK, tcol); IP_PACK_STORE(O + row * 1024 + tcol + bj * 128 + cl); });
            else IP_LOOP({ IP_PACK_STORE(O + row * 1024 + tcol + bj * 128 + cl); });
        } else if (pn < 16) {
            bf16* O = (bf16*)(PA + PA_NV); const int tcol = (pn - 12) * 256;
            if (u.pm < 16) IP_LOOP({ IP_F32_COPY(outV, tcol); });
            IP_TRANSPOSE(0, { *(v4u*)(O + (size_t)(tcol + bj * 128 + wc * 32 + c_) * MTOK + ((size_t)u.pm * 256 + ai * 128 + wr * 64 + 32 * mp + 8 * k_)) = w_; });
        } else if (pn < 24) {
            bf16* O = (bf16*)(PA + PA_GV); const int tcol = (pn - 20) * 256;
            IP_TRANSPOSE(1, { const int e_ = tcol + bj * 128 + wc * 32 + c_, chunk_ = u.pm * 4 + ai * 2 + wr;
                *(v4u*)((unsigned char*)O + ((size_t)chunk_ * 64 + (e_ >> 4)) * 2048 + (size_t)((k_ * 16 + (e_ & 15)) * 32) + mp * 16) = w_; });
        } else if (pn < 28) {
            bf16* O = (bf16*)(PA + PA_GR); const int tcol = (pn - 24) * 256;
            IP_LOOP({ v0 = v0 * sigmoid4(v0); v1 = v1 * sigmoid4(v1); IP_PACK_STORE(O + row * 1024 + tcol + bj * 128 + cl); });
        } else {
            bf16* O = (bf16*)(PA + PA_GL) + ((size_t)u.pm * 24 + (pn - 28)) * 65536 + (size_t)((wr * 4 + wc) * 64 + fq * 16 + fr) * 8;
            IP_LOOP({ v0 = sigmoid4(v0); v1 = sigmoid4(v1); IP_PACK_STORE(O + (size_t)(((ai * 4 + m) * 2 + bj) * 512) * 8); });
        }
#undef IP_TRANSPOSE
#undef IP_LOOP
#undef IP_PACK_STORE
#undef IP_F32_COPY
#undef IP_TRANS_STORE
    }
};

template <int CTRL> __device__ __forceinline__ float dpp_mov(float v) { return __builtin_bit_cast(float, __builtin_amdgcn_update_dpp(0, __builtin_bit_cast(int, v), CTRL, 0xf, 0xf, false)); }
__device__ __forceinline__ float rdlane(float v, int l) { return __builtin_bit_cast(float, __builtin_amdgcn_readlane(__builtin_bit_cast(int, v), l)); }
__device__ __forceinline__ float row16_sum(float v) {
    v += dpp_mov<0xB1>(v); v += dpp_mov<0x4E>(v); v += dpp_mov<0x141>(v); v += dpp_mov<0x140>(v); return v; }
__device__ __forceinline__ float row16_max(float v) {
    v = fmaxf(v, dpp_mov<0xB1>(v)); v = fmaxf(v, dpp_mov<0x4E>(v)); v = fmaxf(v, dpp_mov<0x141>(v)); v = fmaxf(v, dpp_mov<0x140>(v)); return v; }
__device__ __forceinline__ float wave_sum(float v) { v = row16_sum(v); return (rdlane(v, 0) + rdlane(v, 16)) + (rdlane(v, 32) + rdlane(v, 48)); }
__device__ __forceinline__ float wave_max(float v) { v = row16_max(v); return fmaxf(fmaxf(rdlane(v, 0), rdlane(v, 16)), fmaxf(rdlane(v, 32), rdlane(v, 48))); }
__device__ __forceinline__ void p0_transpose_item(const float* W, int K, int N, bf16* WT, int dst_row0, LAS float* scr, int kb, int nb, int lane) {
    const int k0 = 64 * kb, n0 = 32 * nb;
#pragma unroll 8
    for (int i = 0; i < 32; ++i) { const int kk = 2 * i + (lane >> 5); scr[kk * 33 + (lane & 31)] = W[(size_t)(k0 + kk) * N + n0 + (lane & 31)]; }
    LDS_WAIT(); asm volatile("" ::: "memory");
    const int c = lane & 7;
#pragma unroll
    for (int j = 0; j < 4; ++j) { const int n = (lane >> 3) + 8 * j; const LAS float* s = scr + (8 * c) * 33 + n;
        v4u o; o.x = pk2(s[0 * 33], s[1 * 33]); o.y = pk2(s[2 * 33], s[3 * 33]); o.z = pk2(s[4 * 33], s[5 * 33]); o.w = pk2(s[6 * 33], s[7 * 33]);
        *(GAS v4u*)(WT + (size_t)(dst_row0 + n) * K + k0 + 8 * c) = o; }
    LDS_WAIT(); asm volatile("" ::: "memory");
}
__device__ __forceinline__ int win_dst(int n0) {
    if (n0 < 4096) return n0;
    if (n0 < 5120) { const int base = n0 < 4608 ? 4096 : 4608, dd = n0 - base, hh = dd >> 7, w = dd & 127, axis = w >> 6, half = (w >> 5) & 1;
        return base + 256 * (hh >> 1) + 128 * half + (hh & 1) * 64 + axis * 32; }
    if (n0 < 6144) return n0;
    if (n0 < 6176) return 13312;
    return n0 - 32;
}

struct Args { const float* in[22]; float* out; unsigned char* ws; int ph_lo, ph_hi, li, pad; };
#define AS4 __attribute__((address_space(4)))
typedef const AS4 unsigned char* kargp;
#define KARG ((kargp)__builtin_amdgcn_kernarg_segment_ptr())
__device__ __forceinline__ const float* arg_in(kargp ka, int i) { return *(const float* const AS4*)(ka + 8 * i); }
__device__ __forceinline__ float* arg_out(kargp ka) { return *(float* const AS4*)(ka + 176); }
__device__ __forceinline__ unsigned char* arg_ws(kargp ka) { return *(unsigned char* const AS4*)(ka + 184); }
__device__ __forceinline__ int arg_i(kargp ka, int off) { return *(const int AS4*)(ka + off); }

template <bool FIRST, bool LAST>
__device__ __forceinline__ void norm_rows(kargp ka, int gw, int NGW, int lane, const bf16* Y, const float* post, int li, int gi, float resw, const float* pre, int ln, int gn, int row_lo, int row_hi) {
    const float* MOD = (const float*)(arg_ws(ka) + WS_MOD);
    bf16* H = (bf16*)(arg_ws(ka) + WS_H);
    const int R = (row_hi - row_lo + NGW - 1) / NGW, r0 = row_lo + gw * R, r1 = r0 + R < row_hi ? r0 + R : row_hi;
    int vcur = -1;
    f32x4 cg[8], cb[8], cs[8];
#pragma unroll
    for (int j = 0; j < 8; ++j) { cg[j] = (f32x4){0.f, 0.f, 0.f, 0.f}; cb[j] = cg[j]; cs[j] = cg[j]; }
    for (int row = r0; row < r1; ++row) {
        const int v = row < MCTX ? 0 : 1 + ((row - MCTX) >> 11);
        const float* xin = FIRST ? (row < MCTX ? arg_in(ka, 0) + (size_t)row * DM : arg_in(ka, 1) + (size_t)(row - MCTX) * DM) : arg_out(ka) + (size_t)row * DM;
        const f32x4* xr = (const f32x4*)xin + lane;
        f32x4 x[8]; v2u yw[8];
#pragma unroll
        for (int j = 0; j < 8; ++j) x[j] = xr[64 * j];
        if (!FIRST) { const v2u* y0 = (const v2u*)(Y + (size_t)row * DM) + lane;
#pragma unroll
            for (int j = 0; j < 8; ++j) yw[j] = y0[64 * j]; }
        if (v != vcur) {
            vcur = v;
            if (!FIRST) { const f32x4* pg = (const f32x4*)post + lane; const f32x4* gt = (const f32x4*)(MOD + (size_t)((v * 2 + li) * NMOD + 3 * gi + 2) * DM) + lane;
#pragma unroll
                for (int j = 0; j < 8; ++j) cg[j] = (gt[64 * j] * resw) * pg[64 * j]; }
            if (!LAST) { const f32x4* pg = (const f32x4*)pre + lane;
                const f32x4* sh = (const f32x4*)(MOD + (size_t)((v * 2 + ln) * NMOD + 3 * gn + 0) * DM) + lane;
                const f32x4* sc = (const f32x4*)(MOD + (size_t)((v * 2 + ln) * NMOD + 3 * gn + 1) * DM) + lane;
#pragma unroll
                for (int j = 0; j < 8; ++j) { cb[j] = pg[64 * j] * (sc[64 * j] + 1.0f); cs[j] = sh[64 * j]; } }
        }
        if (!FIRST) {
            float ss = 0.f;
#pragma unroll
            for (int j = 0; j < 8; ++j) { const v2u a = yw[j]; const float y0f = bflo(a.x), y1f = bfhi(a.x), y2f = bflo(a.y), y3f = bfhi(a.y);
                ss += (y0f * y0f + y1f * y1f) + (y2f * y2f + y3f * y3f); }
            const float rstd = 1.0f / sqrtf(wave_sum(ss) * (1.f / DM) + EPS);
#pragma unroll
            for (int j = 0; j < 8; ++j) { const v2u a = yw[j]; f32x4 yj; yj.x = bflo(a.x); yj.y = bfhi(a.x); yj.z = bflo(a.y); yj.w = bfhi(a.y);
                x[j] = x[j] + cg[j] * (yj * rstd); }
        }
        f32x4* xo = (f32x4*)(arg_out(ka) + (size_t)row * DM) + lane;
#pragma unroll
        for (int j = 0; j < 8; ++j) xo[64 * j] = x[j];
        if (!LAST) {
            float ss = 0.f;
#pragma unroll
            for (int j = 0; j < 8; ++j) ss += (x[j].x * x[j].x + x[j].y * x[j].y) + (x[j].z * x[j].z + x[j].w * x[j].w);
            const float rstd = 1.0f / sqrtf(wave_sum(ss) * (1.f / DM) + EPS);
            v2u* ho = (v2u*)(H + (size_t)row * DM) + lane;
#pragma unroll
            for (int j = 0; j < 8; ++j) { const f32x4 h = (x[j] * rstd) * cb[j] + cs[j];
                v2u w; w.x = cvt_pk_bf16(h.x, h.y); w.y = cvt_pk_bf16(h.z, h.w); ho[64 * j] = w; }
        }
    }
}

typedef short bf16x8v __attribute__((ext_vector_type(8)));
__device__ __forceinline__ float swz16(float v) { return __builtin_bit_cast(float, __builtin_amdgcn_ds_swizzle(__builtin_bit_cast(int, v), 0x401F)); }
__device__ __forceinline__ void pl32swap(unsigned& a, unsigned& b) { asm volatile("s_nop 1\n\tv_permlane32_swap_b32 %0, %1" : "+v"(a), "+v"(b)); }
__device__ __forceinline__ float xmax32(float v) { unsigned a = __builtin_bit_cast(unsigned, v), b = a; pl32swap(a, b); return fmaxf(__builtin_bit_cast(float, a), __builtin_bit_cast(float, b)); }
__device__ __forceinline__ float xsum32(float v) { unsigned a = __builtin_bit_cast(unsigned, v), b = a; pl32swap(a, b); return __builtin_bit_cast(float, a) + __builtin_bit_cast(float, b); }
template <int NQT, bool LATENT>
__device__ __forceinline__ void attn_block(LAS unsigned char* lds, int wave, int lane, const bf16* NQ, const float* rpbh, bf16* BR1,
                                           int q0, int h, int rs, int r, int ct0, int qc0, int Rlo, int nloc,
                                           const char* lksrc, const char* lvsrc  ,
                                           const char* ksrc, unsigned krs, const char* vsrc, unsigned vrs, int nshared) {
    asm volatile("" : "+v"(lane));
    const int fr = lane & 15, g = lane >> 4;
    const int nstage = nloc + nshared;
#define AT_DMA(bufi, st_) do { int ln_ = lane; asm volatile("" : "+v"(ln_));   \
        const bool lc_ = (st_) < nloc; const int si_ = lc_ ? (st_) : (st_) - nloc; const bool kw_ = wave < 4; \
        const unsigned strd_ = kw_ ? (lc_ ? 2048u : krs) : (lc_ ? (unsigned)(MTOK * 2) : vrs); \
        const char* sb_ = kw_ ? (lc_ ? lksrc + (size_t)si_ * 128u * 2048u : ksrc + (size_t)si_ * 128u * krs) : (lc_ ? lvsrc : vsrc) + (size_t)si_ * 256u; \
        const char* lb_ = sb_ + (size_t)(32 * (wave & 3) + (ln_ >> 4)) * strd_; \
        _Pragma("unroll") for (int j_ = 0; j_ < 8; ++j_) { const int c_ = (ln_ & 15) ^ ((4 * j_ + (ln_ >> 4)) & 15); \
        __builtin_amdgcn_global_load_lds((const unsigned*)(lb_ + (size_t)(4 * j_) * strd_ + c_ * 16), (LAS unsigned*)(lds + (bufi) * 65536 + (wave * 8 + j_) * 1024), 16, 0, 0); } } while (0)
    AT_DMA(0, 0);
    if (nstage > 1) AT_DMA(1, 1);
    LAS float* rpbl = (LAS float*)(lds + TS_OFF);
    if (LATENT) { for (int e = wave * 64 + lane; e < 465; e += NTHR) rpbl[e] = rpbh[e] * 1.4426950408889634f; asm volatile("s_waitcnt lgkmcnt(0)" ::: "memory"); }
    bf16x8v Qf[NQT][4];
#pragma unroll
    for (int qt = 0; qt < NQT; ++qt)
#pragma unroll
        for (int kk = 0; kk < 4; ++kk) Qf[qt][kk] = *(const bf16x8v*)(NQ + (size_t)(q0 + qt * 16 + fr) * 1024 + h * 128 + kk * 32 + g * 8);
    f32x4 O[NQT][8]; float m[NQT], lsum[NQT];
#pragma unroll
    for (int qt = 0; qt < NQT; ++qt) { m[qt] = -1e30f; lsum[qt] = 0.f;
#pragma unroll
        for (int d = 0; d < 8; ++d) O[qt][d] = (f32x4){0.f, 0.f, 0.f, 0.f}; }
#define AT_STEP(MASKED, ka0_, kb0_, ria, cta, rib, ctb, bok_) do { \
        f32x4 sa[NQT], sb[NQT]; \
        _Pragma("unroll") for (int qt = 0; qt < NQT; ++qt) { sa[qt] = (f32x4){0.f, 0.f, 0.f, 0.f}; sb[qt] = (f32x4){0.f, 0.f, 0.f, 0.f}; } \
        _Pragma("unroll") for (int kk = 0; kk < 4; ++kk) { const int ra = (ka0_) + fr, rb = (kb0_) + fr; \
            const bf16x8v Ka = *(const LAS bf16x8v*)(Kimg + ra * 256 + (((kk * 4 + g) ^ (ra & 15)) * 16)), Kb = *(const LAS bf16x8v*)(Kimg + rb * 256 + (((kk * 4 + g) ^ (rb & 15)) * 16)); \
            __builtin_amdgcn_s_setprio(1); _Pragma("unroll") for (int qt = 0; qt < NQT; ++qt) { sa[qt] = __builtin_amdgcn_mfma_f32_16x16x32_bf16(Ka, Qf[qt][kk], sa[qt], 0, 0, 0); sb[qt] = __builtin_amdgcn_mfma_f32_16x16x32_bf16(Kb, Qf[qt][kk], sb[qt], 0, 0, 0); } __builtin_amdgcn_s_setprio(0); } \
        bf16x8v P[NQT]; \
        _Pragma("unroll") for (int qt = 0; qt < NQT; ++qt) { \
            bool va[4] = {true, true, true, true}, vb[4] = {true, true, true, true}; \
            if (MASKED) { \
                const int c = qc0 + qt * 16 + fr; int cs = c - 8; cs = cs < 0 ? 0 : (cs > 48 ? 48 : cs); \
                _Pragma("unroll") for (int i = 0; i < 4; ++i) { \
                    const int kca = (cta) * 16 + 4 * g + i, kcb = (ctb) * 16 + 4 * g + i; \
                    va[i] = (kca >= cs) && (kca < cs + 16); vb[i] = (bok_) && (kcb >= cs) && (kcb < cs + 16); \
                    const float ba = va[i] ? rpbl[((ria) - r + 7) * 31 + (kca - c + 15)] : 0.f; \
                    const float bb = vb[i] ? rpbl[((rib) - r + 7) * 31 + (kcb - c + 15)] : 0.f; \
                    sa[qt][i] = va[i] ? sa[qt][i] + ba : -1e30f; sb[qt][i] = vb[i] ? sb[qt][i] + bb : -1e30f; } } \
            float mx = fmaxf(fmaxf(fmaxf(sa[qt][0], sa[qt][1]), fmaxf(sa[qt][2], sa[qt][3])), fmaxf(fmaxf(sb[qt][0], sb[qt][1]), fmaxf(sb[qt][2], sb[qt][3]))); \
            mx = fmaxf(mx, swz16(mx)); mx = xmax32(mx); \
            const float mn = fmaxf(m[qt], mx), alpha = __builtin_amdgcn_exp2f(fmaxf(m[qt] - mn, -200.f)); m[qt] = mn; \
            float pa[4], pb[4], ps = 0.f;     \
            _Pragma("unroll") for (int i = 0; i < 4; ++i) { pa[i] = va[i] ? __builtin_amdgcn_exp2f(fmaxf(sa[qt][i] - mn, -200.f)) : 0.f; pb[i] = vb[i] ? __builtin_amdgcn_exp2f(fmaxf(sb[qt][i] - mn, -200.f)) : 0.f; ps += pa[i] + pb[i]; } \
            lsum[qt] = lsum[qt] * alpha + ps; \
            _Pragma("unroll") for (int d = 0; d < 8; ++d) O[qt][d] *= alpha; \
            v4u pw; pw.x = cvt_pk_bf16(pa[0], pa[1]); pw.y = cvt_pk_bf16(pa[2], pa[3]); pw.z = cvt_pk_bf16(pb[0], pb[1]); pw.w = cvt_pk_bf16(pb[2], pb[3]); \
            P[qt] = __builtin_bit_cast(bf16x8v, pw); } \
        _Pragma("unroll") for (int d = 0; d < 8; ++d) { const int rv = 16 * d + fr; \
            const v2u Va = *(const LAS v2u*)(Vimg + rv * 256 + (((((ka0_) >> 3) + (g >> 1)) ^ (rv & 15)) * 16) + 8 * (g & 1)); \
            const v2u Vb = *(const LAS v2u*)(Vimg + rv * 256 + (((((kb0_) >> 3) + (g >> 1)) ^ (rv & 15)) * 16) + 8 * (g & 1)); \
            v4u vw; vw.x = Va.x; vw.y = Va.y; vw.z = Vb.x; vw.w = Vb.y; const bf16x8v Vf = __builtin_bit_cast(bf16x8v, vw); \
            __builtin_amdgcn_s_setprio(1); _Pragma("unroll") for (int qt = 0; qt < NQT; ++qt) O[qt][d] = __builtin_amdgcn_mfma_f32_16x16x32_bf16(Vf, P[qt], O[qt][d], 0, 0, 0); __builtin_amdgcn_s_setprio(0); } } while (0)
    for (int sg = 0; sg < nstage; ++sg) {
        asm volatile("s_waitcnt vmcnt(0)" ::: "memory");
        __builtin_amdgcn_s_barrier();
        const LAS unsigned char* Kimg = lds + (sg & 1) * 65536; const LAS unsigned char* Vimg = Kimg + 32768;
        if (LATENT && sg < nloc) {
            const int R0 = Rlo + 2 * sg; const bool act0 = (R0 >= rs) && (R0 <= rs + 7), act1 = (R0 + 1 >= rs) && (R0 + 1 <= rs + 7);
            const int nt = 3 * ((act0 ? 1 : 0) + (act1 ? 1 : 0)), rsel1 = act0 ? 0 : 1;
#pragma unroll 1
            for (int k = 0; k < nt; k += 2) {
                const int ka = k, kb = (k + 1 < nt) ? k + 1 : k;
                const int rowa = (act0 && act1) ? ka / 3 : rsel1, cta = ct0 + ((act0 && act1) ? ka % 3 : ka);
                const int rowb = (act0 && act1) ? kb / 3 : rsel1, ctb = ct0 + ((act0 && act1) ? kb % 3 : kb);
                const bool bok = k + 1 < nt;
                AT_STEP(true, rowa * 64 + cta * 16, rowb * 64 + ctb * 16, R0 + rowa, cta, R0 + rowb, ctb, bok);
            }
        } else {
#pragma unroll 1
            for (int j = 0; j < 4; ++j) AT_STEP(false, 32 * j, 32 * j + 16, 0, 0, 0, 0, true);
        }
        asm volatile("s_waitcnt lgkmcnt(0)" ::: "memory");
        __builtin_amdgcn_s_barrier();
        if (sg + 2 < nstage) AT_DMA(sg & 1, sg + 2);
    }
#undef AT_STEP
#undef AT_DMA
#pragma unroll
    for (int qt = 0; qt < NQT; ++qt) {
        float lt = lsum[qt]; lt += swz16(lt); lt = xsum32(lt);
        const float iv = 1.0f / lt;
        bf16* op = BR1 + (size_t)(q0 + qt * 16 + fr) * 1024 + h * 128 + 4 * g;
#pragma unroll
        for (int d = 0; d < 8; ++d) { v2u w; w.x = cvt_pk_bf16(O[qt][d][0] * iv, O[qt][d][1] * iv); w.y = cvt_pk_bf16(O[qt][d][2] * iv, O[qt][d][3] * iv); *(v2u*)(op + d * 16) = w; }
    }
}

template <int DIR>
__device__ __forceinline__ void gla_g1_item(LAS float* zs, LAS float* xch, int tid, int blk, const float* wg, const float* bg, const bf16* GQ, const bf16* GK, bf16* QI, bf16* KI, bf16* KDT, float* DEC) {
    const int tok0 = blk * 64, half = tid >> 8, c0 = 2 * (tid & 255);
    f32x2 wv[16];
#pragma unroll
    for (int r = 0; r < 16; ++r) wv[r] = *(const f32x2*)(wg + r * 512 + c0);
    const f32x2 bgv = *(const f32x2*)(bg + c0);
    f32x2 b[32];
#pragma unroll
    for (int p = 0; p < 32; ++p) {
        const LAS f32x4* zp = (const LAS f32x4*)(zs + (half * 32 + p) * 16);
        f32x2 lg = bgv;
#pragma unroll
        for (int r4 = 0; r4 < 4; ++r4) { const f32x4 z = zp[r4]; lg += z.x * wv[4 * r4]; lg += z.y * wv[4 * r4 + 1]; lg += z.z * wv[4 * r4 + 2]; lg += z.w * wv[4 * r4 + 3]; }
        b[p].x = (fminf(lg.x, 0.f) - __builtin_amdgcn_logf(1.f + __expf(-fabsf(lg.x))) * 0.6931471805599453f) * (1.0f / 16.0f);
        b[p].y = (fminf(lg.y, 0.f) - __builtin_amdgcn_logf(1.f + __expf(-fabsf(lg.y))) * 0.6931471805599453f) * (1.0f / 16.0f);
    }
    if (DIR == 0) {
#pragma unroll
        for (int p = 1; p < 32; ++p) b[p] += b[p - 1];
    } else {
#pragma unroll
        for (int p = 30; p >= 0; --p) b[p] += b[p + 1];
    }
    const f32x2 T = DIR == 0 ? b[31] : b[0];
    *(LAS f32x2*)(xch + half * 512 + c0) = T;
    __syncthreads();
    const f32x2 To = *(const LAS f32x2*)(xch + (half ^ 1) * 512 + c0);
    const bool addo = DIR == 0 ? (half == 1) : (half == 0);
    const f32x2 off = addo ? To : (f32x2){0.f, 0.f};
    const f32x2 bend = T + To;
    f32x2 ebend; ebend.x = __expf(bend.x); ebend.y = __expf(bend.y);
    if (half == 0) *(f32x2*)(DEC + (size_t)blk * 512 + c0) = ebend;
    int c2 = c0; asm volatile("" : "+v"(c2));
    const size_t rb = (size_t)(tok0 + half * 32) * 512 + c2;
    const bf16* gq = GQ + rb; const bf16* gk = GK + rb; bf16* qi = QI + rb; bf16* ki = KI + rb;
    unsigned char* kdrec = (unsigned char*)KDT + ((size_t)(blk * 4 + (c2 >> 7)) * 8 + ((c2 & 127) >> 4)) * 2048 + (size_t)(c2 & 15) * 32 + half * 16;
    unsigned qw[32], kw[32];
#pragma unroll
    for (int p = 0; p < 32; ++p) { qw[p] = *(const unsigned*)(gq + (size_t)p * 512); kw[p] = *(const unsigned*)(gk + (size_t)p * 512); }
#pragma unroll
    for (int g = 0; g < 4; ++g) {
        unsigned r0[4], r1[4];
#pragma unroll
        for (int jj = 0; jj < 2; ++jj)
#pragma unroll
            for (int i2 = 0; i2 < 2; ++i2) {
                const int p = 16 * jj + 4 * g + 2 * i2;
                const unsigned qa = qw[p], qb = qw[p + 1];
                const unsigned ka_ = kw[p], kb_ = kw[p + 1];
                const f32x2 ba = b[p] + off, bb = b[p + 1] + off;
                f32x2 ea, eb; ea.x = __expf(ba.x); ea.y = __expf(ba.y); eb.x = __expf(bb.x); eb.y = __expf(bb.y);
                f32x2 ra, rbv; ra.x = __builtin_amdgcn_rcpf(ea.x); ra.y = __builtin_amdgcn_rcpf(ea.y); rbv.x = __builtin_amdgcn_rcpf(eb.x); rbv.y = __builtin_amdgcn_rcpf(eb.y);
                f32x2 qfa, qfb, kfa, kfb; qfa.x = bflo(qa); qfa.y = bfhi(qa); qfb.x = bflo(qb); qfb.y = bfhi(qb); kfa.x = bflo(ka_); kfa.y = bfhi(ka_); kfb.x = bflo(kb_); kfb.y = bfhi(kb_);
                qfa *= ea; qfb *= eb; kfa *= ra; kfb *= rbv;
                *(unsigned*)(qi + (size_t)p * 512) = cvt_pk_bf16(qfa.x, qfa.y); *(unsigned*)(qi + (size_t)(p + 1) * 512) = cvt_pk_bf16(qfb.x, qfb.y);
                *(unsigned*)(ki + (size_t)p * 512) = cvt_pk_bf16(kfa.x, kfa.y); *(unsigned*)(ki + (size_t)(p + 1) * 512) = cvt_pk_bf16(kfb.x, kfb.y);
                kfa *= ebend; kfb *= ebend;
                r0[jj * 2 + i2] = cvt_pk_bf16(kfa.x, kfb.x); r1[jj * 2 + i2] = cvt_pk_bf16(kfa.y, kfb.y);
            }
        v4u w0, w1; w0.x = r0[0]; w0.y = r0[1]; w0.z = r0[2]; w0.w = r0[3]; w1.x = r1[0]; w1.y = r1[1]; w1.z = r1[2]; w1.w = r1[3];
        *(v4u*)(kdrec + g * 512) = w0; *(v4u*)(kdrec + g * 512 + 32) = w1;
    }
}
__device__ __forceinline__ void gld16(bf16x8v& d, const void* p) { asm volatile("global_load_dwordx4 %0, %1, off" : "=&v"(d) : "v"(p) : "memory"); }
__device__ __forceinline__ void gld8(v2u& d, const void* p) { asm volatile("global_load_dwordx2 %0, %1, off" : "=&v"(d) : "v"(p) : "memory"); }
__device__ __forceinline__ void gld4(float& d, const void* p) { asm volatile("global_load_dword %0, %1, off" : "=&v"(d) : "v"(p) : "memory"); }
template <int OFF> __device__ __forceinline__ void gld16s(bf16x8v& d, unsigned vo, const void* sb) { asm volatile("global_load_dwordx4 %0, %1, %2 offset:%3" : "=&v"(d) : "v"(vo), "s"(sb), "n"(OFF) : "memory"); }
template <int OFF> __device__ __forceinline__ void gld8s(v2u& d, unsigned vo, const void* sb) { asm volatile("global_load_dwordx2 %0, %1, %2 offset:%3" : "=&v"(d) : "v"(vo), "s"(sb), "n"(OFF) : "memory"); }
template <int OFF> __device__ __forceinline__ void gld4s(float& d, unsigned vo, const void* sb) { asm volatile("global_load_dword %0, %1, %2 offset:%3" : "=&v"(d) : "v"(vo), "s"(sb), "n"(OFF) : "memory"); }
struct G2Regs { bf16x8v Vf[2][2]; bf16x8v Kf[2][2]; float dec[2]; bf16x8v Pf[2]; };
__device__ __forceinline__ int gla_g2_unit4(kargp ka, LAS unsigned char* ldsg, int tt, int lane, int l, int u) {
    asm volatile("" : "+v"(lane));
    unsigned char* ws = arg_ws(ka);
    const bool latent = u < 256; const int uu = latent ? u : u - 256;
    const int slice = uu & 7, cj = uu >> 3, b = cj >> 3, h = (cj >> 1) & 3, dir = cj & 1;
    const int nchunk = latent ? 32 : 4, base = latent ? MCTX + b * 2048 : b * 256;
    const bf16* QI = (const bf16*)(ws + WS_QI) + (size_t)dir * MTOK * 512; const unsigned char* PT = ws + WS_PT + (size_t)dir * 192 * 32768;
    const bf16* KDT = (const bf16*)(ws + WS_KDT) + (size_t)dir * 512 * MTOK; const float* DEC = (const float*)(ws + WS_DEC) + (size_t)dir * 192 * 512;
    const bf16* GVT = (const bf16*)(ws + WS_A + PA_GV);
    float* OUT = (float*)(ws + WS_B) + (size_t)dir * MTOK * 1024;
    const int fr = lane & 15, g = lane >> 4;
    const int e0 = h * 256 + slice * 32;
    LAS unsigned char* S16 = ldsg;
    LAS unsigned char* QR = ldsg + 16384;
    f32x4 ST[2][2];
    const size_t sidx = ((((size_t)b * 2 + l) * 2 + dir) * 4 + h) * 128 * 256;
    unsigned dsrc[4];
#pragma unroll
    for (int j = 0; j < 4; ++j) { const int pcs = 4 * tt + j, r = 4 * pcs + (lane >> 4), c = (lane & 15) ^ (r & 15); dsrc[j] = (unsigned)(r * 1024 + h * 256 + c * 16); }
#define G2_DMA(bufi, tok) do { const char* qb_ = (const char*)(QI + (size_t)(tok) * 512); \
        _Pragma("unroll") for (int j_ = 0; j_ < 4; ++j_) \
            __builtin_amdgcn_global_load_lds((const unsigned*)(qb_ + dsrc[j_]), (LAS unsigned*)(QR + (bufi) * 16384 + (4 * tt + j_) * 1024), 16, 0, 0); } while (0)
    unsigned offd[2];
#pragma unroll
    for (int j = 0; j < 2; ++j) offd[j] = (unsigned)((h * 128 + (2 * tt + j) * 16 + fr) * 4);
    const unsigned offp = (unsigned)(tt * 2048 + lane * 16), offr = (unsigned)(lane * 32);
#define G2_LOADR(R, tok) do { const int ck_ = __builtin_amdgcn_readfirstlane((tok) >> 6); \
        const char* vb_ = (const char*)GVT + ((size_t)ck_ * 64 + (e0 >> 4)) * 2048; const char* kb_ = (const char*)KDT + (((size_t)ck_ * 4 + h) * 8 + 2 * tt) * 2048; \
        const char* db_ = (const char*)(DEC + (size_t)ck_ * 512); const char* pb_ = (const char*)(PT + ((size_t)ck_ * 4 + h) * 8192); \
        gld16s<0>(R.Vf[0][0], offr, vb_); gld16s<16>(R.Vf[0][1], offr, vb_); gld16s<2048>(R.Vf[1][0], offr, vb_); gld16s<2064>(R.Vf[1][1], offr, vb_); \
        gld16s<0>(R.Kf[0][0], offr, kb_); gld16s<16>(R.Kf[0][1], offr, kb_); gld16s<2048>(R.Kf[1][0], offr, kb_); gld16s<2064>(R.Kf[1][1], offr, kb_); \
        gld4s<0>(R.dec[0], offd[0], db_); gld4s<0>(R.dec[1], offd[1], db_); \
        gld16s<0>(R.Pf[0], offp, pb_); gld16s<1024>(R.Pf[1], offp, pb_); } while (0)
#define G2_TOK(c) (base + 64 * (dir ? nchunk - 1 - ((c) < nchunk ? (c) : nchunk - 1) : ((c) < nchunk ? (c) : nchunk - 1)))
#define G2_S16OFF(e_, d_) ((e_) * 256 + ((((d_) >> 3) ^ ((e_) & 15)) * 16) + ((d_) & 7) * 2)
    G2_DMA(0, G2_TOK(0));
    G2Regs R0; G2_LOADR(R0, G2_TOK(0));
    G2_DMA(1, G2_TOK(1));
    G2Regs R1; G2_LOADR(R1, G2_TOK(1));
#pragma unroll
    for (int et = 0; et < 2; ++et)
#pragma unroll
        for (int dt = 0; dt < 2; ++dt) {
            const int d = (2 * tt + dt) * 16 + fr;
            if (latent) ST[et][dt] = *(const f32x4*)(arg_in(ka, 5) + sidx + (size_t)d * 256 + slice * 32 + et * 16 + 4 * g); else ST[et][dt] = (f32x4){0.f, 0.f, 0.f, 0.f};
#pragma unroll
            for (int i = 0; i < 4; ++i) *(LAS bf16*)(S16 + G2_S16OFF(et * 16 + 4 * g + i, d)) = (bf16)f2bf(ST[et][dt][i]);
        }
    asm volatile("s_waitcnt vmcnt(0) lgkmcnt(0)" ::: "memory");
    __builtin_amdgcn_s_barrier();
#define G2_STEP(RC, RF, BC, BF, cn_) do { \
        const int tok0 = G2_TOK(cn_); \
        const LAS unsigned char* Sr = S16 + ((cn_) & 1) * 8192; LAS unsigned char* Sw = S16 + (((cn_) + 1) & 1) * 8192; \
        const LAS unsigned char* Qs = QR + (BC) * 16384; \
        G2_DMA(BF, G2_TOK((cn_) + 2)); \
        G2_LOADR(RF, G2_TOK((cn_) + 2)); \
        bf16x8v Qf[4]; \
        _Pragma("unroll") for (int kk = 0; kk < 4; ++kk) { const int r = 16 * tt + fr; Qf[kk] = *(const LAS bf16x8v*)(Qs + r * 256 + (((kk * 4 + g) ^ (r & 15)) * 16)); } \
        _Pragma("unroll") for (int et = 0; et < 2; ++et) { \
            f32x4 o = (f32x4){0.f, 0.f, 0.f, 0.f}; \
            _Pragma("unroll") for (int pr = 0; pr < 2; ++pr) o = __builtin_amdgcn_mfma_f32_16x16x32_bf16(RC.Vf[et][pr], RC.Pf[pr], o, 0, 0, 0); \
            _Pragma("unroll") for (int kk = 0; kk < 4; ++kk) { const int er = et * 16 + fr; const bf16x8v Sf = *(const LAS bf16x8v*)(Sr + er * 256 + (((kk * 4 + g) ^ (er & 15)) * 16)); \
                o = __builtin_amdgcn_mfma_f32_16x16x32_bf16(Sf, Qf[kk], o, 0, 0, 0); } \
            *(f32x4*)(OUT + (size_t)(tok0 + 16 * tt + fr) * 1024 + e0 + et * 16 + 4 * g) = o; } \
        _Pragma("unroll") for (int dt = 0; dt < 2; ++dt) { \
            const int d = (2 * tt + dt) * 16 + fr; \
            _Pragma("unroll") for (int et = 0; et < 2; ++et) { \
                ST[et][dt] *= RC.dec[dt]; \
                _Pragma("unroll") for (int hf = 0; hf < 2; ++hf) ST[et][dt] = __builtin_amdgcn_mfma_f32_16x16x32_bf16(RC.Vf[et][hf], RC.Kf[dt][hf], ST[et][dt], 0, 0, 0); \
                _Pragma("unroll") for (int i = 0; i < 4; ++i) *(LAS bf16*)(Sw + G2_S16OFF(et * 16 + 4 * g + i, d)) = (bf16)f2bf(ST[et][dt][i]); } } \
          \
        asm volatile("s_waitcnt vmcnt(18) lgkmcnt(0)" ::: "memory"); \
        __builtin_amdgcn_s_barrier(); } while (0)
    G2Regs R2;
    for (int cn = 0; cn < nchunk; cn += 3) {
        G2_STEP(R0, R2, 0, 2, cn);
        if (cn + 1 < nchunk) G2_STEP(R1, R0, 1, 0, cn + 1);
        if (cn + 2 < nchunk) G2_STEP(R2, R1, 2, 1, cn + 2);
    }
#undef G2_STEP
#undef G2_TOK
#undef G2_DMA
#undef G2_LOADR
    if (!latent) {
#pragma unroll
        for (int et = 0; et < 2; ++et)
#pragma unroll
            for (int dt = 0; dt < 2; ++dt) { const int d = (2 * tt + dt) * 16 + fr;
                *(f32x4*)(arg_out(ka) + (size_t)41943040 + sidx + (size_t)d * 256 + slice * 32 + et * 16 + 4 * g) = ST[et][dt]; }
    }
#undef G2_S16OFF
    asm volatile("s_waitcnt vmcnt(0)" ::: "memory");
    return 1 + nchunk;
}

#define PHASE_FN static __device__ __forceinline__ void
#define PH_BEGIN \
    LAS unsigned char* lds = lds_; \
    int wave = wave_, G = gridDim.x, bx = blockIdx.x; kargp ka = KARG; asm volatile("" : "+s"(wave), "+s"(G), "+s"(bx), "+s"(ka)); \
    unsigned zz_ = 0u; asm volatile("" : "+v"(zz_)); const int lane = (int)__builtin_amdgcn_mbcnt_hi(~0u, __builtin_amdgcn_mbcnt_lo(~0u, zz_)); \
    const int tid = wave * 64 + lane; const int vcu = (G % 8 == 0) ? (bx % 8) * (G / 8) + bx / 8 : bx; \
    const int gw = vcu * NWAVES + wave, NGW = G * NWAVES; unsigned char* ws = arg_ws(ka); \
    (void)lane; (void)gw; (void)NGW; (void)ws; (void)tid; (void)lds;
#define WSP(T, name, off) T* name = (T*)(ws + (off))

template<int FI0, int FI1, int FO0, int FO1, int IN0, int IN1, int BR0, int BR1, int OUT0, int OUT1, int SMALL>
__device__ __forceinline__ void cvt_run(kargp ka, unsigned char* ws, LAS float* scr, int lane, int w, int NW, int rep) {
    WSP(bf16, WFI, WS_WFI); WSP(bf16, WFO, WS_WFO); WSP(bf16, WIN, WS_WIN); WSP(bf16, WBR, WS_WBR); WSP(bf16, WOUT, WS_WOUT); WSP(bf16, WPOOL, WS_WPOOL);
    constexpr int I_FI = FI1 - FI0, I_FO = FO1 - FO0, I_IN = IN1 - IN0, I_BR = BR1 - BR0, I_OUT = OUT1 - OUT0, I_PW = SMALL ? 256 : 0, I_CV = SMALL ? 2048 : 0, NITEMS = I_FI + I_FO + I_IN + I_BR + I_OUT + I_PW + I_CV;
    for (int it = w, k_ = 0; it < NITEMS; (++k_ < rep) ? ++it : (k_ = 0, it += NW - rep + 1)) {
        int r = it;
        if (r < I_FI) { r += FI0; const int mat = r / 11008, rr = r % 11008, kb = rr / 344, nb = rr % 344, n0 = nb * 32, half = n0 / FF, j0 = n0 % FF;
            p0_transpose_item(arg_in(ka, 11) + (size_t)mat * 2048 * FF2, 2048, FF2, WFI + (size_t)mat * FF2 * 2048, 256 * (j0 >> 7) + 128 * half + (j0 & 127), scr, kb, nb, lane); continue; }
        r -= I_FI;
        if (r < I_FO) { r += FO0; const int mat = r / 5504, rr = r % 5504, kb = rr / 64, nb = rr % 64;
            p0_transpose_item(arg_in(ka, 12) + (size_t)mat * FF * 2048, FF, 2048, WFO + (size_t)mat * 2048 * FF, nb * 32, scr, kb, nb, lane); continue; }
        r -= I_FO;
        if (r < I_IN) { r += IN0; const int l = r / 13344, rr = r % 13344, kb = rr / 417, nb = rr % 417;
            p0_transpose_item(arg_in(ka, 13) + (size_t)l * 2048 * INC, 2048, INC, WIN + (size_t)l * INP * 2048, win_dst(nb * 32), scr, kb, nb, lane); continue; }
        r -= I_IN;
        if (r < I_BR) { r += BR0; const int mat = r / 1024, rr = r % 1024, kb = rr / 64, nb = rr % 64;
            p0_transpose_item(arg_in(ka, 20) + (size_t)mat * 1024 * 2048, 1024, 2048, WBR + (size_t)mat * 2048 * 1024, nb * 32, scr, kb, nb, lane); continue; }
        r -= I_BR;
        if (r < I_OUT) { r += OUT0; const int l = r / 2048, rr = r % 2048, kb = rr / 64, nb = rr % 64;
            p0_transpose_item(arg_in(ka, 21) + (size_t)l * 2048 * 2048, 2048, 2048, WOUT + (size_t)l * 2048 * 2048, nb * 32, scr, kb, nb, lane); continue; }
        if (SMALL) {
            r -= I_OUT;
            if (r < I_PW) { const int mat = r / 32, rr = r % 32, kb = rr / 8, nb = rr % 8;
                p0_transpose_item(arg_in(ka, 14) + (size_t)mat * 65536, 256, 256, WPOOL + (size_t)mat * 65536, nb * 32, scr, kb, nb, lane); continue; }
            r -= I_PW;
            { const int mat = r / 32, rr = r % 32, kb = rr / 4, nb = rr % 4;
                p0_transpose_item(arg_in(ka, 4) + (size_t)mat * 65536, 512, 128, (bf16*)(ws + WS_CVT) + (size_t)mat * 65536, nb * 32, scr, kb, nb, lane); }
        }
    }
}

__device__ __forceinline__ void mod_gemv(kargp ka, LAS unsigned char* lds, int tid, float* MOD, int it_end, int start, int stride) {
    LAS float* sc = (LAS float*)lds; LAS float* red = sc + 5 * 2048;
    for (int e = tid; e < 5 * 2048; e += NTHR) { const int v = e >> 11, k = e & 2047; const float c = v == 0 ? arg_in(ka, 6)[k] : arg_in(ka, 2)[(v - 1) * 2048 + k]; sc[e] = c / (1.f + expf(-c)); }
    __syncthreads();
    for (int it = start; it < it_end; it += stride) {
        const int l = it / 288, j0 = (it % 288) * 64, cg = tid & 15, kg = tid >> 4;
        const float* w = arg_in(ka, 7) + ((size_t)l * 2048 + kg * 64) * 18432 + j0 + cg * 4;
        f32x4 a0 = (f32x4){0.f, 0.f, 0.f, 0.f}, a1 = a0, a2 = a0, a3 = a0, a4 = a0;
#pragma unroll 16
        for (int k = 0; k < 64; ++k) { const f32x4 wv = *(const f32x4*)(w + (size_t)k * 18432); const int kk = kg * 64 + k;
            a0 += sc[kk] * wv; a1 += sc[2048 + kk] * wv; a2 += sc[4096 + kk] * wv; a3 += sc[6144 + kk] * wv; a4 += sc[8192 + kk] * wv; }
        *(LAS f32x4*)(red + (kg * 5 + 0) * 64 + cg * 4) = a0; *(LAS f32x4*)(red + (kg * 5 + 1) * 64 + cg * 4) = a1; *(LAS f32x4*)(red + (kg * 5 + 2) * 64 + cg * 4) = a2;
        *(LAS f32x4*)(red + (kg * 5 + 3) * 64 + cg * 4) = a3; *(LAS f32x4*)(red + (kg * 5 + 4) * 64 + cg * 4) = a4;
        __syncthreads();
        if (tid < 320) { const int v = tid >> 6, c2 = tid & 63; float s = 0.f;
#pragma unroll
            for (int k8 = 0; k8 < 32; ++k8) s += red[(k8 * 5 + v) * 64 + c2];
            const int j = j0 + c2; MOD[(size_t)(v * 2 + l) * 18432 + j] = s + arg_in(ka, 8)[(size_t)l * 18432 + j]; }
        __syncthreads();
    }
}

PHASE_FN ph_prologue(LAS unsigned char* lds_, int wave_) {
    PH_BEGIN
    WSP(float, MOD, WS_MOD); WSP(f32x2, ROPE, WS_ROPE); WSP(bf16, WFI, WS_WFI); WSP(bf16, WFO, WS_WFO); WSP(bf16, WIN, WS_WIN); WSP(bf16, WBR, WS_WBR); WSP(bf16, WOUT, WS_WOUT); WSP(bf16, WPOOL, WS_WPOOL);
    if (tid == 0) {
        const int r0 = 384 - G, n1_ = (r0 > 0 && 2 * r0 <= G) ? r0 : 0; const unsigned myx = xb_xcc_id() & 15u; unsigned* cw = (unsigned*)(ws + WS_CTL) + CW_MFLAG;
        if (bx < 384) __hip_atomic_store(cw + bx, myx, __ATOMIC_RELAXED, __HIP_MEMORY_SCOPE_AGENT);
        if (bx >= n1_ && bx < 2 * n1_) (void)__hip_atomic_fetch_add(cw + 384 + myx, 1u, __ATOMIC_RELAXED, __HIP_MEMORY_SCOPE_AGENT);
    }
    mod_gemv(ka, lds, tid, MOD, 576, bx, G);
    if (bx == G - 1) {
        for (int e = tid; e < 2048; e += NTHR) { const int pos = e >> 5, j = e & 31; const float invf = exp2f(-(float)j * (13.287712379549449f / 32.f)); const float ang = (float)pos * invf;
            f32x2 cs; cs.x = cosf(ang); cs.y = sinf(ang); ROPE[e] = cs; }
    }
    {
        const int gt = vcu * NTHR + tid, NGT = G * NTHR;
        for (int i = gt; i < 2 * 57344; i += NGT) { const int l = i / 57344, r = i % 57344; ((v4u*)(WIN + ((size_t)l * INP + INC) * 2048))[r] = (v4u){0u, 0u, 0u, 0u}; }
    }
    cvt_run<0, 22016, 0, 11008, 0, 13344, 0, 3072, 0, 2048, 1>(ka, ws, (LAS float*)(lds + wave * 16384), lane, gw, NGW, 1);
    {
        const int gt = vcu * NTHR + tid, NGT = G * NTHR; const float* ck = arg_in(ka, 3); bf16* CKB = (bf16*)(ws + WS_CKB);
        for (int i = gt; i < 4194304 / 8; i += NGT) { const f32x4 a = ((const f32x4*)ck)[2 * i], b2 = ((const f32x4*)ck)[2 * i + 1];
            v4u w; w.x = pk2(a.x, a.y); w.y = pk2(a.z, a.w); w.z = pk2(b2.x, b2.y); w.w = pk2(b2.z, b2.w); ((v4u*)CKB)[i] = w; }
    }
}
PHASE_FN ph_norm(LAS unsigned char* lds_, int wave_, int mode_, int l_, int i_, int part_, int lfp_) {
    PH_BEGIN
    const int mode = mode_, l = l_, i = i_, part = part_;
    pg8::FfnPreOrder SP; SP.init(G, bx, 2048);
    const int npre = part == 2 ? SP.nblk() : 0;
    if (part == 2 && bx < npre) {
        WSP(bf16, H, WS_H); WSP(bf16, WFI, WS_WFI); WSP(bf16, ACT, WS_A);
        pg8::Gemm g{H, WFI + (size_t)lfp_ * FF2 * 2048, 2048, 2048, 1024, 1024, 2048, 2048, (unsigned*)(ws + WS_CTL + 524288)};
        EpiSwiGLUPre E{ACT, (bf16*)(ws + WS_B + 64 * MiB) + (size_t)(bx & 15) * 65536, (unsigned*)(ws + WS_CTL) + CW_MFLAG + 656 + lfp_ * 16 + (bx & 15), SP.split ? (bx < 16 ? 1 : 2) : 0};
        pg8::gemm_phase<EpiSwiGLUPre, pg8::FfnPreOrder>(lds, g, SP, E, tid);
        return;
    }
    WSP(bf16, YB, WS_B);
    const int ln = (i == 2) ? l + 1 : l, gn = (i == 2) ? 0 : i + 1;
    const float resw = (i == 1) ? 1.0f : 0.5f;
    const int row_lo = part == 2 ? MCTX : 0, row_hi = part == 1 ? MCTX : MTOK;
    const int gwe = part == 2 ? (bx - npre) * NWAVES + wave : gw, NGWe = part == 2 ? (G - npre) * NWAVES : NGW;
    if (mode == 0) norm_rows<true, false>(ka, gwe, NGWe, lane, nullptr, nullptr, 0, 0, 0.f, arg_in(ka, 9), 0, 0, row_lo, row_hi);
    else if (mode == 1) norm_rows<false, false>(ka, gwe, NGWe, lane, YB, arg_in(ka, 10) + (size_t)(l * 3 + i) * DM, l, i, resw, arg_in(ka, 9) + (size_t)(ln * 3 + gn) * DM, ln, gn, row_lo, row_hi);
    else norm_rows<false, true>(ka, gwe, NGWe, lane, YB, arg_in(ka, 10) + (size_t)(l * 3 + i) * DM, l, i, resw, nullptr, 0, 0, row_lo, row_hi);
}
PHASE_FN ph_ffn_in(LAS unsigned char* lds_, int wave_, int lf_) {
    PH_BEGIN
    const int lf = lf_;
    WSP(bf16, H, WS_H); WSP(bf16, WFI, WS_WFI); WSP(bf16, ACT, WS_A);
    pg8::Gemm g{H, WFI + (size_t)lf * FF2 * 2048, 2048, 2048, 0, 0, 2048, 2048, (unsigned*)(ws + WS_CTL + 524288)}; pg8::FfnOrder S; S.init(G, bx, 0);
    EpiSwiGLU E{ACT}; pg8::gemm_phase<EpiSwiGLU, pg8::FfnOrder>(lds, g, S, E, tid);
}
PHASE_FN ph_ffn_out(LAS unsigned char* lds_, int wave_, int lf_) {
    PH_BEGIN
    const int lf = lf_;
    WSP(bf16, ACT, WS_A); WSP(bf16, WFO, WS_WFO); WSP(bf16, YB, WS_B);
    pg8::Gemm g{ACT, WFO + (size_t)lf * 2048 * FF, FF, FF, 2944, 2944, 2944, 2560, (unsigned*)(ws + WS_CTL + 524288)}; pg8::SplitKOrder S; S.init(G, bx, FF, 2944);
    const int n1 = S.n1, jt = (bx < n1 ? bx : bx - n1) & 127;
    EpiY E{YB, DM, ws, 2 + lf, jt, n1, (n1 > 0 && bx < 2 * n1) ? (bx < n1 ? 1 : 2) : 0, S.pm2, S.pn2}; pg8::gemm_phase<EpiY, pg8::SplitKOrder>(lds, g, S, E, tid);
}
PHASE_FN ph_inproj(LAS unsigned char* lds_, int wave_, int l_) {
    PH_BEGIN
    const int l = l_;
    WSP(bf16, H, WS_H); WSP(bf16, WIN, WS_WIN); WSP(f32x2, ROPE, WS_ROPE);
    pg8::Gemm g{H, WIN + (size_t)l * INP * 2048, 2048, 2048, 0, 0, 2048, 2048, (unsigned*)(ws + WS_CTL + 524288)}; pg8::ZOrder S; S.init(48, 53, 1, G, bx, 0);
    EpiInProj E{ws + WS_A, arg_out(ka) + 25165824, arg_out(ka) + 33554432, ROPE, l, lds + TS_OFF};
    pg8::gemm_phase<EpiInProj, pg8::ZOrder>(lds, g, S, E, tid);
}
PHASE_FN ph_mix1(LAS unsigned char* lds_, int wave_, int l_) {
    PH_BEGIN
    const int l = l_;
    unsigned char* PA = ws + WS_A; WSP(bf16, PL, WS_PL); WSP(bf16, BR, WS_BR);
    const bf16* U = (const bf16*)(PA + PA_U);
    {
        const int gt = vcu * NTHR + tid, NGT = G * NTHR;
#define PL_ACC(w_, f_) { s[0] += f_ * bflo(w_.x); s[1] += f_ * bfhi(w_.x); s[2] += f_ * bflo(w_.y); s[3] += f_ * bfhi(w_.y); s[4] += f_ * bflo(w_.z); s[5] += f_ * bfhi(w_.z); s[6] += f_ * bflo(w_.w); s[7] += f_ * bfhi(w_.w); }
        for (int idx = gt; idx < (MTOK / 16) * 128; idx += NGT) {
            const int run = idx >> 7, cc = idx & 127, col0 = cc * 8, g4 = col0 >> 8, win = 2 << g4, lo = win / 2, hi = win - 1 - lo;
            const int row0 = run * 16;
            const int base = row0 < MCTX ? (row0 & ~255) : MCTX + ((row0 - MCTX) & ~2047), L = row0 < MCTX ? 256 : 2048, t0 = row0 - base;
            const bf16* Ub = U + (size_t)base * 1024 + col0; bf16* Pb = PL + (size_t)base * 1024 + col0;
            float s[8] = {0.f, 0.f, 0.f, 0.f, 0.f, 0.f, 0.f, 0.f};
            {
                v4u wq[16];
#pragma unroll
                for (int k = 0; k < 16; ++k) { int r = t0 - lo + k; r = r < 0 ? 0 : (r > L - 1 ? L - 1 : r); wq[k] = *(const v4u*)(Ub + (size_t)r * 1024); }
#pragma unroll
                for (int k = 0; k < 16; ++k) { const int r = t0 - lo + k; const float f = (k < win && r >= 0 && r <= L - 1) ? 1.f : 0.f; PL_ACC(wq[k], f) }
            }
#pragma unroll
            for (int jg = 0; jg < 4; ++jg) {
                v4u wn[4], wo[4], wc[4];
#pragma unroll
                for (int jj = 0; jj < 4; ++jj) { const int t = t0 + 4 * jg + jj; int tn = t + hi, to = t - lo - 1; tn = tn > L - 1 ? L - 1 : tn; to = to < 0 ? 0 : to;
                    wn[jj] = *(const v4u*)(Ub + (size_t)tn * 1024); wo[jj] = *(const v4u*)(Ub + (size_t)to * 1024); wc[jj] = *(const v4u*)(Ub + (size_t)t * 1024); }
#pragma unroll
                for (int jj = 0; jj < 4; ++jj) { const int j = 4 * jg + jj, t = t0 + j;
                    if (j > 0) { const float fn = (t + hi <= L - 1) ? 1.f : 0.f, fo = (t - lo - 1 >= 0) ? -1.f : 0.f; PL_ACC(wn[jj], fn) PL_ACC(wo[jj], fo) }
                    const int tlo = t - lo < 0 ? 0 : t - lo, thi = t + hi > L - 1 ? L - 1 : t + hi;
                    const float ic = __builtin_amdgcn_rcpf((float)(thi - tlo + 1));
                    const v4u w = wc[jj];
                    v4u o; o.x = cvt_pk_bf16(s[0] * ic - bflo(w.x), s[1] * ic - bfhi(w.x)); o.y = cvt_pk_bf16(s[2] * ic - bflo(w.y), s[3] * ic - bfhi(w.y));
                    o.z = cvt_pk_bf16(s[4] * ic - bflo(w.z), s[5] * ic - bfhi(w.z)); o.w = cvt_pk_bf16(s[6] * ic - bflo(w.w), s[7] * ic - bfhi(w.w));
                    *(v4u*)(Pb + (size_t)t * 1024) = o; }
            }
        }
#undef PL_ACC
    }
    {
        LAS float* zs = (LAS float*)lds;
        const bf16* GQ = (const bf16*)(PA + PA_GQ); const bf16* GK = (const bf16*)(PA + PA_GK); const float* GZ = (const float*)(PA + PA_GZ);
        for (int it = bx; it < 384; it += G) {
            const int dir = it & 1, blk = it >> 1;
            __syncthreads();
            for (int e = tid; e < 1024; e += NTHR) zs[e] = GZ[(size_t)(blk * 64 + (e >> 4)) * 32 + dir * 16 + (e & 15)];
            __syncthreads();
            const float* wg = arg_in(ka, 17) + (size_t)(l * 2 + dir) * 16 * 512; const float* bg = arg_in(ka, 18) + (size_t)(l * 2 + dir) * 512;
            bf16* QI = (bf16*)(ws + WS_QI) + (size_t)dir * MTOK * 512; bf16* KI = (bf16*)(ws + WS_KI) + (size_t)dir * MTOK * 512;
            bf16* KDT = (bf16*)(ws + WS_KDT) + (size_t)dir * 512 * MTOK; float* DEC = (float*)(ws + WS_DEC) + (size_t)dir * 192 * 512;
            if (dir == 0) gla_g1_item<0>(zs, zs + 1024, tid, blk, wg, bg, GQ, GK, QI, KI, KDT, DEC); else gla_g1_item<1>(zs, zs + 1024, tid, blk, wg, bg, GQ, GK, QI, KI, KDT, DEC);
            asm volatile("s_waitcnt vmcnt(0)" ::: "memory");
            __syncthreads();
            {
                const int hh = wave >> 1, pr = wave & 1, fr = lane & 15, g = lane >> 4, tok0 = blk * 64;
                bf16x8v Kf[2][4];
#pragma unroll
                for (int sl = 0; sl < 2; ++sl)
#pragma unroll
                    for (int kk = 0; kk < 4; ++kk) Kf[sl][kk] = *(const bf16x8v*)(KI + (size_t)(tok0 + 16 * (2 * pr + sl) + fr) * 512 + hh * 128 + kk * 32 + g * 8);
                unsigned char* pt = ws + WS_PT + ((size_t)(dir * 192 + blk) * 4 + hh) * 8192 + pr * 1024 + lane * 16;
                bf16x8v Qa[4][4];
#pragma unroll
                for (int t4 = 0; t4 < 4; ++t4)
#pragma unroll
                    for (int kk = 0; kk < 4; ++kk) Qa[t4][kk] = *(const bf16x8v*)(QI + (size_t)(tok0 + 16 * t4 + fr) * 512 + hh * 128 + kk * 32 + g * 8);
#pragma unroll
                for (int t4 = 0; t4 < 4; ++t4) {
                    f32x4 a0 = (f32x4){0.f, 0.f, 0.f, 0.f}, a1 = (f32x4){0.f, 0.f, 0.f, 0.f};
#pragma unroll
                    for (int kk = 0; kk < 4; ++kk) { const bf16x8v Qf = Qa[t4][kk];
                        a0 = __builtin_amdgcn_mfma_f32_16x16x32_bf16(Kf[0][kk], Qf, a0, 0, 0, 0); a1 = __builtin_amdgcn_mfma_f32_16x16x32_bf16(Kf[1][kk], Qf, a1, 0, 0, 0); }
#pragma unroll
                    for (int i = 0; i < 4; ++i) { const int tp = 16 * t4 + fr, s0 = 32 * pr + 4 * g + i, s1 = s0 + 16;
                        a0[i] = (dir ? (s0 >= tp) : (s0 <= tp)) ? a0[i] : 0.f; a1[i] = (dir ? (s1 >= tp) : (s1 <= tp)) ? a1[i] : 0.f; }
                    v4u pw; pw.x = cvt_pk_bf16(a0[0], a0[1]); pw.y = cvt_pk_bf16(a0[2], a0[3]); pw.z = cvt_pk_bf16(a1[0], a1[1]); pw.w = cvt_pk_bf16(a1[2], a1[3]);
                    *(v4u*)(pt + t4 * 2048) = pw;
                }
            }
        }
    }
    {
        const bf16* NQ = (const bf16*)(PA + PA_NQ); const bf16* NK = (const bf16*)(PA + PA_NK); const bf16* NVT = (const bf16*)(PA + PA_NV);
        bf16* BR1 = BR + (size_t)MTOK * 1024;
        const float* rpb = arg_in(ka, 16) + (size_t)l * 8 * 15 * 31;
        const bf16* CKB = (const bf16*)(ws + WS_CKB); const bf16* CVT = (const bf16*)(ws + WS_CVT);
        __syncthreads();
        for (int rep_ = 0; rep_ < REP_ATT; ++rep_) {
        for (int ub = vcu; ub < 256; ub += G) {
            const int u = ub * 8 + wave, half = u & 1, r = (u >> 1) & 31, h = (u >> 6) & 7, b = u >> 9;
            int rs = r - 4; rs = rs < 0 ? 0 : (rs > 24 ? 24 : rs);
            const int r0 = r & ~3; int Rlo = r0 - 4; Rlo = Rlo < 0 ? 0 : (Rlo > 24 ? 24 : Rlo); int rs3 = r0 + 3 - 4; rs3 = rs3 < 0 ? 0 : (rs3 > 24 ? 24 : rs3);
            const int nR = rs3 + 7 - Rlo + 1, nloc = (nR + 1) >> 1;
            const int base = MCTX + b * 2048; const size_t co = (((size_t)b * 2 + l) * 8 + h) * 512 * 128;
            attn_block<2, true>(lds, wave, lane, NQ, rpb + h * 465, BR1, base + r * 64 + half * 32, h, rs, r, half, half * 32, Rlo, nloc,
                                (const char*)(NK + (size_t)(base + Rlo * 64) * 1024 + h * 128), (const char*)(NVT + (size_t)(h * 128) * MTOK + base + Rlo * 64),
                                (const char*)(CKB + co), 256u, (const char*)(CVT + co), 1024u, 4);
        }
        for (int ub = bx; ub < 256; ub += G) {
            const int qh = ub & 1, h = (ub >> 1) & 7, b = ub >> 4;
            attn_block<1, false>(lds, wave, lane, NQ, nullptr, BR1, b * 256 + qh * 128 + wave * 16, h, 0, 0, 0, 0, 0, 0, nullptr, nullptr,
                                 (const char*)(NK + (size_t)(b * 256) * 1024 + h * 128), 2048u, (const char*)(NVT + (size_t)(h * 128) * MTOK + b * 256), (unsigned)(MTOK * 2), 2);
        }
        }
    }
}
PHASE_FN ph_mix1b(LAS unsigned char* lds_, int wave_, int l_) {
    PH_BEGIN
    const int l = l_;
    int nb0 = 0, nb1 = 0;
    for (int u = vcu; u < 256; u += G) nb0 += 33;
    for (int u = 256 + vcu; u < 1280; u += G) nb1 += 5;
    const int nbmax = nb0 > nb1 ? nb0 : nb1;
    int done = 0;
    if (wave < 4) { for (int u = vcu; u < 256; u += G) done += gla_g2_unit4(ka, lds, wave, lane, l, u); }
    else { for (int u = 256 + vcu; u < 1280; u += G) done += gla_g2_unit4(ka, lds + 65536, wave - 4, lane, l, u); }
    for (; done < nbmax; ++done) __builtin_amdgcn_s_barrier();
}
PHASE_FN ph_mix2(LAS unsigned char* lds_, int wave_, int l_) {
    PH_BEGIN
    const int l = l_;
    unsigned char* PA = ws + WS_A; WSP(bf16, PL, WS_PL); WSP(bf16, BR, WS_BR); WSP(float, YB, WS_B); WSP(bf16, WPOOL, WS_WPOOL);
    {
        const float* OF = YB; const float* OB = YB + (size_t)MTOK * 1024; const bf16* GR = (const bf16*)(PA + PA_GR); bf16* BR2 = BR + (size_t)2 * MTOK * 1024;
        const float* gn = arg_in(ka, 19) + (size_t)l * 1024;
        const int hh = lane >> 4, sub = lane & 15;
        for (int row = gw; row < MTOK; row += NGW) {
            f32x4 o[4], gv[4]; v2u rv[4]; float ss = 0.f;
#pragma unroll
            for (int j = 0; j < 4; ++j) { const int c = hh * 256 + (sub + 16 * j) * 4; const size_t off = (size_t)row * 1024 + c; o[j] = *(const f32x4*)(OF + off) + *(const f32x4*)(OB + off);
                gv[j] = *(const f32x4*)(gn + c); rv[j] = *(const v2u*)(GR + off); }
#pragma unroll
            for (int j = 0; j < 4; ++j) ss += (o[j].x * o[j].x + o[j].y * o[j].y) + (o[j].z * o[j].z + o[j].w * o[j].w);
            ss = row16_sum(ss);
            const float rstd = 1.0f / sqrtf(ss * (1.f / 256.f) + EPS);
#pragma unroll
            for (int j = 0; j < 4; ++j) { const int c = hh * 256 + (sub + 16 * j) * 4; const f32x4 g4 = gv[j]; const v2u rw = rv[j];
                v2u w; w.x = cvt_pk_bf16(o[j].x * rstd * g4.x * bflo(rw.x), o[j].y * rstd * g4.y * bfhi(rw.x)); w.y = cvt_pk_bf16(o[j].z * rstd * g4.z * bflo(rw.y), o[j].w * rstd * g4.w * bfhi(rw.y));
                *(v2u*)(BR2 + (size_t)row * 1024 + c) = w; }
        }
    }
    {
        pg8::Gemm g{PL, WPOOL + (size_t)l * 4 * 65536, 1024, 256, 256, 65536, 256, 256, (unsigned*)(ws + WS_CTL + 524288)}; pg8::ZOrder S; S.init(48, 1, 4, G, bx, 0);
        EpiPool E{BR, arg_in(ka, 15) + (size_t)l * 1024};
        pg8::gemm_phase<EpiPool, pg8::ZOrder>(lds, g, S, E, tid);
    }
}
PHASE_FN ph_merge(LAS unsigned char* lds_, int wave_, int l_) {
    PH_BEGIN
    const int l = l_;
    WSP(bf16, BR, WS_BR); WSP(bf16, WBR, WS_WBR); WSP(bf16, YB, WS_B); WSP(bf16, MG, WS_MG);
    pg8::Gemm g{BR, WBR + (size_t)l * 3 * 2048 * 1024, 1024, 1024, (size_t)MTOK * 1024, (size_t)2048 * 1024, 1024, 1024, (unsigned*)(ws + WS_CTL + 524288)}; pg8::MergeOrder S; S.init(G, bx); if (l == 0) S.n1 = 0;
    const int n1 = S.n1, jt = bx < n1 ? bx : bx - n1;
    pg8::Unit u2; u2.pm = -1; u2.pn = -1; if (n1 > 0 && bx < 2 * n1) S.Z.map(G + jt, u2);
    EpiMerge E{(const bf16*)(ws + WS_A + PA_GL), YB, MG, ws, l, jt & 127, n1, (n1 > 0 && bx < 2 * n1) ? (bx < n1 ? 1 : 2) : 0, u2.pm, u2.pn};
    pg8::gemm_phase<EpiMerge, pg8::MergeOrder>(lds, g, S, E, tid);
    {
        int w0, rep = 1, NV; bool act;
        if (n1 > 0) {
            if (l == 0) { NV = n1 * NWAVES * 4; act = bx < 2 * n1; if (bx < n1) w0 = bx * NWAVES + wave; else { w0 = n1 * NWAVES + ((bx - n1) * NWAVES + wave) * 3; rep = 3; } }
            else { NV = n1 * NWAVES; act = bx >= n1 && bx < 2 * n1; w0 = (bx - n1) * NWAVES + wave; }
        } else { const int first = 384 % G; act = bx >= first; w0 = (bx - first) * NWAVES + wave; NV = (G - first) * NWAVES; }
        if (act) {
            __syncthreads();
            if (l == 0) cvt_run<22016, 33024, 11008, 16512, 13344, 26688, 3072, 6144, 2048, 4096, 0>(ka, ws, (LAS float*)(lds + wave * 16384), lane, w0, NV, rep);
            else        cvt_run<33024, 44032, 16512, 22016, 0, 0, 0, 0, 0, 0, 0>(ka, ws, (LAS float*)(lds + wave * 16384), lane, w0, NV, rep);
        }
    }
}
PHASE_FN ph_out(LAS unsigned char* lds_, int wave_, int l_) {
    PH_BEGIN
    const int l = l_;
    WSP(bf16, MG, WS_MG); WSP(bf16, WOUT, WS_WOUT); WSP(bf16, YB, WS_B);
    pg8::Gemm g{MG, WOUT + (size_t)l * 2048 * 2048, 2048, 2048, 1152, 1152, 1152, 896, (unsigned*)(ws + WS_CTL + 524288)}; pg8::SplitKOrder S; S.init(G, bx, 2048, 1152);
    const int n1 = S.n1, jt = (bx < n1 ? bx : bx - n1) & 127;
    EpiY E{YB, DM, ws, 6 + l, jt, n1, (n1 > 0 && bx < 2 * n1) ? (bx < n1 ? 1 : 2) : 0, S.pm2, S.pn2};
    pg8::gemm_phase<EpiY, pg8::SplitKOrder>(lds, g, S, E, tid);
}

__global__ void __launch_bounds__(NTHR, 2) mk_fwd(Args args) {
    extern __shared__ __attribute__((aligned(16))) unsigned char lds_raw[];
    LAS unsigned char* lds = (LAS unsigned char*)lds_raw;
    volatile LAS unsigned* MISC = (volatile LAS unsigned*)(lds + MISC_OFF);
    const int wave0 = __builtin_amdgcn_readfirstlane((int)(threadIdx.x >> 6));
    unsigned char* ws0 = arg_ws(KARG);
    gu32* ctl = (gu32*)(ws0 + WS_CTL);
    for (int u = threadIdx.x; u < (LDS_BYTES - LDSCTL_OFF) / 4; u += NTHR) ((LAS unsigned*)(lds + LDSCTL_OFF))[u] = 0u;
    __syncthreads();
    XcdBarrier bar = xcd_barrier_post((unsigned*)(ctl + CW_BAR) + arg_i(KARG, 200) * XCD_BAR_WORDS, MISC + 8);
#if MK_PER_PHASE
    const int lo = arg_i(KARG, 192), hi = arg_i(KARG, 196);
#define IN(k) (lo <= (k) && (k) < hi)
#else
#define IN(k) ((k) < NPH)
#endif
#define SEAM(k) do { if (IN(k) && IN((k) + 1)) { unsigned* bb_ = bar.bar; unsigned bx_ = bar.x; int w_ = wave0; asm volatile("" : "+s"(bb_), "+s"(bx_), "+s"(w_)); \
        unsigned zz_ = 0u; asm volatile("" : "+v"(zz_)); const int ln_ = (int)__builtin_amdgcn_mbcnt_hi(~0u, __builtin_amdgcn_mbcnt_lo(~0u, zz_)); xcd_barrier_impl(bb_, bx_, bar.st, w_ * 64 + ln_); } } while (0)
    if (IN(0)) { ph_prologue(lds, wave0); if (REP_PRO > 1) { __syncthreads(); ph_prologue(lds, wave0); } }
    SEAM(0);
    if (IN(1)) ph_norm(lds, wave0, 0, 0, 0, 1, 0);
    SEAM(1);
    if (IN(2)) ph_norm(lds, wave0, 0, 0, 0, 2, 0);
    SEAM(2);
#define LAYER(l) { constexpr int k0 = 3 + 16 * (l); \
        if (IN(k0 + 0)) { ph_ffn_in(lds, wave0, l * 2 + 0); if (REP_GEMM > 1 || REP_FFI > 1) { __syncthreads(); ph_ffn_in(lds, wave0, l * 2 + 0); } } \
        SEAM(k0 + 0); \
        if (IN(k0 + 1)) { ph_ffn_out(lds, wave0, l * 2 + 0); if (REP_GEMM > 1 || REP_FFO > 1) { __syncthreads(); ph_ffn_out(lds, wave0, l * 2 + 0); } } \
        SEAM(k0 + 1); \
        if (IN(k0 + 2)) ph_norm(lds, wave0, 1, l, 0, 0, 0); \
        SEAM(k0 + 2); \
        if (IN(k0 + 3)) { ph_inproj(lds, wave0, l); if (REP_GEMM > 1 || REP_INP > 1) { __syncthreads(); ph_inproj(lds, wave0, l); } } \
        SEAM(k0 + 3); \
        if (IN(k0 + 4)) { ph_mix1(lds, wave0, l); if (REP_MIX1 > 1) { __syncthreads(); ph_mix1(lds, wave0, l); } } \
        SEAM(k0 + 4); \
        if (IN(k0 + 5)) { ph_mix1b(lds, wave0, l); if (REP_SCAN > 1) { __syncthreads(); ph_mix1b(lds, wave0, l); } } \
        SEAM(k0 + 5); \
        if (IN(k0 + 6)) { ph_mix2(lds, wave0, l); if (REP_GEMM > 1) { __syncthreads(); ph_mix2(lds, wave0, l); } } \
        SEAM(k0 + 6); \
        if (IN(k0 + 7)) { ph_merge(lds, wave0, l); if (REP_GEMM > 1) { __syncthreads(); ph_merge(lds, wave0, l); } } \
        SEAM(k0 + 7); \
        if (IN(k0 + 8)) { ph_out(lds, wave0, l); if (REP_GEMM > 1) { __syncthreads(); ph_out(lds, wave0, l); } } \
        SEAM(k0 + 8); \
        if (IN(k0 + 9)) ph_norm(lds, wave0, 1, l, 1, 1, 0); \
        SEAM(k0 + 9); \
        if (IN(k0 + 10)) ph_norm(lds, wave0, 1, l, 1, 2, l * 2 + 1); \
        SEAM(k0 + 10); \
        if (IN(k0 + 11)) { ph_ffn_in(lds, wave0, l * 2 + 1); if (REP_GEMM > 1 || REP_FFI > 1) { __syncthreads(); ph_ffn_in(lds, wave0, l * 2 + 1); } } \
        SEAM(k0 + 11); \
        if (IN(k0 + 12)) { ph_ffn_out(lds, wave0, l * 2 + 1); if (REP_GEMM > 1 || REP_FFO > 1) { __syncthreads(); ph_ffn_out(lds, wave0, l * 2 + 1); } } \
        SEAM(k0 + 12); \
        if (l == 0) { \
            if (IN(k0 + 13)) ph_norm(lds, wave0, 1, l, 2, 1, 0); \
            SEAM(k0 + 13); \
            if (IN(k0 + 14)) ph_norm(lds, wave0, 1, l, 2, 2, 2); \
            SEAM(k0 + 14); \
        } else { \
            if (IN(k0 + 13)) ph_norm(lds, wave0, 2, l, 2, 0, 0); \
        } \
    }
    LAYER(0)
    LAYER(1)
#undef LAYER
#undef IN
#undef SEAM
}

extern "C" void kernel_launch(void* const* d_in, const int* in_sizes, int n_in, void* d_out, int out_size, void* d_ws, size_t ws_size, hipStream_t stream) {
    static int grid = 0;
    if (grid == 0) {
        if (n_in != 22 || out_size != 50331648 || ws_size < WS_END) { fprintf(stderr, "kernel_launch: unexpected shapes (n_in %d, out %d, ws %zu); nothing launched\n", n_in, out_size, ws_size); grid = -1; return; }
        int dev = 0, cus = 0, per_cu = 0;
        if (hipGetDevice(&dev) != hipSuccess || hipDeviceGetAttribute(&cus, hipDeviceAttributeMultiprocessorCount, dev) != hipSuccess) { grid = -1; return; }
        if (hipFuncSetAttribute((const void*)mk_fwd, hipFuncAttributeMaxDynamicSharedMemorySize, LDS_BYTES) != hipSuccess) { fprintf(stderr, "kernel_launch: hipFuncSetAttribute failed\n"); grid = -1; return; }
        if (hipOccupancyMaxActiveBlocksPerMultiprocessor(&per_cu, (const void*)mk_fwd, NTHR, LDS_BYTES) != hipSuccess || per_cu < 1)
            fprintf(stderr, "kernel_launch: note: occupancy query reports %d workgroups per CU\n", per_cu);
        (void)hipGetLastError();
        grid = cus;
    }
    if (grid < 0) return;
    if (hipMemsetAsync((char*)d_ws + WS_CTL, 0, CTL_ZERO_BYTES, stream) != hipSuccess) { fprintf(stderr, "kernel_launch: memset failed\n"); return; }
    Args a{};
    for (int i = 0; i < 22; ++i) a.in[i] = (const float*)d_in[i];
    a.out = (float*)d_out; a.ws = (unsigned char*)d_ws;
#if MK_PER_PHASE
    for (int k = 0; k < NPH; ++k) { a.ph_lo = k; a.ph_hi = k + 1; a.li = k;
        hipLaunchKernelGGL(mk_fwd, dim3(grid), dim3(NTHR), LDS_BYTES, stream, a); }
#else
    a.ph_lo = 0; a.ph_hi = NPH; a.li = 0;
    hipLaunchKernelGGL(mk_fwd, dim3(grid), dim3(NTHR), LDS_BYTES, stream, a);
#endif
    const hipError_t le = hipPeekAtLastError();
    if (le != hipSuccess) fprintf(stderr, "kernel_launch: launch failed: %s\n", hipGetErrorName(le));
}
```
